# Optimizing an MI355X kernel written in HIP

```python
import jax, jax.numpy as jnp
from jax import lax
import numpy as np

D_MODEL = 1024
BATCH = 16
SEQ = 2048
DEPTH = 1

D_RNN = D_MODEL
RNN_BLOCKS = 16
RNN_BLOCK_W = D_RNN // RNN_BLOCKS
CONV_W = 4
LRU_C = 8.0
HEAD_DIM = 64
N_Q_HEADS = D_MODEL // HEAD_DIM
N_KV_HEADS = 4
GQA_GROUP = N_Q_HEADS // N_KV_HEADS
WINDOW = 128
ATTN_BLOCK = WINDOW
ROPE_THETA = 10000.0
Q_W = N_Q_HEADS * HEAD_DIM
KV_W = N_KV_HEADS * HEAD_DIM
D_FF = 4 * D_MODEL
PLE_DIM = 256
NORM_EPS = 1e-6
IN_WIDTHS = [D_RNN, D_RNN, Q_W, KV_W, KV_W, D_MODEL, D_MODEL]
IN_TOTAL = int(sum(IN_WIDTHS))
SPLIT_IDX = [int(v) for v in np.cumsum(IN_WIDTHS)[:-1]]

kernel_name = 'hybrid_rglru_swa_sink_gated_block'


def _rmsnorm(t, g):
    tf = t.astype(jnp.float32)
    y = tf * lax.rsqrt(jnp.mean(tf * tf, axis=-1, keepdims=True) + NORM_EPS)
    return (y * g.astype(jnp.float32)).astype(t.dtype)


def _rope_tables(S):
    inv = ROPE_THETA ** (-jnp.arange(0, HEAD_DIM, 2, dtype=jnp.float32) / HEAD_DIM)
    ang = jnp.arange(S, dtype=jnp.float32)[:, None] * inv[None, :]
    return jnp.cos(ang), jnp.sin(ang)


def _rope(t, cos, sin):
    tf = t.astype(jnp.float32)
    t1, t2 = jnp.split(tf, 2, axis=-1)
    c = cos[None, :, None, :]
    s = sin[None, :, None, :]
    return jnp.concatenate([t1 * c - t2 * s, t2 * c + t1 * s], axis=-1).astype(t.dtype)


def _causal_conv(t, w, b):
    S = t.shape[1]
    tp = jnp.pad(t, ((0, 0), (CONV_W - 1, 0), (0, 0)))
    out = b + tp[:, 0:S] * w[0]
    for j in range(1, CONV_W):
        out = out + tp[:, j:j + S] * w[j]
    return out


def _rg_lru(xc, w_rg, b_rg, w_ig, b_ig, lam):
    B, S, _ = xc.shape
    xb = xc.reshape(B, S, RNN_BLOCKS, RNN_BLOCK_W)
    r = jax.nn.sigmoid(jnp.einsum('bshi,hij->bshj', xb, w_rg).reshape(B, S, D_RNN) + b_rg)
    i = jax.nn.sigmoid(jnp.einsum('bshi,hij->bshj', xb, w_ig).reshape(B, S, D_RNN) + b_ig)
    log_a = -LRU_C * r.astype(jnp.float32) * jax.nn.softplus(-lam.astype(jnp.float32))
    a = jnp.exp(log_a)
    mult = jnp.sqrt(-jnp.expm1(2.0 * log_a))
    bterm = mult * (i * xc).astype(jnp.float32)

    def combine(left, right):
        a1, b1 = left
        a2, b2 = right
        return a1 * a2, a2 * b1 + b2

    _, h = lax.associative_scan(combine, (a, bterm), axis=1)
    return h.astype(xc.dtype)


def _sliding_window_attention(q, k, v, q_gain, k_gain, sinks, cos, sin):
    B, S, _ = q.shape
    NB = S // ATTN_BLOCK
    q = _rope(_rmsnorm(q.reshape(B, S, N_Q_HEADS, HEAD_DIM), q_gain), cos, sin)
    k = _rope(_rmsnorm(k.reshape(B, S, N_KV_HEADS, HEAD_DIM), k_gain), cos, sin)
    v = v.reshape(B, S, N_KV_HEADS, HEAD_DIM)
    qb = q.reshape(B, NB, ATTN_BLOCK, N_KV_HEADS, GQA_GROUP, HEAD_DIM)

    def band(t):
        tb = t.reshape(B, NB, ATTN_BLOCK, N_KV_HEADS, HEAD_DIM)
        prev = jnp.pad(tb[:, :-1], ((0, 0), (1, 0), (0, 0), (0, 0), (0, 0)))
        return jnp.concatenate([prev, tb], axis=2)

    kb = band(k)
    vb = band(v)
    s = jnp.einsum('bnqkgd,bnckd->bnkgqc', qb, kb).astype(jnp.float32) * (HEAD_DIM ** -0.5)
    qi = jnp.arange(ATTN_BLOCK)[:, None]
    ci = jnp.arange(2 * ATTN_BLOCK)[None, :]
    diff = ATTN_BLOCK + qi - ci
    blk = jnp.arange(NB)[:, None, None]
    valid = (diff >= 0) & (diff < WINDOW) & ((blk - 1) * ATTN_BLOCK + ci >= 0)
    s = jnp.where(valid[None, :, None, None, :, :], s, -jnp.inf)
    sink = sinks.astype(jnp.float32).reshape(N_KV_HEADS, GQA_GROUP)[None, None, :, :, None, None]
    m = jnp.maximum(jnp.max(s, axis=-1, keepdims=True), sink)
    e = jnp.exp(s - m)
    probs = e / (jnp.sum(e, axis=-1, keepdims=True) + jnp.exp(sink - m))
    o = jnp.einsum('bnkgqc,bnckd->bnqkgd', probs.astype(v.dtype), vb)
    return o.reshape(B, S, Q_W)


def setup_inputs(seed: int = 0) -> dict:
    key = jax.random.key(seed)
    ks = jax.random.split(key, 24)
    f32 = jnp.float32
    L = DEPTH

    def nrm(k, shape, scale):
        return jax.random.normal(k, shape, f32) * scale

    u = jax.random.uniform(ks[10], (L, D_RNN), f32, minval=0.9, maxval=0.999)
    s_a = u ** (1.0 / LRU_C)
    lru_lambda = jnp.log(s_a) - jnp.log1p(-s_a)
    return {
        'x': nrm(ks[0], (BATCH, SEQ, D_MODEL), 1.0),
        'p': nrm(ks[1], (DEPTH, BATCH, SEQ, PLE_DIM), 1.0),
        'g_mix': 1.0 + nrm(ks[2], (L, D_MODEL), 0.02),
        'w_in': nrm(ks[3], (L, D_MODEL, IN_TOTAL), D_MODEL ** -0.5),
        'conv_w': nrm(ks[4], (L, CONV_W, D_RNN), CONV_W ** -0.5),
        'conv_b': nrm(ks[5], (L, D_RNN), 0.01),
        'w_rg': nrm(ks[6], (L, RNN_BLOCKS, RNN_BLOCK_W, RNN_BLOCK_W), RNN_BLOCK_W ** -0.5),
        'b_rg': nrm(ks[7], (L, D_RNN), 0.01),
        'w_ig': nrm(ks[8], (L, RNN_BLOCKS, RNN_BLOCK_W, RNN_BLOCK_W), RNN_BLOCK_W ** -0.5),
        'b_ig': nrm(ks[9], (L, D_RNN), 0.01),
        'lru_lambda': lru_lambda,
        'w_rnn_proj': nrm(ks[11], (L, D_RNN, D_MODEL), D_RNN ** -0.5),
        'q_gain': 1.0 + nrm(ks[12], (L, HEAD_DIM), 0.02),
        'k_gain': 1.0 + nrm(ks[13], (L, HEAD_DIM), 0.02),
        'sinks': nrm(ks[14], (L, N_Q_HEADS), 0.5),
        'w_attn_proj': nrm(ks[15], (L, Q_W, D_MODEL), Q_W ** -0.5),
        'w_out': nrm(ks[16], (L, D_MODEL, D_MODEL), D_MODEL ** -0.5),
        'g_mlp': 1.0 + nrm(ks[17], (L, D_MODEL), 0.02),
        'w_up': nrm(ks[18], (L, D_MODEL, D_FF), D_MODEL ** -0.5),
        'w_down': nrm(ks[19], (L, D_FF, D_MODEL), D_FF ** -0.5),
        'g_ple': 1.0 + nrm(ks[20], (L, D_MODEL), 0.02),
        'w_ple_gate': nrm(ks[21], (L, D_MODEL, D_MODEL), D_MODEL ** -0.5),
        'w_ple_proj': nrm(ks[22], (L, PLE_DIM, D_MODEL), PLE_DIM ** -0.5),
    }


def reference(x, p, g_mix, w_in, conv_w, conv_b, w_rg, b_rg, w_ig, b_ig, lru_lambda,
              w_rnn_proj, q_gain, k_gain, sinks, w_attn_proj, w_out, g_mlp, w_up, w_down,
              g_ple, w_ple_gate, w_ple_proj):
    S = x.shape[1]
    cos, sin = _rope_tables(S)
    for l in range(DEPTH):
        h = _rmsnorm(x, g_mix[l])
        z = h @ w_in[l]
        x_rnn, g_rnn, q, k, v, gate_a, gate_b = jnp.split(z, SPLIT_IDX, axis=-1)
        xc = _causal_conv(x_rnn, conv_w[l], conv_b[l])
        hr = _rg_lru(xc, w_rg[l], b_rg[l], w_ig[l], b_ig[l], lru_lambda[l])
        y_a = (hr * jax.nn.gelu(g_rnn)) @ w_rnn_proj[l]
        y_b = _sliding_window_attention(q, k, v, q_gain[l], k_gain[l], sinks[l], cos, sin) @ w_attn_proj[l]
        merged = jax.nn.sigmoid(gate_a) * y_a + jax.nn.sigmoid(gate_b) * y_b
        x = x + merged @ w_out[l]
        hm = _rmsnorm(x, g_mlp[l])
        x = x + jnp.square(jax.nn.relu(hm @ w_up[l])) @ w_down[l]
        e = p[l] @ w_ple_proj[l]
        x = x + e * jax.nn.sigmoid(_rmsnorm(x, g_ple[l]) @ w_ple_gate[l])
    return x
```

```cpp
#include <hip/hip_runtime.h>
#include <hip/hip_cooperative_groups.h>
#include <cstdio>
#include <cstdint>
namespace cg = cooperative_groups;

#ifndef MK_N_LAUNCHES
#define MK_N_LAUNCHES 1
#endif

#ifndef PROBE_MODE
#define PROBE_MODE 0
#endif
#define LAS __attribute__((address_space(3)))
typedef unsigned short bf16_t;
typedef short bf16x8 __attribute__((ext_vector_type(8)));
typedef short s16x4 __attribute__((ext_vector_type(4)));
typedef float f32x4 __attribute__((ext_vector_type(4)));
typedef float f32x16 __attribute__((ext_vector_type(16)));
typedef unsigned u32x4 __attribute__((ext_vector_type(4)));
typedef unsigned u32x2 __attribute__((ext_vector_type(2)));

constexpr int M = 32768, DM = 1024, SEQ = 2048, NIN = 5632, DFF = 4096, PLE = 256;
constexpr float EPS = 1e-6f;
constexpr int LDZ_RG = 2048, LDZ_QKV = 1536, LDZ_G = 2048;

constexpr size_t MiB = 1u << 20, KiB = 1u << 10;
constexpr size_t WS_SSQ0 = 0, WS_SSQ1 = 128 * KiB, WS_SSQ2 = 256 * KiB, WS_COS = 512 * KiB, WS_SIN = 768 * KiB;
constexpr size_t WS_BAR = 384 * KiB;
constexpr size_t WS_WRG = 1 * MiB, WS_WIG = 1 * MiB + 128 * KiB;
constexpr size_t WS_WIN = 2 * MiB, WS_WRNN = 13 * MiB, WS_WATT = 15 * MiB, WS_WOUT = 17 * MiB, WS_WUP = 19 * MiB, WS_WDN = 27 * MiB, WS_WGATE = 35 * MiB, WS_WPLE = 37 * MiB;
constexpr size_t WS_XB = 38 * MiB;
constexpr size_t WS_PB = 102 * MiB;
constexpr size_t WS_ZRG = 118 * MiB;
constexpr size_t WS_ZQKV = 246 * MiB;
constexpr size_t WS_ZG = 342 * MiB;
constexpr size_t WS_XC = 406 * MiB;
constexpr size_t WS_U = 118 * MiB;
constexpr size_t WS_END = 470 * MiB;

constexpr int LDS_BYTES = 147456;

__device__ __forceinline__ unsigned cvt_pk_bf16(float lo, float hi) { unsigned r; asm volatile("v_cvt_pk_bf16_f32 %0, %1, %2" : "=v"(r) : "v"(lo), "v"(hi)); return r; }
__device__ __forceinline__ float bflo(unsigned w) { return __uint_as_float(w << 16); }
__device__ __forceinline__ float bfhi(unsigned w) { return __uint_as_float(w & 0xffff0000u); }
__device__ __forceinline__ float sigm(float x) { return __builtin_amdgcn_rcpf(1.f + __builtin_amdgcn_exp2f(-1.44269504f * x)); }
__device__ __forceinline__ f32x4 exp2v(f32x4 v) { return (f32x4){__builtin_amdgcn_exp2f(v.x), __builtin_amdgcn_exp2f(v.y), __builtin_amdgcn_exp2f(v.z), __builtin_amdgcn_exp2f(v.w)}; }
__device__ __forceinline__ f32x4 rcpv(f32x4 v) { return (f32x4){__builtin_amdgcn_rcpf(v.x), __builtin_amdgcn_rcpf(v.y), __builtin_amdgcn_rcpf(v.z), __builtin_amdgcn_rcpf(v.w)}; }
__device__ __forceinline__ f32x4 maxv(f32x4 v, float lo) { return (f32x4){fmaxf(v.x, lo), fmaxf(v.y, lo), fmaxf(v.z, lo), fmaxf(v.w, lo)}; }
__device__ __forceinline__ f32x4 expnegv(f32x4 x) { return exp2v(maxv(x, -60.f) * -1.44269504f); }

namespace pg8 {
constexpr int BM = 256, BK = 64, HALF = 128, HTB = HALF * BK * 2, STAGE_BYTES = 8 * HTB, NXCD = 8, WGM = 8;
__host__ __device__ __forceinline__ int lds_byte(int r, int c) { const int st = (r >> 4) * 2 + (c >> 5), rr = r & 15, cc = c & 31, ob = rr * 64 + cc * 2; return st * 1024 + (ob ^ (((ob >> 9) & 1) << 5)); }
__host__ __device__ __forceinline__ void stage_rc(int b, int& R, int& C) { const int st = b / 1024, sb = b % 1024, swz = sb ^ (((sb >> 9) & 1) << 5); R = (st >> 1) * 16 + swz / 64; C = (st & 1) * 32 + (swz % 64) / 2; }
__host__ __device__ __forceinline__ int perm32(int rho) { const int n = rho >> 4, i = rho & 15; return 8 * (i >> 2) + 4 * n + (i & 3); }

struct Unit { int pm, pn; };
struct Gemm { const bf16_t* A; const bf16_t* Bt; int M, N, K, lda, ldb; const bf16_t* A1; const bf16_t* Bt1; int lda1; };

struct StaticOrder {
    int nM, nN, nwg, G, c, i0 = 0, imax = 1 << 30, rot = 0;
    __host__ __device__ void init(int M_, int N_, int G_, int c_) { nM = M_ / BM; nN = N_ / BM; nwg = nM * nN; G = G_; c = c_; }
    __host__ __device__ bool next(int i, Unit& u) const {
        if (i >= imax) return false;
        const long L = (long)(i + i0) * G + c; if (L >= nwg) return false;
        int wgid = (int)L; { const int q = nwg / NXCD, r = nwg % NXCD, xcd = wgid % NXCD, off = wgid / NXCD; wgid = (xcd < r ? xcd * (q + 1) : r * (q + 1) + (xcd - r) * q) + off; }
        const int nig = WGM * nN, gid = wgid / nig, fm = gid * WGM, gsz = (nM - fm) < WGM ? (nM - fm) : WGM;
        u.pm = fm + ((wgid % nig) % gsz); u.pn = (wgid % nig) / gsz + rot; if (u.pn >= nN) u.pn -= nN; return true;
    }
};

template <class Epi, bool DUAL = false>
__device__ __forceinline__ void gemm_phase(LAS unsigned char* lds, const Gemm g, const StaticOrder& S, const Epi& E) {
    const int tid = threadIdx.x, wid = __builtin_amdgcn_readfirstlane(tid >> 6), lane = tid & 63, wr = wid >> 2, wc = wid & 3, fr = lane & 15, fq = lane >> 4;
    const int K = g.K, nt = K / BK;
    unsigned voffA0[2], voffA1[2], voffB[2];
#pragma unroll
    for (int i = 0; i < 2; ++i) { int R, C; stage_rc(tid * 16 + i * 8192, R, C); const int Rb = (R & ~31) + perm32(R & 31);
        voffA0[i] = (unsigned)(R * g.lda + C) * 2u; voffA1[i] = DUAL ? (unsigned)(R * g.lda1 + C) * 2u : voffA0[i]; voffB[i] = (unsigned)(Rb * g.ldb + C) * 2u; }
    const size_t kstep = (size_t)(BK * 2);
    const size_t hstepA0 = (size_t)HALF * g.lda * 2, hstepA1 = DUAL ? (size_t)HALF * g.lda1 * 2 : hstepA0, hstepB = (size_t)HALF * g.ldb * 2;
    const size_t tstepA0 = 2 * hstepA0, tstepA1 = 2 * hstepA1, tstepB = 2 * hstepB;
    const unsigned ldsw = (unsigned)wid * 1024u;
    const int aoff = lds_byte(wr * 64 + fr, fq * 8), boff = lds_byte(wc * 32 + fr, fq * 8);
#define PG8_SA(b, h) (((b) * 2 + (h)) * HTB)
#define PG8_SB(b, h) ((4 + (b) * 2 + (h)) * HTB)
#define PG8_STAGE2(bufoff, gbase, v0, v1) do { \
        __builtin_amdgcn_global_load_lds((const unsigned*)((const char*)(gbase) + (v0)), (LAS unsigned*)(lds + (bufoff) + ldsw), 16, 0, 0); \
        __builtin_amdgcn_global_load_lds((const unsigned*)((const char*)(gbase) + (v1)), (LAS unsigned*)(lds + (bufoff) + ldsw + 8192), 16, 0, 0); } while (0)
#define PG8_STAGEB(bufoff, gbase) PG8_STAGE2(bufoff, gbase, voffB[0], voffB[1])
#define PG8_LDA(dst, b, h) do { _Pragma("unroll") for (int m = 0; m < 4; ++m) _Pragma("unroll") for (int k = 0; k < 2; ++k) dst[m][k] = *(const LAS bf16x8*)(lds + PG8_SA(b, h) + aoff + m * 2048 + k * 1024); } while (0)
#define PG8_LDB(dst, b, h) do { _Pragma("unroll") for (int n = 0; n < 2; ++n) _Pragma("unroll") for (int k = 0; k < 2; ++k) dst[n][k] = *(const LAS bf16x8*)(lds + PG8_SB(b, h) + boff + n * 2048 + k * 1024); } while (0)
#define PG8_MMA(ai, bj, At, Bt) do { __builtin_amdgcn_s_setprio(1); _Pragma("unroll") for (int m = 0; m < 4; ++m) _Pragma("unroll") for (int n = 0; n < 2; ++n) _Pragma("unroll") for (int k = 0; k < 2; ++k) \
        acc[ai][bj][m][n] = __builtin_amdgcn_mfma_f32_16x16x32_bf16(Bt[n][k], At[m][k], acc[ai][bj][m][n], 0, 0, 0); __builtin_amdgcn_s_setprio(0); } while (0)
#define PG8_WAIT_V(n) asm volatile("s_waitcnt vmcnt(" #n ")" ::: "memory")
#define PG8_WAIT_L(n) asm volatile("s_waitcnt lgkmcnt(" #n ")" ::: "memory")
#define PG8_BAR __builtin_amdgcn_s_barrier()
#define PG8_SCHED __builtin_amdgcn_sched_barrier(0)
    Unit cur, nxt; int ui = 0;
    if (!S.next(0, cur)) return;
    f32x4 acc[2][2][4][2];
#pragma unroll
    for (int a = 0; a < 2; ++a)
#pragma unroll
        for (int b = 0; b < 2; ++b)
#pragma unroll
            for (int m = 0; m < 4; ++m)
#pragma unroll
                for (int n = 0; n < 2; ++n) acc[a][b][m][n] = (f32x4){0.f, 0.f, 0.f, 0.f};
    bf16x8 At[4][2], B0[2][2], B1[2][2];
    const char* cA = (const char*)g.A + (size_t)cur.pm * tstepA0; const char* cB = (const char*)g.Bt + (size_t)cur.pn * tstepB;
    PG8_STAGEB(PG8_SB(0, 0), cB); PG8_STAGEB(PG8_SB(0, 1), cB + hstepB); PG8_STAGE2(PG8_SA(0, 0), cA, voffA0[0], voffA0[1]); PG8_STAGE2(PG8_SA(0, 1), cA + hstepA0, voffA0[0], voffA0[1]);
    if (wr == 1) PG8_BAR;
    PG8_WAIT_V(2); PG8_BAR;
    PG8_STAGEB(PG8_SB(1, 0), cB + kstep); PG8_STAGE2(PG8_SA(1, 0), cA + kstep, voffA0[0], voffA0[1]); PG8_STAGEB(PG8_SB(1, 1), cB + hstepB + kstep);
    PG8_WAIT_V(6); PG8_BAR;
    for (;;) {
        const bool has_next = S.next(ui + 1, nxt);
#pragma unroll
        for (int sg = 0; sg < (DUAL ? 2 : 1); ++sg) {
            const bool to_seg1 = DUAL && sg == 0;
            const unsigned vc0 = sg ? voffA1[0] : voffA0[0], vc1 = sg ? voffA1[1] : voffA0[1]; const size_t hc = sg ? hstepA1 : hstepA0;
            const char* nA; const char* nB; unsigned vn0, vn1; size_t hn;
            if (to_seg1) { nA = (const char*)g.A1 + (size_t)cur.pm * tstepA1; nB = (const char*)g.Bt1 + (size_t)cur.pn * tstepB; vn0 = voffA1[0]; vn1 = voffA1[1]; hn = hstepA1; }
            else if (has_next) { nA = (const char*)g.A + (size_t)nxt.pm * tstepA0; nB = (const char*)g.Bt + (size_t)nxt.pn * tstepB; vn0 = voffA0[0]; vn1 = voffA0[1]; hn = hstepA0; }
            else { nA = cA; nB = cB; vn0 = vc0; vn1 = vc1; hn = hc; }
            for (int t = 0; t < nt; t += 2) {
                const bool last = (t == nt - 2);
                const char* a1 = cA + (size_t)(t + 1) * kstep;
                const char* a2 = last ? nA : cA + (size_t)(t + 2) * kstep; const char* b2 = last ? nB : cB + (size_t)(t + 2) * kstep;
                const char* a3 = a2 + kstep; const char* b3 = b2 + kstep;
                const unsigned vx0 = last ? vn0 : vc0, vx1 = last ? vn1 : vc1; const size_t hx = last ? hn : hc;
                PG8_LDB(B0, 0, 0); PG8_LDB(B1, 0, 1); PG8_SCHED; PG8_LDA(At, 0, 0); PG8_STAGE2(PG8_SA(1, 1), a1 + hc, vc0, vc1);
                PG8_WAIT_V(8); PG8_WAIT_L(0); PG8_BAR; PG8_MMA(0, 0, At, B0); PG8_MMA(0, 1, At, B1); PG8_BAR; PG8_SCHED;
                PG8_LDA(At, 0, 1); PG8_STAGEB(PG8_SB(0, 0), b2); PG8_STAGEB(PG8_SB(0, 1), b2 + hstepB); PG8_STAGE2(PG8_SA(0, 0), a2, vx0, vx1);
                PG8_WAIT_V(8); PG8_WAIT_L(0); PG8_BAR; PG8_MMA(1, 0, At, B0); PG8_MMA(1, 1, At, B1); PG8_BAR; PG8_SCHED;
                PG8_LDB(B0, 1, 0); PG8_LDB(B1, 1, 1); PG8_SCHED; PG8_LDA(At, 1, 0); PG8_STAGE2(PG8_SA(0, 1), a2 + hx, vx0, vx1);
                PG8_WAIT_V(8); PG8_WAIT_L(0); PG8_BAR; PG8_MMA(0, 0, At, B0); PG8_MMA(0, 1, At, B1); PG8_BAR; PG8_SCHED;
                PG8_LDA(At, 1, 1); PG8_STAGEB(PG8_SB(1, 0), b3); PG8_STAGEB(PG8_SB(1, 1), b3 + hstepB); PG8_STAGE2(PG8_SA(1, 0), a3, vx0, vx1);
                PG8_WAIT_V(8); PG8_WAIT_L(0); PG8_BAR; PG8_MMA(1, 0, At, B0); PG8_MMA(1, 1, At, B1); PG8_BAR; PG8_SCHED;
            }
            if constexpr (DUAL) { if (sg == 0) { PG8_SCHED; E.mid(acc, cur, wr, wc, fr, fq); PG8_SCHED; } }
            cA = nA; cB = nB;
        }
        if (wr == 0) PG8_BAR;
        E(acc, cur, wr, wc, fr, fq);
        if (!has_next) break;
        bf16x8 zfrag = {0, 0, 0, 0, 0, 0, 0, 0}; asm volatile("" : "+v"(zfrag));
#pragma unroll
        for (int a = 0; a < 2; ++a)
#pragma unroll
            for (int b = 0; b < 2; ++b)
#pragma unroll
                for (int m = 0; m < 4; ++m)
#pragma unroll
                    for (int n = 0; n < 2; ++n) acc[a][b][m][n] = __builtin_amdgcn_mfma_f32_16x16x32_bf16(zfrag, zfrag, (f32x4){0.f, 0.f, 0.f, 0.f}, 0, 0, 0);
        cur = nxt; ++ui;
        if (wr == 1) PG8_BAR;
    }
    PG8_WAIT_V(0);
    PG8_BAR;
#undef PG8_SA
#undef PG8_SB
#undef PG8_STAGE2
#undef PG8_STAGEB
#undef PG8_LDA
#undef PG8_LDB
#undef PG8_MMA
#undef PG8_WAIT_V
#undef PG8_WAIT_L
#undef PG8_BAR
#undef PG8_SCHED
}
}

typedef f32x4 AccT[2][2][4][2];
#define EPI_LOOP_ROWS  _Pragma("unroll") for (int ai = 0; ai < 2; ++ai) _Pragma("unroll") for (int m = 0; m < 4; ++m)
__device__ __forceinline__ u32x4 pack8(f32x4 v0, f32x4 v1) { u32x4 w; w.x = cvt_pk_bf16(v0[0], v0[1]); w.y = cvt_pk_bf16(v0[2], v0[3]); w.z = cvt_pk_bf16(v1[0], v1[1]); w.w = cvt_pk_bf16(v1[2], v1[3]); return w; }
__device__ __forceinline__ void unpack8(u32x4 w, f32x4& v0, f32x4& v1) { v0 = (f32x4){bflo(w.x), bfhi(w.x), bflo(w.y), bfhi(w.y)}; v1 = (f32x4){bflo(w.z), bfhi(w.z), bflo(w.w), bfhi(w.w)}; }

#define EPI_M _Pragma("unroll") for (int m = 0; m < 4; ++m)
#define EPI_BJ _Pragma("unroll") for (int bj = 0; bj < 2; ++bj)
struct EpiIn {
    bf16_t *zrg, *zqkv, *zg; const float* ssq;
    __device__ __forceinline__ void operator()(const AccT& acc, const pg8::Unit& u, int wr, int wc, int fr, int fq) const {
        bf16_t* base; int ld, colt;
        if (u.pn < 8) { base = zrg; ld = LDZ_RG; colt = u.pn * 256; } else if (u.pn < 14) { base = zqkv; ld = LDZ_QKV; colt = (u.pn - 8) * 256; } else { base = zg; ld = LDZ_G; colt = (u.pn - 14) * 256; }
        const int row0 = u.pm * 256 + wr * 64 + fr, col0 = colt + wc * 32 + 8 * fq;
        float sv[2][4];
        EPI_LOOP_ROWS sv[ai][m] = ssq[row0 + ai * 128 + m * 16];
        EPI_LOOP_ROWS { const int row = row0 + ai * 128 + m * 16; const float s = __builtin_amdgcn_rsqf(sv[ai][m] * (1.f / DM) + EPS); bf16_t* rowp = base + (size_t)row * ld + col0;
            EPI_BJ *(u32x4*)(rowp + bj * 128) = pack8(acc[ai][bj][m][0] * s, acc[ai][bj][m][1] * s); }
    }
};
struct EpiMerge {
    const bf16_t* ga; const bf16_t* gb; int ldg; bf16_t* O; int ldo;
    __device__ __forceinline__ void mid(AccT& acc, const pg8::Unit& u, int wr, int wc, int fr, int fq) const {
        int row0 = u.pm * 256 + wr * 64 + fr, col0 = u.pn * 256 + wc * 32 + 8 * fq;
        asm volatile("" : "+v"(row0), "+v"(col0));
        u32x4 av[2][2][2], bv[2][2][2];
#pragma unroll
        for (int b = 0; b < 5; ++b) {
            if (b < 4) {
#pragma unroll
                for (int mm = 0; mm < 2; ++mm) EPI_BJ { const size_t off = (size_t)(row0 + (b >> 1) * 128 + (2 * (b & 1) + mm) * 16) * ldg + col0 + bj * 128; av[b & 1][mm][bj] = *(const u32x4*)(ga + off); bv[b & 1][mm][bj] = *(const u32x4*)(gb + off); }
            }
            if (b >= 1) { const int c = b - 1, ai = c >> 1;
#pragma unroll
                for (int mm = 0; mm < 2; ++mm) { const int m = 2 * (c & 1) + mm;
                    EPI_BJ { f32x4 a0, a1, b0, b1; unpack8(av[c & 1][mm][bj], a0, a1); unpack8(bv[c & 1][mm][bj], b0, b1);
                        acc[ai][bj][m][0] *= (expnegv(b0) + 1.f) * rcpv(exp2v(a0 * -1.44269504f) + 1.f);
                        acc[ai][bj][m][1] *= (expnegv(b1) + 1.f) * rcpv(exp2v(a1 * -1.44269504f) + 1.f); }
                    asm volatile("" : "+v"(acc[ai][0][m][0]), "+v"(acc[ai][0][m][1]), "+v"(acc[ai][1][m][0]), "+v"(acc[ai][1][m][1]) :: "memory"); }
            }
        }
    }
    __device__ __forceinline__ void operator()(const AccT& acc, const pg8::Unit& u, int wr, int wc, int fr, int fq) const {
        const int row0 = u.pm * 256 + wr * 64 + fr, col0 = u.pn * 256 + wc * 32 + 8 * fq;
        u32x4 bv[2][4][2];
        EPI_LOOP_ROWS EPI_BJ bv[ai][m][bj] = *(const u32x4*)(gb + (size_t)(row0 + ai * 128 + m * 16) * ldg + col0 + bj * 128);
        EPI_LOOP_ROWS EPI_BJ { f32x4 b0, b1; unpack8(bv[ai][m][bj], b0, b1);
            const f32x4 v0 = acc[ai][bj][m][0] * rcpv(expnegv(b0) + 1.f), v1 = acc[ai][bj][m][1] * rcpv(expnegv(b1) + 1.f);
            *(u32x4*)(O + (size_t)(row0 + ai * 128 + m * 16) * ldo + col0 + bj * 128) = pack8(v0, v1); }
    }
};
template <int NB  > struct EpiRes {
    const bf16_t* rbf; bf16_t* xb; float* ssq;
    __device__ __forceinline__ void operator()(const AccT& acc, const pg8::Unit& u, int wr, int wc, int fr, int fq) const {
        const int row0 = u.pm * 256 + wr * 64 + fr, col0 = u.pn * 256 + wc * 32 + 8 * fq;
#pragma unroll
        for (int h = 0; h < NB; ++h) {
            u32x4 rb[2][4][2];
#pragma unroll
            for (int ai = (NB == 2 ? h : 0); ai < (NB == 2 ? h + 1 : 2); ++ai) EPI_M EPI_BJ rb[ai][m][bj] = *(const u32x4*)(rbf + (size_t)(row0 + ai * 128 + m * 16) * DM + col0 + bj * 128);
#pragma unroll
            for (int ai = (NB == 2 ? h : 0); ai < (NB == 2 ? h + 1 : 2); ++ai) EPI_M { const int row = row0 + ai * 128 + m * 16; float sq = 0.f;
                EPI_BJ { const size_t off = (size_t)row * DM + col0 + bj * 128; f32x4 r0, r1; unpack8(rb[ai][m][bj], r0, r1);
                    const f32x4 v0 = acc[ai][bj][m][0] + r0, v1 = acc[ai][bj][m][1] + r1;
                    *(u32x4*)(xb + off) = pack8(v0, v1);
                    const f32x4 q4 = v0 * v0 + v1 * v1; sq += (q4[0] + q4[1]) + (q4[2] + q4[3]); }
                sq += __shfl_xor(sq, 16); sq += __shfl_xor(sq, 32);
                if (fq == 0) unsafeAtomicAdd(ssq + row, sq); }
        }
    }
};
struct EpiUp {
    const float* ssq; bf16_t* O;
    __device__ __forceinline__ void operator()(const AccT& acc, const pg8::Unit& u, int wr, int wc, int fr, int fq) const {
        const int row0 = u.pm * 256 + wr * 64 + fr, col0 = u.pn * 256 + wc * 32 + 8 * fq;
        float sv[2][4];
        EPI_LOOP_ROWS sv[ai][m] = ssq[row0 + ai * 128 + m * 16];
        EPI_LOOP_ROWS { const int row = row0 + ai * 128 + m * 16; const float s = __builtin_amdgcn_rsqf(sv[ai][m] * (1.f / DM) + EPS);
            EPI_BJ { const f32x4 r0 = maxv(acc[ai][bj][m][0] * s, 0.f), r1 = maxv(acc[ai][bj][m][1] * s, 0.f);
                *(u32x4*)(O + (size_t)row * DFF + col0 + bj * 128) = pack8(r0 * r0, r1 * r1); } }
    }
};
struct EpiPlain {
    bf16_t* O;
    __device__ __forceinline__ void operator()(const AccT& acc, const pg8::Unit& u, int wr, int wc, int fr, int fq) const {
        const int row0 = u.pm * 256 + wr * 64 + fr, col0 = u.pn * 256 + wc * 32 + 8 * fq;
        EPI_LOOP_ROWS { const int row = row0 + ai * 128 + m * 16;
            EPI_BJ *(u32x4*)(O + (size_t)row * DM + col0 + bj * 128) = pack8(acc[ai][bj][m][0], acc[ai][bj][m][1]); }
    }
};
struct EpiFinal {
    const float* ssq; const bf16_t* Eb; const bf16_t* xin; float* out;
    __device__ __forceinline__ void operator()(const AccT& acc, const pg8::Unit& u, int wr, int wc, int fr, int fq) const {
        const int row0 = u.pm * 256 + wr * 64 + fr, col0 = u.pn * 256 + wc * 32 + 8 * fq;
        float sv[2][4];
        EPI_LOOP_ROWS sv[ai][m] = ssq[row0 + ai * 128 + m * 16];
        u32x4 xv[2][2][2], ev[2][2][2];
#pragma unroll
        for (int b = 0; b < 5; ++b) {
            if (b < 4) {
#pragma unroll
                for (int mm = 0; mm < 2; ++mm) EPI_BJ { const size_t off = (size_t)(row0 + (b >> 1) * 128 + (2 * (b & 1) + mm) * 16) * DM + col0 + bj * 128; xv[b & 1][mm][bj] = *(const u32x4*)(xin + off); ev[b & 1][mm][bj] = *(const u32x4*)(Eb + off); }
            }
            if (b >= 1) { const int c = b - 1, ai = c >> 1;
#pragma unroll
                for (int mm = 0; mm < 2; ++mm) { const int m = 2 * (c & 1) + mm; const float sc = __builtin_amdgcn_rsqf(sv[ai][m] * (1.f / DM) + EPS);
                    EPI_BJ { const size_t off = (size_t)(row0 + ai * 128 + m * 16) * DM + col0 + bj * 128; f32x4 e0, e1, v0, v1; unpack8(ev[c & 1][mm][bj], e0, e1); unpack8(xv[c & 1][mm][bj], v0, v1);
                        const float nsc = -1.44269504f * sc;
                        v0 += e0 * rcpv(exp2v(acc[ai][bj][m][0] * nsc) + 1.f); v1 += e1 * rcpv(exp2v(acc[ai][bj][m][1] * nsc) + 1.f);
                        __builtin_nontemporal_store(v0, (f32x4*)(out + off)); __builtin_nontemporal_store(v1, (f32x4*)(out + off + 4)); } }
            }
        }
    }
};

__device__ __forceinline__ float wave_sum(float v) {
#pragma unroll
    for (int o = 1; o < 64; o <<= 1) v += __shfl_xor(v, o);
    return v;
}
__device__ __forceinline__ void p0_transpose_item(const float* W, int K, int N, bf16_t* WT, const float* g, LAS float* scr, int item, int lane) {
    const int nblk = N / 32, kb = item / nblk, nb = item % nblk, k0 = 64 * kb, n0 = 32 * nb;
#pragma unroll
    for (int i = 0; i < 32; ++i) { const int kk = 2 * i + (lane >> 5); const float gv = g ? g[k0 + kk] : 1.f; scr[kk * 33 + (lane & 31)] = W[(size_t)(k0 + kk) * N + n0 + (lane & 31)] * gv; }
    asm volatile("s_waitcnt lgkmcnt(0)" ::: "memory");
    const int c = lane & 7;
#pragma unroll
    for (int j = 0; j < 4; ++j) { const int n = (lane >> 3) + 8 * j; const LAS float* s = scr + (8 * c) * 33 + n;
        u32x4 o; o.x = cvt_pk_bf16(s[0 * 33], s[1 * 33]); o.y = cvt_pk_bf16(s[2 * 33], s[3 * 33]); o.z = cvt_pk_bf16(s[4 * 33], s[5 * 33]); o.w = cvt_pk_bf16(s[6 * 33], s[7 * 33]);
        *(u32x4*)(WT + (size_t)(n0 + n) * K + k0 + 8 * c) = o; }
    asm volatile("s_waitcnt lgkmcnt(0)" ::: "memory");
}

struct Args { const float* in[23]; float* out; unsigned char* ws; int ph_lo, ph_hi; };
enum { I_X = 0, I_P, I_GMIX, I_WIN, I_CONVW, I_CONVB, I_WRG, I_BRG, I_WIG, I_BIG, I_LAM, I_WRNN, I_QG, I_KG, I_SINK, I_WATT, I_WOUT, I_GMLP, I_WUP, I_WDN, I_GPLE, I_WGATE, I_WPLE };

__device__ __forceinline__ void convert_p(const Args& a, int G) {
    const int gt = blockIdx.x * 512 + threadIdx.x, NT = G * 512;
    const f32x4* p4 = (const f32x4*)a.in[I_P]; u32x2* pb = (u32x2*)(a.ws + WS_PB);
    for (int i = gt; i < M * PLE / 4; i += 4 * NT) { f32x4 v[4];
#pragma unroll
        for (int q = 0; q < 4; ++q) v[q] = (i + q * NT < M * PLE / 4) ? __builtin_nontemporal_load(p4 + i + q * NT) : (f32x4){0.f, 0.f, 0.f, 0.f};
#pragma unroll
        for (int q = 0; q < 4; ++q) if (i + q * NT < M * PLE / 4) { u32x2 w; w.x = cvt_pk_bf16(v[q].x, v[q].y); w.y = cvt_pk_bf16(v[q].z, v[q].w); pb[i + q * NT] = w; } }
}

enum { WJ_IN = 1, WJ_RNN = 2, WJ_ATT = 4, WJ_OUT = 8, WJ_UP = 16, WJ_DN = 32, WJ_GATE = 64, WJ_PLE = 128, WJ_RG = 256, WJ_IG = 512 };
template <unsigned MASK> __device__ __forceinline__ void convert_weights(const Args& a, LAS unsigned char* lds, int G) {
    const int tid = threadIdx.x, lane = tid & 63, wave = tid >> 6;
    unsigned char* ws = a.ws;
    LAS float* scr = (LAS float*)(lds + wave * 16384);
    const int gw = blockIdx.x * 8 + wave, NGW = G * 8;
    constexpr int N0 = (DM / 64) * (NIN / 32), N1 = (DM / 64) * (DM / 32), N5 = (DM / 64) * (DFF / 32), N6 = (DFF / 64) * (DM / 32), N8 = (PLE / 64) * (DM / 32), N9 = 32;
    constexpr int C_IN = (MASK & WJ_IN) ? N0 : 0, C_RNN = (MASK & WJ_RNN) ? N1 : 0, C_ATT = (MASK & WJ_ATT) ? N1 : 0, C_OUT = (MASK & WJ_OUT) ? N1 : 0, C_UP = (MASK & WJ_UP) ? N5 : 0,
                  C_DN = (MASK & WJ_DN) ? N6 : 0, C_GATE = (MASK & WJ_GATE) ? N1 : 0, C_PLE = (MASK & WJ_PLE) ? N8 : 0, C_RG = (MASK & WJ_RG) ? N9 : 0, C_IG = (MASK & WJ_IG) ? N9 : 0;
    constexpr int NITEMS = C_IN + C_RNN + C_ATT + C_OUT + C_UP + C_DN + C_GATE + C_PLE + C_RG + C_IG;
    for (int it = gw; it < NITEMS; it += NGW) {
        int r = it;
        if (r < C_IN) { p0_transpose_item(a.in[I_WIN], DM, NIN, (bf16_t*)(ws + WS_WIN), a.in[I_GMIX], scr, r, lane); continue; } r -= C_IN;
        if (r < C_RNN) { p0_transpose_item(a.in[I_WRNN], DM, DM, (bf16_t*)(ws + WS_WRNN), nullptr, scr, r, lane); continue; } r -= C_RNN;
        if (r < C_ATT) { p0_transpose_item(a.in[I_WATT], DM, DM, (bf16_t*)(ws + WS_WATT), nullptr, scr, r, lane); continue; } r -= C_ATT;
        if (r < C_OUT) { p0_transpose_item(a.in[I_WOUT], DM, DM, (bf16_t*)(ws + WS_WOUT), nullptr, scr, r, lane); continue; } r -= C_OUT;
        if (r < C_UP) { p0_transpose_item(a.in[I_WUP], DM, DFF, (bf16_t*)(ws + WS_WUP), a.in[I_GMLP], scr, r, lane); continue; } r -= C_UP;
        if (r < C_DN) { p0_transpose_item(a.in[I_WDN], DFF, DM, (bf16_t*)(ws + WS_WDN), nullptr, scr, r, lane); continue; } r -= C_DN;
        if (r < C_GATE) { p0_transpose_item(a.in[I_WGATE], DM, DM, (bf16_t*)(ws + WS_WGATE), a.in[I_GPLE], scr, r, lane); continue; } r -= C_GATE;
        if (r < C_PLE) { p0_transpose_item(a.in[I_WPLE], PLE, DM, (bf16_t*)(ws + WS_WPLE), nullptr, scr, r, lane); continue; } r -= C_PLE;
        if (r < C_RG) { p0_transpose_item(a.in[I_WRG] + (size_t)(r >> 1) * 4096, 64, 64, (bf16_t*)(ws + WS_WRG) + (size_t)(r >> 1) * 4096, nullptr, scr, r & 1, lane); continue; } r -= C_RG;
        if (r < C_IG) p0_transpose_item(a.in[I_WIG] + (size_t)(r >> 1) * 4096, 64, 64, (bf16_t*)(ws + WS_WIG) + (size_t)(r >> 1) * 4096, nullptr, scr, r & 1, lane);
    }
}

__device__ __forceinline__ void p0_prologue(const Args& a, LAS unsigned char* lds, int G) {
    const int tid = threadIdx.x, lane = tid & 63, wave = tid >> 6;
    unsigned char* ws = a.ws;
    const int gw = blockIdx.x * 8 + wave, NGW = G * 8;
    convert_weights<WJ_IN>(a, lds, G);
    const float* x = a.in[I_X]; bf16_t* XB = (bf16_t*)(ws + WS_XB); float* ssq0 = (float*)(ws + WS_SSQ0);
    for (int m4 = gw * 4; m4 < M; m4 += NGW * 4) {
        f32x4 v[4][4];
#pragma unroll
        for (int r = 0; r < 4; ++r) { const f32x4* xr = (const f32x4*)(x + (size_t)(m4 + r) * DM) + lane;
#pragma unroll
            for (int j = 0; j < 4; ++j) v[r][j] = __builtin_nontemporal_load(xr + 64 * j); }
#pragma unroll
        for (int r = 0; r < 4; ++r) { float s = 0.f;
#pragma unroll
            for (int j = 0; j < 4; ++j) s += (v[r][j].x * v[r][j].x + v[r][j].y * v[r][j].y) + (v[r][j].z * v[r][j].z + v[r][j].w * v[r][j].w);
            s = wave_sum(s); if (lane == 0) ssq0[m4 + r] = s;
            u32x2* o8 = (u32x2*)(XB + (size_t)(m4 + r) * DM) + lane;
#pragma unroll
            for (int j = 0; j < 4; ++j) { u32x2 w; w.x = cvt_pk_bf16(v[r][j].x, v[r][j].y); w.y = cvt_pk_bf16(v[r][j].z, v[r][j].w); o8[64 * j] = w; } }
    }
}
__device__ __forceinline__ void setup_misc(const Args& a, int G) {
    unsigned char* ws = a.ws;
    const int gt = blockIdx.x * 512 + threadIdx.x, NT = G * 512;
    { float* s1 = (float*)(ws + WS_SSQ1); float* s2 = (float*)(ws + WS_SSQ2); for (int i = gt; i < M; i += NT) { s1[i] = 0.f; s2[i] = 0.f; } }
    { float* ct = (float*)(ws + WS_COS); float* st = (float*)(ws + WS_SIN);
      for (int i = gt; i < SEQ * 32; i += NT) { const int pos = i >> 5, k = i & 31; const float inv = exp2f(-(float)k * 0.41524101186092029f); const float ang = (float)pos * inv; ct[i] = cosf(ang); st[i] = sinf(ang); } }
}

constexpr int R_XS = 0, R_GS = 18432, R_XCB = 36864, R_WR = 46080, R_WI = 55296, R_AF = 64512, R_BI = 81920, R_SEGP = 99328, R_SEGH = 101376, R_CARRY = 103424;
constexpr int RP = 144;
constexpr int FP = 68;
__device__ __forceinline__ void rnn_item(LAS unsigned char* lds, int item, const Args& a, bf16_t* yo, int ldy) {
    const int tid = threadIdx.x, lane = tid & 63, w = __builtin_amdgcn_readfirstlane(tid >> 6);
    const int b = item >> 4, blk = item & 15, c0 = blk * 64;
    bf16_t* zrg = (bf16_t*)(a.ws + WS_ZRG);
    const int c = lane, seg = w;
    const int lrow = tid >> 3, lpiece = tid & 7;
    { const bf16_t* wr = (const bf16_t*)(a.ws + WS_WRG) + blk * 4096; const bf16_t* wi = (const bf16_t*)(a.ws + WS_WIG) + blk * 4096;
      *(LAS u32x4*)(lds + R_WR + lrow * RP + lpiece * 16) = *(const u32x4*)(wr + lrow * 64 + lpiece * 8);
      *(LAS u32x4*)(lds + R_WI + lrow * RP + lpiece * 16) = *(const u32x4*)(wi + lrow * 64 + lpiece * 8); }
    const int ch = c0 + c;
    const float cw0 = a.in[I_CONVW][ch], cw1 = a.in[I_CONVW][1024 + ch], cw2 = a.in[I_CONVW][2048 + ch], cw3 = a.in[I_CONVW][3072 + ch], cb = a.in[I_CONVB][ch];
    float ebr[2], ebi[2], ec8[2];
#pragma unroll
    for (int q = 0; q < 2; ++q) { const int che = c0 + 16 * (2 * (w & 1) + q) + (lane & 15); ebr[q] = -1.44269504f * a.in[I_BRG][che]; ebi[q] = -1.44269504f * a.in[I_BIG][che]; ec8[q] = 1.44269504f * 8.f * log1pf(expf(-a.in[I_LAM][che])); }
    const size_t rowbase = (size_t)b * SEQ;
    const bf16_t* gx = zrg + (rowbase + lrow) * LDZ_RG + c0 + lpiece * 8;
    u32x4 xpre = *(const u32x4*)gx, gpre = *(const u32x4*)(gx + 1024);
    const int mt = w >> 1;
    for (int ci = 0; ci < SEQ / 64; ++ci) {
        const int cur = ci & 1;
        LAS unsigned char* XS = lds + R_XS + cur * 9216; LAS unsigned char* XSP = lds + R_XS + (cur ^ 1) * 9216; LAS unsigned char* GS = lds + R_GS + cur * 9216;
        *(LAS u32x4*)(XS + lrow * RP + lpiece * 16) = xpre; *(LAS u32x4*)(GS + lrow * RP + lpiece * 16) = gpre;
        if (ci + 1 < SEQ / 64) { const bf16_t* gn = gx + (size_t)(ci + 1) * 64 * LDZ_RG; xpre = *(const u32x4*)gn; gpre = *(const u32x4*)(gn + 1024); }
        __syncthreads();
        float xv[11];
#pragma unroll
        for (int k = 0; k < 11; ++k) { const int rr = seg * 8 - 3 + k;
            if (rr >= 0) xv[k] = __uint_as_float((unsigned)*(const LAS unsigned short*)(XS + rr * RP + c * 2) << 16);
            else xv[k] = (ci > 0) ? __uint_as_float((unsigned)*(const LAS unsigned short*)(XSP + (64 + rr) * RP + c * 2) << 16) : 0.f; }
        float xc[8];
#pragma unroll
        for (int j = 0; j < 8; ++j) { xc[j] = (((cb + xv[j] * cw0) + xv[j + 1] * cw1) + xv[j + 2] * cw2) + xv[j + 3] * cw3;
            *(LAS unsigned short*)(lds + R_XCB + (seg * 8 + j) * RP + c * 2) = (unsigned short)(cvt_pk_bf16(xc[j], 0.f) & 0xffffu); }
        __syncthreads();
        {
            bf16x8 af[2];
#pragma unroll
            for (int ks = 0; ks < 2; ++ks) af[ks] = *(const LAS bf16x8*)(lds + R_XCB + (16 * mt + (lane & 15)) * RP + ks * 64 + (lane >> 4) * 16);
#pragma unroll
            for (int q = 0; q < 2; ++q) { const int nt = 2 * (w & 1) + q;
                f32x4 ar = (f32x4){0.f, 0.f, 0.f, 0.f}, ai = (f32x4){0.f, 0.f, 0.f, 0.f};
#pragma unroll
                for (int ks = 0; ks < 2; ++ks) { const int boff = (16 * nt + (lane & 15)) * RP + ks * 64 + (lane >> 4) * 16;
                    ar = __builtin_amdgcn_mfma_f32_16x16x32_bf16(af[ks], *(const LAS bf16x8*)(lds + R_WR + boff), ar, 0, 0, 0);
                    ai = __builtin_amdgcn_mfma_f32_16x16x32_bf16(af[ks], *(const LAS bf16x8*)(lds + R_WI + boff), ai, 0, 0, 0); }
#pragma unroll
                for (int e = 0; e < 4; e += 2) { const int t = 16 * mt + 4 * (lane >> 4) + e, cc = 16 * nt + (lane & 15);
                    typedef float f32x2 __attribute__((ext_vector_type(2)));
                    const f32x2 tr = (f32x2){ar[e], ar[e + 1]} * -1.44269504f + ebr[q], ti = (f32x2){ai[e], ai[e + 1]} * -1.44269504f + ebi[q];
                    const f32x2 dr = (f32x2){__builtin_amdgcn_exp2f(tr.x), __builtin_amdgcn_exp2f(tr.y)} + 1.f, di = (f32x2){__builtin_amdgcn_exp2f(ti.x), __builtin_amdgcn_exp2f(ti.y)} + 1.f;
                    const f32x2 r = {__builtin_amdgcn_rcpf(dr.x), __builtin_amdgcn_rcpf(dr.y)}, ig = {__builtin_amdgcn_rcpf(di.x), __builtin_amdgcn_rcpf(di.y)};
                    const f32x2 la2 = r * -ec8[q];
                    const f32x2 av = {__builtin_amdgcn_exp2f(la2.x), __builtin_amdgcn_exp2f(la2.y)};
                    const f32x2 m2 = 1.f - av * av;
                    const f32x2 bi = (f32x2){__builtin_amdgcn_sqrtf(m2.x), __builtin_amdgcn_sqrtf(m2.y)} * ig;
                    ((LAS float*)(lds + R_AF))[t * FP + cc] = av.x; ((LAS float*)(lds + R_AF))[(t + 1) * FP + cc] = av.y;
                    ((LAS float*)(lds + R_BI))[t * FP + cc] = bi.x; ((LAS float*)(lds + R_BI))[(t + 1) * FP + cc] = bi.y; } }
        }
        __syncthreads();
        float av[8], bv[8]; float P = 1.f, h = 0.f;
#pragma unroll
        for (int j = 0; j < 8; ++j) { av[j] = ((const LAS float*)(lds + R_AF))[(seg * 8 + j) * FP + c]; bv[j] = ((const LAS float*)(lds + R_BI))[(seg * 8 + j) * FP + c] * xc[j]; h = av[j] * h + bv[j]; P *= av[j]; }
        ((LAS float*)(lds + R_SEGP))[seg * 64 + c] = P; ((LAS float*)(lds + R_SEGH))[seg * 64 + c] = h;
        __syncthreads();
        float hin = (ci > 0) ? ((const LAS float*)(lds + R_CARRY))[cur * 64 + c] : 0.f;
        for (int s = 0; s < seg; ++s) hin = ((const LAS float*)(lds + R_SEGP))[s * 64 + c] * hin + ((const LAS float*)(lds + R_SEGH))[s * 64 + c];
        h = hin;
        float hv[8];
#pragma unroll
        for (int j = 0; j < 8; ++j) { h = av[j] * h + bv[j]; hv[j] = h; }
#pragma unroll
        for (int j = 0; j < 8; j += 2) { typedef float f32x2 __attribute__((ext_vector_type(2)));
            const f32x2 gg = {__uint_as_float((unsigned)*(const LAS unsigned short*)(GS + (seg * 8 + j) * RP + c * 2) << 16), __uint_as_float((unsigned)*(const LAS unsigned short*)(GS + (seg * 8 + j + 1) * RP + c * 2) << 16)};
            const f32x2 wq = gg * (gg * gg * -0.10294324f + -2.3022082f);
            const f32x2 dn = (f32x2){__builtin_amdgcn_exp2f(wq.x), __builtin_amdgcn_exp2f(wq.y)} + 1.f;
            const f32x2 y = (f32x2){hv[j], hv[j + 1]} * gg * (f32x2){__builtin_amdgcn_rcpf(dn.x), __builtin_amdgcn_rcpf(dn.y)};
            *(LAS unsigned short*)(lds + R_XCB + (seg * 8 + j) * RP + c * 2) = (unsigned short)(cvt_pk_bf16(y.x, 0.f) & 0xffffu);
            *(LAS unsigned short*)(lds + R_XCB + (seg * 8 + j + 1) * RP + c * 2) = (unsigned short)(cvt_pk_bf16(y.y, 0.f) & 0xffffu); }
        if (seg == 7) ((LAS float*)(lds + R_CARRY))[(cur ^ 1) * 64 + c] = h;
        __syncthreads();
        *(u32x4*)(yo + (rowbase + (size_t)ci * 64 + lrow) * ldy + c0 + lpiece * 8) = *(const LAS u32x4*)(lds + R_XCB + lrow * RP + lpiece * 16);
    }
    __syncthreads();
}

constexpr int A_K = 0, A_V = 36864, KP = 144, VP = 520;
__device__ __forceinline__ void attn_kv_load(int item, const bf16_t* zq, int tid, u32x4 (&kr)[4], u32x2 (&vr)[8]) {
    const int b = item >> 6, n = (item >> 2) & 15, kvh = item & 3;
    const int key = tid >> 1, half = tid & 1; const int pos = (n - 1) * 128 + key;
    if (pos >= 0) {
        const bf16_t* kp = zq + (size_t)(b * SEQ + pos) * LDZ_QKV + 1024 + kvh * 64 + 16 * half;
        kr[0] = *(const u32x4*)kp; kr[1] = *(const u32x4*)(kp + 8); kr[2] = *(const u32x4*)(kp + 32); kr[3] = *(const u32x4*)(kp + 40);
    } else {
        const u32x4 z = (u32x4){0u, 0u, 0u, 0u};
#pragma unroll
        for (int i = 0; i < 4; ++i) kr[i] = z;
    }
    const int kp2 = tid >> 2, dq = tid & 3; const int vpos = (n - 1) * 128 + 2 * kp2;
    if (vpos >= 0) {
        const bf16_t* vp = zq + (size_t)(b * SEQ + vpos) * LDZ_QKV + 1280 + kvh * 64 + 4 * dq;
#pragma unroll
        for (int g = 0; g < 4; ++g) { vr[2 * g] = *(const u32x2*)(vp + 16 * g); vr[2 * g + 1] = *(const u32x2*)(vp + LDZ_QKV + 16 * g); }
    } else {
#pragma unroll
        for (int i = 0; i < 8; ++i) vr[i] = (u32x2){0u, 0u};
    }
}
__device__ __forceinline__ void attn_phase(LAS unsigned char* lds, const Args& a, bf16_t* oo, int ldo, int first, int step) {
    const int tid = threadIdx.x, lane = tid & 63, w = __builtin_amdgcn_readfirstlane(tid >> 6);
    const bf16_t* zq = (const bf16_t*)(a.ws + WS_ZQKV);
    const float* cosT = (const float*)(a.ws + WS_COS); const float* sinT = (const float*)(a.ws + WS_SIN);
    const int g = w >> 1, r = lane & 31, hh = lane >> 5;
    const float C2 = 0.125f * 1.44269504f;
    int item = first; if (item >= 1024) return;
    u32x4 kr[4]; u32x2 vr[8];
    attn_kv_load(item, zq, tid, kr, vr);
    for (; item < 1024; item += step) {
        const int b = item >> 6, n = (item >> 2) & 15, kvh = item & 3, head = kvh * 4 + g;
        u32x4 qr[2][4];
#pragma unroll
        for (int qt = 0; qt < 2; ++qt) { const bf16_t* qp = zq + (size_t)(b * SEQ + n * 128 + (w & 1) * 64 + qt * 32 + r) * LDZ_QKV + head * 64;
#pragma unroll
            for (int ks = 0; ks < 4; ++ks) qr[qt][ks] = *(const u32x4*)(qp + 16 * ks + 8 * hh); }
        {
            const int key = tid >> 1, half = tid & 1; const int pos = (n - 1) * 128 + key; const int posc = pos >= 0 ? pos : 0;
            float t1[16], t2[16];
            { f32x4 p, q; unpack8(kr[0], p, q); t1[0] = p[0]; t1[1] = p[1]; t1[2] = p[2]; t1[3] = p[3]; t1[4] = q[0]; t1[5] = q[1]; t1[6] = q[2]; t1[7] = q[3];
              unpack8(kr[1], p, q); t1[8] = p[0]; t1[9] = p[1]; t1[10] = p[2]; t1[11] = p[3]; t1[12] = q[0]; t1[13] = q[1]; t1[14] = q[2]; t1[15] = q[3];
              unpack8(kr[2], p, q); t2[0] = p[0]; t2[1] = p[1]; t2[2] = p[2]; t2[3] = p[3]; t2[4] = q[0]; t2[5] = q[1]; t2[6] = q[2]; t2[7] = q[3];
              unpack8(kr[3], p, q); t2[8] = p[0]; t2[9] = p[1]; t2[10] = p[2]; t2[11] = p[3]; t2[12] = q[0]; t2[13] = q[1]; t2[14] = q[2]; t2[15] = q[3]; }
            float ss = 0.f;
#pragma unroll
            for (int i = 0; i < 16; ++i) ss += t1[i] * t1[i] + t2[i] * t2[i];
            ss += __shfl_xor(ss, 1);
            const float rinv = __builtin_amdgcn_rsqf(ss * (1.f / 64.f) + EPS);
            const float* kg = a.in[I_KG] + 16 * half; const float* cp = cosT + posc * 32 + 16 * half; const float* sp = sinT + posc * 32 + 16 * half;
            float o1[16], o2[16];
#pragma unroll
            for (int i = 0; i < 16; ++i) { const float y1 = t1[i] * rinv * kg[i], y2 = t2[i] * rinv * kg[32 + i], cc = cp[i], sn = sp[i]; o1[i] = y1 * cc - y2 * sn; o2[i] = y2 * cc + y1 * sn; }
            LAS unsigned char* kd = lds + A_K + key * KP + 32 * half;
            *(LAS u32x4*)(kd) = pack8((f32x4){o1[0], o1[1], o1[2], o1[3]}, (f32x4){o1[4], o1[5], o1[6], o1[7]});
            *(LAS u32x4*)(kd + 16) = pack8((f32x4){o1[8], o1[9], o1[10], o1[11]}, (f32x4){o1[12], o1[13], o1[14], o1[15]});
            *(LAS u32x4*)(kd + 64) = pack8((f32x4){o2[0], o2[1], o2[2], o2[3]}, (f32x4){o2[4], o2[5], o2[6], o2[7]});
            *(LAS u32x4*)(kd + 80) = pack8((f32x4){o2[8], o2[9], o2[10], o2[11]}, (f32x4){o2[12], o2[13], o2[14], o2[15]});
            const int kp2 = tid >> 2, dq = tid & 3;
            LAS unsigned char* vd = lds + A_V + (4 * dq) * VP + kp2 * 4;
#pragma unroll
            for (int g = 0; g < 4; ++g) { const unsigned a0 = vr[2 * g].x, a1 = vr[2 * g].y, b0 = vr[2 * g + 1].x, b1 = vr[2 * g + 1].y;
                *(LAS unsigned*)(vd + (16 * g + 0) * VP) = (a0 & 0xffffu) | (b0 << 16);
                *(LAS unsigned*)(vd + (16 * g + 1) * VP) = (a0 >> 16) | (b0 & 0xffff0000u);
                *(LAS unsigned*)(vd + (16 * g + 2) * VP) = (a1 & 0xffffu) | (b1 << 16);
                *(LAS unsigned*)(vd + (16 * g + 3) * VP) = (a1 >> 16) | (b1 & 0xffff0000u); }
        }
        __syncthreads();
        if (item + step < 1024) attn_kv_load(item + step, zq, tid, kr, vr);
        const float sink2 = a.in[I_SINK][head] * 1.44269504f;
#pragma unroll
        for (int qt = 0; qt < 2; ++qt) {
            const int m0 = (w & 1) * 64 + qt * 32, i0 = m0 >> 5, q = m0 + r; const int pos = n * 128 + q;
            bf16_t* op = oo + (size_t)(b * SEQ + pos) * ldo + head * 64;
            float v[4][8];
#pragma unroll
            for (int ks = 0; ks < 4; ++ks) { f32x4 p0, p1; unpack8(qr[qt][ks], p0, p1);
                v[ks][0] = p0[0]; v[ks][1] = p0[1]; v[ks][2] = p0[2]; v[ks][3] = p0[3]; v[ks][4] = p1[0]; v[ks][5] = p1[1]; v[ks][6] = p1[2]; v[ks][7] = p1[3]; }
            float ss = 0.f;
#pragma unroll
            for (int ks = 0; ks < 4; ++ks)
#pragma unroll
                for (int j = 0; j < 8; ++j) ss += v[ks][j] * v[ks][j];
            ss += __shfl_xor(ss, 32);
            const float rinv = __builtin_amdgcn_rsqf(ss * (1.f / 64.f) + EPS) * C2;
            bf16x8 qf[4];
#pragma unroll
            for (int ks = 0; ks < 2; ++ks) { const int dl = 16 * ks + 8 * hh; float o1[8], o2[8];
#pragma unroll
                for (int j = 0; j < 8; ++j) { const float y1 = v[ks][j] * rinv * a.in[I_QG][dl + j], y2 = v[ks + 2][j] * rinv * a.in[I_QG][32 + dl + j], cc = cosT[pos * 32 + dl + j], sn = sinT[pos * 32 + dl + j];
                    o1[j] = y1 * cc - y2 * sn; o2[j] = y2 * cc + y1 * sn; }
                u32x4 w1 = pack8((f32x4){o1[0], o1[1], o1[2], o1[3]}, (f32x4){o1[4], o1[5], o1[6], o1[7]}), w2 = pack8((f32x4){o2[0], o2[1], o2[2], o2[3]}, (f32x4){o2[4], o2[5], o2[6], o2[7]});
                qf[ks] = __builtin_bit_cast(bf16x8, w1); qf[ks + 2] = __builtin_bit_cast(bf16x8, w2); }
            f32x16 sacc[5];
#pragma unroll
            for (int t = 0; t < 5; ++t) { const int kt = i0 + t;
                const f32x16 zero16 = {0.f, 0.f, 0.f, 0.f, 0.f, 0.f, 0.f, 0.f, 0.f, 0.f, 0.f, 0.f, 0.f, 0.f, 0.f, 0.f};
#pragma unroll
                for (int ks = 0; ks < 4; ++ks) sacc[t] = __builtin_amdgcn_mfma_f32_32x32x16_bf16(*(const LAS bf16x8*)(lds + A_K + (32 * kt + r) * KP + ks * 32 + hh * 16), qf[ks], ks == 0 ? zero16 : sacc[t], 0, 0, 0); }
            const float NEG = -INFINITY;
#pragma unroll
            for (int e = 0; e < 16; ++e) { const int kr_ = (e & 3) + 8 * (e >> 2) + 4 * hh;
                if (!(kr_ > r)) sacc[0][e] = NEG;
                if (!(kr_ <= r)) sacc[4][e] = NEG; }
            if (n == 0) {
#pragma unroll
                for (int t = 0; t < 4; ++t) if (i0 + t < 4) {
#pragma unroll
                    for (int e = 0; e < 16; ++e) sacc[t][e] = NEG; } }
            float mx = NEG;
#pragma unroll
            for (int t = 0; t < 5; ++t)
#pragma unroll
                for (int e = 0; e < 16; ++e) mx = fmaxf(mx, sacc[t][e]);
            mx = fmaxf(mx, __shfl_xor(mx, 32));
            mx = fmaxf(mx, sink2);
            typedef float f32x2v __attribute__((ext_vector_type(2)));
            f32x2v sum2 = {0.f, 0.f};
#pragma unroll
            for (int t = 0; t < 5; ++t)
#pragma unroll
                for (int e = 0; e < 16; e += 2) { const float p0 = __builtin_amdgcn_exp2f(sacc[t][e] - mx), p1 = __builtin_amdgcn_exp2f(sacc[t][e + 1] - mx); sacc[t][e] = p0; sacc[t][e + 1] = p1; sum2 += (f32x2v){p0, p1}; }
            float sum = sum2.x + sum2.y;
            sum += __shfl_xor(sum, 32);
            const float rden = 1.f / (sum + __builtin_amdgcn_exp2f(sink2 - mx));
            f32x16 oacc[2];
#pragma unroll
            for (int t = 0; t < 5; ++t) { const int kt = i0 + t;
#pragma unroll
                for (int s2 = 0; s2 < 2; ++s2) {
                    u32x4 pw; pw.x = cvt_pk_bf16(sacc[t][8 * s2 + 0], sacc[t][8 * s2 + 1]); pw.y = cvt_pk_bf16(sacc[t][8 * s2 + 2], sacc[t][8 * s2 + 3]); pw.z = cvt_pk_bf16(sacc[t][8 * s2 + 4], sacc[t][8 * s2 + 5]); pw.w = cvt_pk_bf16(sacc[t][8 * s2 + 6], sacc[t][8 * s2 + 7]);
                    const bf16x8 pf = __builtin_bit_cast(bf16x8, pw);
#pragma unroll
                    for (int dt = 0; dt < 2; ++dt) { const LAS unsigned char* vb = lds + A_V + (32 * dt + r) * VP + (32 * kt + 16 * s2 + 4 * hh) * 2;
                        const s16x4 lo = *(const LAS s16x4*)vb, hi = *(const LAS s16x4*)(vb + 16);
                        const bf16x8 vf = __builtin_shufflevector(lo, hi, 0, 1, 2, 3, 4, 5, 6, 7);
                        const f32x16 zero16 = {0.f, 0.f, 0.f, 0.f, 0.f, 0.f, 0.f, 0.f, 0.f, 0.f, 0.f, 0.f, 0.f, 0.f, 0.f, 0.f};
                        oacc[dt] = __builtin_amdgcn_mfma_f32_32x32x16_bf16(vf, pf, (t == 0 && s2 == 0) ? zero16 : oacc[dt], 0, 0, 0); } } }
#pragma unroll
            for (int dt = 0; dt < 2; ++dt)
#pragma unroll
                for (int gq = 0; gq < 4; ++gq) { u32x2 ow; ow.x = cvt_pk_bf16(oacc[dt][4 * gq + 0] * rden, oacc[dt][4 * gq + 1] * rden); ow.y = cvt_pk_bf16(oacc[dt][4 * gq + 2] * rden, oacc[dt][4 * gq + 3] * rden);
                    *(u32x2*)(op + 32 * dt + 8 * gq + 4 * hh) = ow; }
        }
        __syncthreads();
    }
}

#define XB_TMO      128
#define XB_XCNT(j)  (256  + 64 * (j))
#define XB_XSUB(j)  (1280 + 64 * (j))
#define XB_XGEN(j)  (2304 + 64 * (j))
#define XB_TOP      3328
#define XB_TOPGEN   3392
#define XCD_BAR_WORDS 3456
#define XB_SPIN_CAP (1u << 18)
__device__ __forceinline__ unsigned xb_ld(unsigned* p)              { return __hip_atomic_load(p, __ATOMIC_RELAXED, __HIP_MEMORY_SCOPE_AGENT); }
__device__ __forceinline__ unsigned xb_add(unsigned* p, unsigned v) { return __hip_atomic_fetch_add(p, v, __ATOMIC_RELAXED, __HIP_MEMORY_SCOPE_AGENT); }
__device__ __forceinline__ unsigned xb_xcc_id() { return (unsigned)__builtin_amdgcn_s_getreg((3 << 11) | 20) & 0xFu; }
#define XB_SPIN(cond, bar) do { unsigned _sp = 0; while (cond) { __builtin_amdgcn_s_sleep(1); \
    if ((++_sp & 255u) == 0u) { if (xb_ld(&(bar)[XB_TMO])) break; if (_sp > XB_SPIN_CAP) { atomicAdd(&(bar)[XB_TMO], 1u); break; } } } } while (0)
struct XcdBarrier { unsigned* bar; unsigned x; volatile LAS unsigned* st; };
__device__ __forceinline__ XcdBarrier xcd_barrier_post(unsigned* bar, volatile LAS unsigned* st) {
    XcdBarrier b; b.bar = bar; b.x = xb_xcc_id(); b.st = st;
    if (threadIdx.x == 0) (void)xb_add(&bar[XB_XCNT(b.x)], 1u);
    return b;
}
__device__ __forceinline__ void xcd_barrier_complete(unsigned* bar, unsigned x, unsigned& nloc, unsigned& nx) {
    const unsigned G = gridDim.x * gridDim.y * gridDim.z;
    unsigned sum, cnt, mine, sp = 0u;
    for (;;) {
        sum = 0u; cnt = 0u; mine = 0u;
#pragma unroll
        for (unsigned j = 0; j < 16; ++j) { const unsigned c = xb_ld(&bar[XB_XCNT(j)]); sum += c; cnt += (c > 0u) ? 1u : 0u; mine = (j == x) ? c : mine; }
        if (sum == G) break;
        __builtin_amdgcn_s_sleep(1);
        if ((++sp & 255u) == 0u) { if (xb_ld(&bar[XB_TMO])) break; if (sp > XB_SPIN_CAP) { atomicAdd(&bar[XB_TMO], 1u); break; } }
    }
    nloc = mine > 0u ? mine : 1u; nx = cnt > 0u ? cnt : 1u;
}
__device__ __forceinline__ void xcd_barrier(const XcdBarrier& b) {
    asm volatile("s_waitcnt vmcnt(0)" ::: "memory");
    __syncthreads();
    if (threadIdx.x == 0) {
        unsigned* bar = b.bar;
        __builtin_amdgcn_s_waitcnt(0);
        unsigned nloc = b.st[0], nx = b.st[1]; const unsigned xg = b.st[3];
        if (nloc == 0u) { xcd_barrier_complete(bar, b.x, nloc, nx); b.st[0] = nloc; b.st[1] = nx; }
        const unsigned old = xb_add(&bar[XB_XSUB(b.x)], 1u);
        const unsigned gen = old / nloc;
        if (old + 1u == (gen + 1u) * nloc) {
            __builtin_amdgcn_fence(__ATOMIC_RELEASE, "agent");
            asm volatile("s_waitcnt vmcnt(0)" ::: "memory");
            const unsigned og = xb_add(&bar[XB_TOP], 1u);
            const unsigned tg = og / nx;
            if (og + 1u == (tg + 1u) * nx) xb_add(&bar[XB_TOPGEN], 1u);
            else XB_SPIN(xb_ld(&bar[XB_TOPGEN]) == tg, bar);
            __builtin_amdgcn_fence(__ATOMIC_ACQUIRE, "agent");
            xb_add(&bar[XB_XGEN(b.x)], 1u);
            asm volatile("s_waitcnt vmcnt(0)" ::: "memory");
        } else {
            XB_SPIN(xb_ld(&bar[XB_XGEN(b.x)]) == xg, bar);
            __builtin_amdgcn_fence(__ATOMIC_ACQUIRE, "agent");
            asm volatile("s_waitcnt vmcnt(0)" ::: "memory");
        }
        b.st[3] = xg + 1u;
    }
    __syncthreads();
}
__device__ __forceinline__ void xcd_arrive(const XcdBarrier& b) {
    asm volatile("s_waitcnt vmcnt(0)" ::: "memory");
    __syncthreads();
    if (threadIdx.x == 0) {
        unsigned* bar = b.bar;
        __builtin_amdgcn_s_waitcnt(0);
        unsigned nloc = b.st[0], nx = b.st[1];
        if (nloc == 0u) { xcd_barrier_complete(bar, b.x, nloc, nx); b.st[0] = nloc; b.st[1] = nx; }
        const unsigned old = xb_add(&bar[XB_XSUB(b.x)], 1u);
        const unsigned gen = old / nloc;
        b.st[2] = gen;
        if (old + 1u == (gen + 1u) * nloc) {
            __builtin_amdgcn_fence(__ATOMIC_RELEASE, "agent");
            asm volatile("s_waitcnt vmcnt(0)" ::: "memory");
            const unsigned og = xb_add(&bar[XB_TOP], 1u);
            const unsigned tg = og / nx;
            if (og + 1u == (tg + 1u) * nx) xb_add(&bar[XB_TOPGEN], 1u);
        }
    }
}
__device__ __forceinline__ void xcd_wait(const XcdBarrier& b) {
    __syncthreads();
    if (threadIdx.x == 0) {
        unsigned* bar = b.bar;
        const unsigned gen = b.st[2];
        XB_SPIN(xb_ld(&bar[XB_TOPGEN]) == gen, bar);
        __builtin_amdgcn_fence(__ATOMIC_ACQUIRE, "agent");
        asm volatile("s_waitcnt vmcnt(0)" ::: "memory");
    }
    __syncthreads();
}

__global__ void __launch_bounds__(512) fwd_megakernel(Args a) {
    extern __shared__ __attribute__((aligned(16))) unsigned char lds_raw[];
    LAS unsigned char* lds = (LAS unsigned char*)lds_raw;
    cg::grid_group grid = cg::this_grid();
    const int G = gridDim.x, lo = a.ph_lo, hi = a.ph_hi;
    unsigned char* ws = a.ws;
    float* ssq0 = (float*)(ws + WS_SSQ0); float* ssq1 = (float*)(ws + WS_SSQ1); float* ssq2 = (float*)(ws + WS_SSQ2);
    bf16_t* XB = (bf16_t*)(ws + WS_XB); bf16_t* PB = (bf16_t*)(ws + WS_PB); bf16_t* ZRG = (bf16_t*)(ws + WS_ZRG); bf16_t* ZQKV = (bf16_t*)(ws + WS_ZQKV); bf16_t* ZG = (bf16_t*)(ws + WS_ZG);
    bf16_t* U = (bf16_t*)(ws + WS_U);
#define IN(k) (lo <= (k) && (k) < hi)
#define SEAM(k) do { if (IN(k) && IN((k) + 1)) xcd_barrier(bar); } while (0)
#define SEAM_FILL(k, filler) do { if (IN(k) && IN((k) + 1)) xcd_arrive(bar); if (IN(k)) { filler; } if (IN(k) && IN((k) + 1)) xcd_wait(bar); } while (0)
    volatile LAS unsigned* MISC = (volatile LAS unsigned*)(lds + 131072);
    if (threadIdx.x < 32) MISC[threadIdx.x] = 0u;
    __syncthreads();
    XcdBarrier bar; bar.bar = (unsigned*)(ws + WS_BAR); bar.x = 0; bar.st = MISC + 8;
    if (hi - lo > 1) bar = xcd_barrier_post((unsigned*)(ws + WS_BAR), MISC + 8);
    if (hi > 1000) grid.sync();
    if (IN(0)) {
#pragma nounroll
        for (int rep = 0; rep < (PROBE_MODE == 4 ? 2 : 1); ++rep) { p0_prologue(a, lds, G); __syncthreads(); }
    }
#if PROBE_MODE == 7
    for (int i = 0; i < 8; ++i) grid.sync();
#endif
    SEAM_FILL(0, (convert_weights<WJ_RNN | WJ_ATT | WJ_OUT | WJ_RG | WJ_IG | WJ_PLE>(a, lds, G), setup_misc(a, G)));
    if (IN(1)) { pg8::Gemm g{XB, (const bf16_t*)(ws + WS_WIN), M, NIN, DM, DM, DM, nullptr, nullptr, 0}; pg8::StaticOrder S; S.init(M, NIN, G, (int)blockIdx.x); S.rot = 14;
        EpiIn E{ZRG, ZQKV, ZG, ssq0}; pg8::gemm_phase(lds, g, S, E);
#if PROBE_MODE == 3
        pg8::gemm_phase(lds, g, S, E);
#endif
    }
    SEAM_FILL(1, convert_p(a, G));
    if (IN(2)) {
        attn_phase(lds, a, ZQKV, LDZ_QKV, (int)blockIdx.x, G);
        for (int it = blockIdx.x; it < 256; it += G) rnn_item(lds, it, a, ZRG + 1024, LDZ_RG);
#if PROBE_MODE == 1
        for (int it = blockIdx.x; it < 256; it += G) rnn_item(lds, it, a, XB, DM);
#elif PROBE_MODE == 2
        attn_phase(lds, a, XB, DM, (int)blockIdx.x, G);
#endif
    }
    SEAM_FILL(2, (convert_weights<WJ_UP>(a, lds, G)));
    bf16_t* XC = (bf16_t*)(ws + WS_XC);
    if (IN(3)) { pg8::Gemm g{ZRG + 1024, (const bf16_t*)(ws + WS_WRNN), M, DM, DM, LDZ_RG, DM, ZQKV, (const bf16_t*)(ws + WS_WATT), LDZ_QKV}; pg8::StaticOrder S; S.init(M, DM, G, (int)blockIdx.x);
        EpiMerge E{ZG, ZG + 1024, LDZ_G, ZRG, LDZ_RG}; pg8::gemm_phase<EpiMerge, true>(lds, g, S, E); }
    SEAM_FILL(3, (convert_weights<WJ_DN>(a, lds, G)));
    if (IN(5)) { pg8::Gemm g{ZRG, (const bf16_t*)(ws + WS_WOUT), M, DM, DM, LDZ_RG, DM, nullptr, nullptr, 0}; pg8::StaticOrder S; S.init(M, DM, G, (int)blockIdx.x);
        EpiRes<1> E{XB, XC, ssq1}; pg8::gemm_phase(lds, g, S, E); }
    SEAM_FILL(5, (convert_weights<WJ_GATE>(a, lds, G)));
    if (IN(6)) { pg8::Gemm g{XC, (const bf16_t*)(ws + WS_WUP), M, DFF, DM, DM, DM, nullptr, nullptr, 0}; pg8::StaticOrder S; S.init(M, DFF, G, (int)blockIdx.x);
        EpiUp E{ssq1, U}; pg8::gemm_phase(lds, g, S, E); }
#define PLE_FILLER(round) do { pg8::Gemm g{PB, (const bf16_t*)(ws + WS_WPLE), M, DM, PLE, PLE, PLE, nullptr, nullptr, 0}; pg8::StaticOrder S; S.init(M, DM, G, (int)blockIdx.x); S.i0 = (round); S.imax = 1; \
        EpiPlain E{XB}; pg8::gemm_phase(lds, g, S, E); } while (0)
    SEAM_FILL(6, PLE_FILLER(0));
    if (IN(7)) {
        { pg8::Gemm g{U, (const bf16_t*)(ws + WS_WDN), M, DM, DFF, DFF, DFF, nullptr, nullptr, 0}; pg8::StaticOrder S; S.init(M, DM, G, (int)blockIdx.x);
          EpiRes<2> E{XC, XC, ssq2}; pg8::gemm_phase(lds, g, S, E); }
    }
    SEAM_FILL(7, PLE_FILLER(1));
    if (IN(8)) { pg8::Gemm g{XC, (const bf16_t*)(ws + WS_WGATE), M, DM, DM, DM, DM, nullptr, nullptr, 0}; pg8::StaticOrder S; S.init(M, DM, G, (int)blockIdx.x);
        EpiFinal E{ssq2, XB, XC, a.out}; pg8::gemm_phase(lds, g, S, E); }
#undef IN
#undef SEAM
#undef SEAM_FILL
#undef PLE_FILLER
}

extern "C" void kernel_launch(void* const* d_in, const int* in_sizes, int n_in, void* d_out, int out_size, void* d_ws, size_t ws_size, hipStream_t stream) {
    static int grid = 0;
    if (grid == 0) {
        if (n_in != 23 || out_size != M * DM || ws_size < WS_END) { fprintf(stderr, "kernel_launch: unexpected shapes (n_in %d out %d ws %zu)\n", n_in, out_size, ws_size); grid = -1; return; }
        int dev = 0, cus = 0, per_cu = 0;
        hipGetDevice(&dev); hipDeviceGetAttribute(&cus, hipDeviceAttributeMultiprocessorCount, dev);
        hipFuncSetAttribute((const void*)fwd_megakernel, hipFuncAttributeMaxDynamicSharedMemorySize, LDS_BYTES);
        hipOccupancyMaxActiveBlocksPerMultiprocessor(&per_cu, (const void*)fwd_megakernel, 512, LDS_BYTES);
        (void)hipGetLastError();
        if (per_cu < 1) fprintf(stderr, "kernel_launch: occupancy query says %d\n", per_cu);
        grid = cus > 0 ? cus : 256;
    }
    if (grid < 0) return;
    Args a{};
    for (int i = 0; i < 23; ++i) a.in[i] = (const float*)d_in[i];
    a.out = (float*)d_out; a.ws = (unsigned char*)d_ws;
#if MK_N_LAUNCHES == 1
    a.ph_lo = 0; a.ph_hi = 9;
    void* args[] = {&a};
    (void)hipMemsetAsync((char*)d_ws + WS_BAR, 0, XCD_BAR_WORDS * 4, stream);
    hipError_t e = hipLaunchCooperativeKernel((const void*)fwd_megakernel, dim3(grid), dim3(512), args, LDS_BYTES, stream);
    if (e != hipSuccess) fprintf(stderr, "cooperative launch failed: %s (grid %d)\n", hipGetErrorString(e), grid);
#else
    for (int ph = 0; ph < 9; ++ph) { a.ph_lo = ph; a.ph_hi = ph + 1; hipLaunchKernelGGL(fwd_megakernel, dim3(grid), dim3(512), LDS_BYTES, stream, a); }
#endif
}
```

```cpp
#include <hip/hip_runtime.h>
#include <hip/hip_cooperative_groups.h>
#include <cstdio>
#include <cstdint>
namespace cg = cooperative_groups;

#ifndef MK_N_LAUNCHES
#define MK_N_LAUNCHES 1
#endif

#ifndef PROBE_MODE
#define PROBE_MODE 0
#endif
#define LAS __attribute__((address_space(3)))
typedef unsigned short bf16_t;
typedef short bf16x8 __attribute__((ext_vector_type(8)));
typedef short s16x4 __attribute__((ext_vector_type(4)));
typedef float f32x4 __attribute__((ext_vector_type(4)));
typedef float f32x16 __attribute__((ext_vector_type(16)));
typedef unsigned u32x4 __attribute__((ext_vector_type(4)));
typedef unsigned u32x2 __attribute__((ext_vector_type(2)));

constexpr int M = 32768, DM = 1024, SEQ = 2048, NIN = 5632, DFF = 4096, PLE = 256;
constexpr float EPS = 1e-6f;
constexpr int LDZ_RG = 2048, LDZ_QKV = 1536, LDZ_G = 2048;

constexpr size_t MiB = 1u << 20, KiB = 1u << 10;
constexpr size_t WS_SSQ0 = 0, WS_SSQ1 = 128 * KiB, WS_SSQ2 = 256 * KiB, WS_COS = 512 * KiB, WS_SIN = 768 * KiB;
constexpr size_t WS_BAR = 384 * KiB;
constexpr size_t WS_WRG = 1 * MiB, WS_WIG = 1 * MiB + 128 * KiB;
constexpr size_t WS_WIN = 2 * MiB, WS_WRNN = 13 * MiB, WS_WATT = 15 * MiB, WS_WOUT = 17 * MiB, WS_WUP = 19 * MiB, WS_WDN = 27 * MiB, WS_WGATE = 35 * MiB, WS_WPLE = 37 * MiB;
constexpr size_t WS_XB = 38 * MiB;
constexpr size_t WS_PB = 102 * MiB;
constexpr size_t WS_ZRG = 118 * MiB;
constexpr size_t WS_ZQKV = 246 * MiB;
constexpr size_t WS_ZG = 342 * MiB;
constexpr size_t WS_XC = 406 * MiB;
constexpr size_t WS_U = 118 * MiB;
constexpr size_t WS_END = 470 * MiB;

constexpr int LDS_BYTES = 147456;

__device__ __forceinline__ unsigned cvt_pk_bf16(float lo, float hi) { unsigned r; asm volatile("v_cvt_pk_bf16_f32 %0, %1, %2" : "=v"(r) : "v"(lo), "v"(hi)); return r; }
__device__ __forceinline__ float bflo(unsigned w) { return __uint_as_float(w << 16); }
__device__ __forceinline__ float bfhi(unsigned w) { return __uint_as_float(w & 0xffff0000u); }
__device__ __forceinline__ float sigm(float x) { return __builtin_amdgcn_rcpf(1.f + __builtin_amdgcn_exp2f(-1.44269504f * x)); }
__device__ __forceinline__ f32x4 exp2v(f32x4 v) { return (f32x4){__builtin_amdgcn_exp2f(v.x), __builtin_amdgcn_exp2f(v.y), __builtin_amdgcn_exp2f(v.z), __builtin_amdgcn_exp2f(v.w)}; }
__device__ __forceinline__ f32x4 rcpv(f32x4 v) { return (f32x4){__builtin_amdgcn_rcpf(v.x), __builtin_amdgcn_rcpf(v.y), __builtin_amdgcn_rcpf(v.z), __builtin_amdgcn_rcpf(v.w)}; }
__device__ __forceinline__ f32x4 maxv(f32x4 v, float lo) { return (f32x4){fmaxf(v.x, lo), fmaxf(v.y, lo), fmaxf(v.z, lo), fmaxf(v.w, lo)}; }
__device__ __forceinline__ f32x4 expnegv(f32x4 x) { return exp2v(maxv(x, -60.f) * -1.44269504f); }

namespace pg8 {
constexpr int BM = 256, BK = 64, HALF = 128, HTB = HALF * BK * 2, STAGE_BYTES = 8 * HTB, NXCD = 8, WGM = 8;
__host__ __device__ __forceinline__ int lds_byte(int r, int c) { const int st = (r >> 4) * 2 + (c >> 5), rr = r & 15, cc = c & 31, ob = rr * 64 + cc * 2; return st * 1024 + (ob ^ (((ob >> 9) & 1) << 5)); }
__host__ __device__ __forceinline__ void stage_rc(int b, int& R, int& C) { const int st = b / 1024, sb = b % 1024, swz = sb ^ (((sb >> 9) & 1) << 5); R = (st >> 1) * 16 + swz / 64; C = (st & 1) * 32 + (swz % 64) / 2; }
__host__ __device__ __forceinline__ int perm32(int rho) { const int n = rho >> 4, i = rho & 15; return 8 * (i >> 2) + 4 * n + (i & 3); }

struct Unit { int pm, pn; };
struct Gemm { const bf16_t* A; const bf16_t* Bt; int M, N, K, lda, ldb; const bf16_t* A1; const bf16_t* Bt1; int lda1; };

struct StaticOrder {
    int nM, nN, nwg, G, c, i0 = 0, imax = 1 << 30;
    __host__ __device__ void init(int M_, int N_, int G_, int c_) { nM = M_ / BM; nN = N_ / BM; nwg = nM * nN; G = G_; c = c_; }
    __host__ __device__ bool next(int i, Unit& u) const {
        if (i >= imax) return false;
        const long L = (long)(i + i0) * G + c; if (L >= nwg) return false;
        int wgid = (int)L; { const int q = nwg / NXCD, r = nwg % NXCD, xcd = wgid % NXCD, off = wgid / NXCD; wgid = (xcd < r ? xcd * (q + 1) : r * (q + 1) + (xcd - r) * q) + off; }
        const int nig = WGM * nN, gid = wgid / nig, fm = gid * WGM, gsz = (nM - fm) < WGM ? (nM - fm) : WGM;
        u.pm = fm + ((wgid % nig) % gsz); u.pn = (wgid % nig) / gsz; return true;
    }
};

template <class Epi, bool DUAL = false>
__device__ __forceinline__ void gemm_phase(LAS unsigned char* lds, const Gemm g, const StaticOrder& S, const Epi& E) {
    const int tid = threadIdx.x, wid = __builtin_amdgcn_readfirstlane(tid >> 6), lane = tid & 63, wr = wid >> 2, wc = wid & 3, fr = lane & 15, fq = lane >> 4;
    const int K = g.K, nt = K / BK;
    unsigned voffA0[2], voffA1[2], voffB[2];
#pragma unroll
    for (int i = 0; i < 2; ++i) { int R, C; stage_rc(tid * 16 + i * 8192, R, C); const int Rb = (R & ~31) + perm32(R & 31);
        voffA0[i] = (unsigned)(R * g.lda + C) * 2u; voffA1[i] = DUAL ? (unsigned)(R * g.lda1 + C) * 2u : voffA0[i]; voffB[i] = (unsigned)(Rb * g.ldb + C) * 2u; }
    const size_t kstep = (size_t)(BK * 2);
    const size_t hstepA0 = (size_t)HALF * g.lda * 2, hstepA1 = DUAL ? (size_t)HALF * g.lda1 * 2 : hstepA0, hstepB = (size_t)HALF * g.ldb * 2;
    const size_t tstepA0 = 2 * hstepA0, tstepA1 = 2 * hstepA1, tstepB = 2 * hstepB;
    const unsigned ldsw = (unsigned)wid * 1024u;
    const int aoff = lds_byte(wr * 64 + fr, fq * 8), boff = lds_byte(wc * 32 + fr, fq * 8);
#define PG8_SA(b, h) (((b) * 2 + (h)) * HTB)
#define PG8_SB(b, h) ((4 + (b) * 2 + (h)) * HTB)
#define PG8_STAGE2(bufoff, gbase, v0, v1) do { \
        __builtin_amdgcn_global_load_lds((const unsigned*)((const char*)(gbase) + (v0)), (LAS unsigned*)(lds + (bufoff) + ldsw), 16, 0, 0); \
        __builtin_amdgcn_global_load_lds((const unsigned*)((const char*)(gbase) + (v1)), (LAS unsigned*)(lds + (bufoff) + ldsw + 8192), 16, 0, 0); } while (0)
#define PG8_STAGEB(bufoff, gbase) PG8_STAGE2(bufoff, gbase, voffB[0], voffB[1])
#define PG8_LDA(dst, b, h) do { _Pragma("unroll") for (int m = 0; m < 4; ++m) _Pragma("unroll") for (int k = 0; k < 2; ++k) dst[m][k] = *(const LAS bf16x8*)(lds + PG8_SA(b, h) + aoff + m * 2048 + k * 1024); } while (0)
#define PG8_LDB(dst, b, h) do { _Pragma("unroll") for (int n = 0; n < 2; ++n) _Pragma("unroll") for (int k = 0; k < 2; ++k) dst[n][k] = *(const LAS bf16x8*)(lds + PG8_SB(b, h) + boff + n * 2048 + k * 1024); } while (0)
#define PG8_MMA(ai, bj, At, Bt) do { __builtin_amdgcn_s_setprio(1); _Pragma("unroll") for (int m = 0; m < 4; ++m) _Pragma("unroll") for (int n = 0; n < 2; ++n) _Pragma("unroll") for (int k = 0; k < 2; ++k) \
        acc[ai][bj][m][n] = __builtin_amdgcn_mfma_f32_16x16x32_bf16(Bt[n][k], At[m][k], acc[ai][bj][m][n], 0, 0, 0); __builtin_amdgcn_s_setprio(0); } while (0)
#define PG8_WAIT_V(n) asm volatile("s_waitcnt vmcnt(" #n ")" ::: "memory")
#define PG8_WAIT_L(n) asm volatile("s_waitcnt lgkmcnt(" #n ")" ::: "memory")
#define PG8_BAR __builtin_amdgcn_s_barrier()
#define PG8_SCHED __builtin_amdgcn_sched_barrier(0)
    Unit cur, nxt; int ui = 0;
    if (!S.next(0, cur)) return;
    f32x4 acc[2][2][4][2];
#pragma unroll
    for (int a = 0; a < 2; ++a)
#pragma unroll
        for (int b = 0; b < 2; ++b)
#pragma unroll
            for (int m = 0; m < 4; ++m)
#pragma unroll
                for (int n = 0; n < 2; ++n) acc[a][b][m][n] = (f32x4){0.f, 0.f, 0.f, 0.f};
    bf16x8 At[4][2], B0[2][2], B1[2][2];
    const char* cA = (const char*)g.A + (size_t)cur.pm * tstepA0; const char* cB = (const char*)g.Bt + (size_t)cur.pn * tstepB;
    PG8_STAGEB(PG8_SB(0, 0), cB); PG8_STAGEB(PG8_SB(0, 1), cB + hstepB); PG8_STAGE2(PG8_SA(0, 0), cA, voffA0[0], voffA0[1]); PG8_STAGE2(PG8_SA(0, 1), cA + hstepA0, voffA0[0], voffA0[1]);
    if (wr == 1) PG8_BAR;
    PG8_WAIT_V(2); PG8_BAR;
    PG8_STAGEB(PG8_SB(1, 0), cB + kstep); PG8_STAGE2(PG8_SA(1, 0), cA + kstep, voffA0[0], voffA0[1]); PG8_STAGEB(PG8_SB(1, 1), cB + hstepB + kstep);
    PG8_WAIT_V(6); PG8_BAR;
    for (;;) {
        const bool has_next = S.next(ui + 1, nxt);
#pragma unroll
        for (int sg = 0; sg < (DUAL ? 2 : 1); ++sg) {
            const bool to_seg1 = DUAL && sg == 0;
            const unsigned vc0 = sg ? voffA1[0] : voffA0[0], vc1 = sg ? voffA1[1] : voffA0[1]; const size_t hc = sg ? hstepA1 : hstepA0;
            const char* nA; const char* nB; unsigned vn0, vn1; size_t hn;
            if (to_seg1) { nA = (const char*)g.A1 + (size_t)cur.pm * tstepA1; nB = (const char*)g.Bt1 + (size_t)cur.pn * tstepB; vn0 = voffA1[0]; vn1 = voffA1[1]; hn = hstepA1; }
            else if (has_next) { nA = (const char*)g.A + (size_t)nxt.pm * tstepA0; nB = (const char*)g.Bt + (size_t)nxt.pn * tstepB; vn0 = voffA0[0]; vn1 = voffA0[1]; hn = hstepA0; }
            else { nA = cA; nB = cB; vn0 = vc0; vn1 = vc1; hn = hc; }
            for (int t = 0; t < nt; t += 2) {
                const bool last = (t == nt - 2);
                const char* a1 = cA + (size_t)(t + 1) * kstep;
                const char* a2 = last ? nA : cA + (size_t)(t + 2) * kstep; const char* b2 = last ? nB : cB + (size_t)(t + 2) * kstep;
                const char* a3 = a2 + kstep; const char* b3 = b2 + kstep;
                const unsigned vx0 = last ? vn0 : vc0, vx1 = last ? vn1 : vc1; const size_t hx = last ? hn : hc;
                PG8_LDB(B0, 0, 0); PG8_LDB(B1, 0, 1); PG8_SCHED; PG8_LDA(At, 0, 0); PG8_STAGE2(PG8_SA(1, 1), a1 + hc, vc0, vc1);
                PG8_WAIT_V(8); PG8_WAIT_L(0); PG8_BAR; PG8_MMA(0, 0, At, B0); PG8_MMA(0, 1, At, B1); PG8_BAR; PG8_SCHED;
                PG8_LDA(At, 0, 1); PG8_STAGEB(PG8_SB(0, 0), b2); PG8_STAGEB(PG8_SB(0, 1), b2 + hstepB); PG8_STAGE2(PG8_SA(0, 0), a2, vx0, vx1);
                PG8_WAIT_V(8); PG8_WAIT_L(0); PG8_BAR; PG8_MMA(1, 0, At, B0); PG8_MMA(1, 1, At, B1); PG8_BAR; PG8_SCHED;
                PG8_LDB(B0, 1, 0); PG8_LDB(B1, 1, 1); PG8_SCHED; PG8_LDA(At, 1, 0); PG8_STAGE2(PG8_SA(0, 1), a2 + hx, vx0, vx1);
                PG8_WAIT_V(8); PG8_WAIT_L(0); PG8_BAR; PG8_MMA(0, 0, At, B0); PG8_MMA(0, 1, At, B1); PG8_BAR; PG8_SCHED;
                PG8_LDA(At, 1, 1); PG8_STAGEB(PG8_SB(1, 0), b3); PG8_STAGEB(PG8_SB(1, 1), b3 + hstepB); PG8_STAGE2(PG8_SA(1, 0), a3, vx0, vx1);
                PG8_WAIT_V(8); PG8_WAIT_L(0); PG8_BAR; PG8_MMA(1, 0, At, B0); PG8_MMA(1, 1, At, B1); PG8_BAR; PG8_SCHED;
            }
            if constexpr (DUAL) { if (sg == 0) { PG8_SCHED; E.mid(acc, cur, wr, wc, fr, fq); PG8_SCHED; } }
            cA = nA; cB = nB;
        }
        if (wr == 0) PG8_BAR;
        E(acc, cur, wr, wc, fr, fq);
        if (!has_next) break;
        bf16x8 zfrag = {0, 0, 0, 0, 0, 0, 0, 0}; asm volatile("" : "+v"(zfrag));
#pragma unroll
        for (int a = 0; a < 2; ++a)
#pragma unroll
            for (int b = 0; b < 2; ++b)
#pragma unroll
                for (int m = 0; m < 4; ++m)
#pragma unroll
                    for (int n = 0; n < 2; ++n) acc[a][b][m][n] = __builtin_amdgcn_mfma_f32_16x16x32_bf16(zfrag, zfrag, (f32x4){0.f, 0.f, 0.f, 0.f}, 0, 0, 0);
        cur = nxt; ++ui;
        if (wr == 1) PG8_BAR;
    }
    PG8_WAIT_V(0);
    PG8_BAR;
#undef PG8_SA
#undef PG8_SB
#undef PG8_STAGE2
#undef PG8_STAGEB
#undef PG8_LDA
#undef PG8_LDB
#undef PG8_MMA
#undef PG8_WAIT_V
#undef PG8_WAIT_L
#undef PG8_BAR
#undef PG8_SCHED
}
}

typedef f32x4 AccT[2][2][4][2];
#define EPI_LOOP_ROWS  _Pragma("unroll") for (int ai = 0; ai < 2; ++ai) _Pragma("unroll") for (int m = 0; m < 4; ++m)
__device__ __forceinline__ u32x4 pack8(f32x4 v0, f32x4 v1) { u32x4 w; w.x = cvt_pk_bf16(v0[0], v0[1]); w.y = cvt_pk_bf16(v0[2], v0[3]); w.z = cvt_pk_bf16(v1[0], v1[1]); w.w = cvt_pk_bf16(v1[2], v1[3]); return w; }
__device__ __forceinline__ void unpack8(u32x4 w, f32x4& v0, f32x4& v1) { v0 = (f32x4){bflo(w.x), bfhi(w.x), bflo(w.y), bfhi(w.y)}; v1 = (f32x4){bflo(w.z), bfhi(w.z), bflo(w.w), bfhi(w.w)}; }

#define EPI_M _Pragma("unroll") for (int m = 0; m < 4; ++m)
#define EPI_BJ _Pragma("unroll") for (int bj = 0; bj < 2; ++bj)
struct EpiIn {
    bf16_t *zrg, *zqkv, *zg; const float* ssq;
    __device__ __forceinline__ void operator()(const AccT& acc, const pg8::Unit& u, int wr, int wc, int fr, int fq) const {
        bf16_t* base; int ld, colt;
        if (u.pn < 8) { base = zrg; ld = LDZ_RG; colt = u.pn * 256; } else if (u.pn < 14) { base = zqkv; ld = LDZ_QKV; colt = (u.pn - 8) * 256; } else { base = zg; ld = LDZ_G; colt = (u.pn - 14) * 256; }
        const int row0 = u.pm * 256 + wr * 64 + fr, col0 = colt + wc * 32 + 8 * fq;
        float sv[2][4];
        EPI_LOOP_ROWS sv[ai][m] = ssq[row0 + ai * 128 + m * 16];
        EPI_LOOP_ROWS { const int row = row0 + ai * 128 + m * 16; const float s = __builtin_amdgcn_rsqf(sv[ai][m] * (1.f / DM) + EPS); bf16_t* rowp = base + (size_t)row * ld + col0;
            EPI_BJ *(u32x4*)(rowp + bj * 128) = pack8(acc[ai][bj][m][0] * s, acc[ai][bj][m][1] * s); }
    }
};
struct EpiMerge {
    const bf16_t* ga; const bf16_t* gb; int ldg; bf16_t* O; int ldo;
    __device__ __forceinline__ void mid(AccT& acc, const pg8::Unit& u, int wr, int wc, int fr, int fq) const {
        int row0 = u.pm * 256 + wr * 64 + fr, col0 = u.pn * 256 + wc * 32 + 8 * fq;
        asm volatile("" : "+v"(row0), "+v"(col0));
        u32x4 av[2][2][2], bv[2][2][2];
#pragma unroll
        for (int b = 0; b < 5; ++b) {
            if (b < 4) {
#pragma unroll
                for (int mm = 0; mm < 2; ++mm) EPI_BJ { const size_t off = (size_t)(row0 + (b >> 1) * 128 + (2 * (b & 1) + mm) * 16) * ldg + col0 + bj * 128; av[b & 1][mm][bj] = *(const u32x4*)(ga + off); bv[b & 1][mm][bj] = *(const u32x4*)(gb + off); }
            }
            if (b >= 1) { const int c = b - 1, ai = c >> 1;
#pragma unroll
                for (int mm = 0; mm < 2; ++mm) { const int m = 2 * (c & 1) + mm;
                    EPI_BJ { f32x4 a0, a1, b0, b1; unpack8(av[c & 1][mm][bj], a0, a1); unpack8(bv[c & 1][mm][bj], b0, b1);
                        acc[ai][bj][m][0] *= (expnegv(b0) + 1.f) * rcpv(exp2v(a0 * -1.44269504f) + 1.f);
                        acc[ai][bj][m][1] *= (expnegv(b1) + 1.f) * rcpv(exp2v(a1 * -1.44269504f) + 1.f); }
                    asm volatile("" : "+v"(acc[ai][0][m][0]), "+v"(acc[ai][0][m][1]), "+v"(acc[ai][1][m][0]), "+v"(acc[ai][1][m][1]) :: "memory"); }
            }
        }
    }
    __device__ __forceinline__ void operator()(const AccT& acc, const pg8::Unit& u, int wr, int wc, int fr, int fq) const {
        const int row0 = u.pm * 256 + wr * 64 + fr, col0 = u.pn * 256 + wc * 32 + 8 * fq;
        u32x4 bv[2][4][2];
        EPI_LOOP_ROWS EPI_BJ bv[ai][m][bj] = *(const u32x4*)(gb + (size_t)(row0 + ai * 128 + m * 16) * ldg + col0 + bj * 128);
        EPI_LOOP_ROWS EPI_BJ { f32x4 b0, b1; unpack8(bv[ai][m][bj], b0, b1);
            const f32x4 v0 = acc[ai][bj][m][0] * rcpv(expnegv(b0) + 1.f), v1 = acc[ai][bj][m][1] * rcpv(expnegv(b1) + 1.f);
            *(u32x4*)(O + (size_t)(row0 + ai * 128 + m * 16) * ldo + col0 + bj * 128) = pack8(v0, v1); }
    }
};
template <int NB  > struct EpiRes {
    const bf16_t* rbf; bf16_t* xb; float* ssq;
    __device__ __forceinline__ void operator()(const AccT& acc, const pg8::Unit& u, int wr, int wc, int fr, int fq) const {
        const int row0 = u.pm * 256 + wr * 64 + fr, col0 = u.pn * 256 + wc * 32 + 8 * fq;
#pragma unroll
        for (int h = 0; h < NB; ++h) {
            u32x4 rb[2][4][2];
#pragma unroll
            for (int ai = (NB == 2 ? h : 0); ai < (NB == 2 ? h + 1 : 2); ++ai) EPI_M EPI_BJ rb[ai][m][bj] = *(const u32x4*)(rbf + (size_t)(row0 + ai * 128 + m * 16) * DM + col0 + bj * 128);
#pragma unroll
            for (int ai = (NB == 2 ? h : 0); ai < (NB == 2 ? h + 1 : 2); ++ai) EPI_M { const int row = row0 + ai * 128 + m * 16; float sq = 0.f;
                EPI_BJ { const size_t off = (size_t)row * DM + col0 + bj * 128; f32x4 r0, r1; unpack8(rb[ai][m][bj], r0, r1);
                    const f32x4 v0 = acc[ai][bj][m][0] + r0, v1 = acc[ai][bj][m][1] + r1;
                    *(u32x4*)(xb + off) = pack8(v0, v1);
                    const f32x4 q4 = v0 * v0 + v1 * v1; sq += (q4[0] + q4[1]) + (q4[2] + q4[3]); }
                sq += __shfl_xor(sq, 16); sq += __shfl_xor(sq, 32);
                if (fq == 0) unsafeAtomicAdd(ssq + row, sq); }
        }
    }
};
struct EpiUp {
    const float* ssq; bf16_t* O;
    __device__ __forceinline__ void operator()(const AccT& acc, const pg8::Unit& u, int wr, int wc, int fr, int fq) const {
        const int row0 = u.pm * 256 + wr * 64 + fr, col0 = u.pn * 256 + wc * 32 + 8 * fq;
        float sv[2][4];
        EPI_LOOP_ROWS sv[ai][m] = ssq[row0 + ai * 128 + m * 16];
        EPI_LOOP_ROWS { const int row = row0 + ai * 128 + m * 16; const float s = __builtin_amdgcn_rsqf(sv[ai][m] * (1.f / DM) + EPS);
            EPI_BJ { const f32x4 r0 = maxv(acc[ai][bj][m][0] * s, 0.f), r1 = maxv(acc[ai][bj][m][1] * s, 0.f);
                *(u32x4*)(O + (size_t)row * DFF + col0 + bj * 128) = pack8(r0 * r0, r1 * r1); } }
    }
};
struct EpiPlain {
    bf16_t* O;
    __device__ __forceinline__ void operator()(const AccT& acc, const pg8::Unit& u, int wr, int wc, int fr, int fq) const {
        const int row0 = u.pm * 256 + wr * 64 + fr, col0 = u.pn * 256 + wc * 32 + 8 * fq;
        EPI_LOOP_ROWS { const int row = row0 + ai * 128 + m * 16;
            EPI_BJ *(u32x4*)(O + (size_t)row * DM + col0 + bj * 128) = pack8(acc[ai][bj][m][0], acc[ai][bj][m][1]); }
    }
};
struct EpiFinal {
    const float* ssq; const bf16_t* Eb; const bf16_t* xin; float* out;
    __device__ __forceinline__ void operator()(const AccT& acc, const pg8::Unit& u, int wr, int wc, int fr, int fq) const {
        const int row0 = u.pm * 256 + wr * 64 + fr, col0 = u.pn * 256 + wc * 32 + 8 * fq;
        float sv[2][4];
        EPI_LOOP_ROWS sv[ai][m] = ssq[row0 + ai * 128 + m * 16];
        u32x4 xv[2][2][2], ev[2][2][2];
#pragma unroll
        for (int b = 0; b < 5; ++b) {
            if (b < 4) {
#pragma unroll
                for (int mm = 0; mm < 2; ++mm) EPI_BJ { const size_t off = (size_t)(row0 + (b >> 1) * 128 + (2 * (b & 1) + mm) * 16) * DM + col0 + bj * 128; xv[b & 1][mm][bj] = *(const u32x4*)(xin + off); ev[b & 1][mm][bj] = *(const u32x4*)(Eb + off); }
            }
            if (b >= 1) { const int c = b - 1, ai = c >> 1;
#pragma unroll
                for (int mm = 0; mm < 2; ++mm) { const int m = 2 * (c & 1) + mm; const float sc = __builtin_amdgcn_rsqf(sv[ai][m] * (1.f / DM) + EPS);
                    EPI_BJ { const size_t off = (size_t)(row0 + ai * 128 + m * 16) * DM + col0 + bj * 128; f32x4 e0, e1, v0, v1; unpack8(ev[c & 1][mm][bj], e0, e1); unpack8(xv[c & 1][mm][bj], v0, v1);
                        const float nsc = -1.44269504f * sc;
                        v0 += e0 * rcpv(exp2v(acc[ai][bj][m][0] * nsc) + 1.f); v1 += e1 * rcpv(exp2v(acc[ai][bj][m][1] * nsc) + 1.f);
                        __builtin_nontemporal_store(v0, (f32x4*)(out + off)); __builtin_nontemporal_store(v1, (f32x4*)(out + off + 4)); } }
            }
        }
    }
};

__device__ __forceinline__ float wave_sum(float v) {
#pragma unroll
    for (int o = 1; o < 64; o <<= 1) v += __shfl_xor(v, o);
    return v;
}
__device__ __forceinline__ void p0_transpose_item(const float* W, int K, int N, bf16_t* WT, const float* g, LAS float* scr, int item, int lane) {
    const int nblk = N / 32, kb = item / nblk, nb = item % nblk, k0 = 64 * kb, n0 = 32 * nb;
#pragma unroll
    for (int i = 0; i < 32; ++i) { const int kk = 2 * i + (lane >> 5); const float gv = g ? g[k0 + kk] : 1.f; scr[kk * 33 + (lane & 31)] = __builtin_nontemporal_load(W + (size_t)(k0 + kk) * N + n0 + (lane & 31)) * gv; }
    asm volatile("s_waitcnt lgkmcnt(0)" ::: "memory");
    const int c = lane & 7;
#pragma unroll
    for (int j = 0; j < 4; ++j) { const int n = (lane >> 3) + 8 * j; const LAS float* s = scr + (8 * c) * 33 + n;
        u32x4 o; o.x = cvt_pk_bf16(s[0 * 33], s[1 * 33]); o.y = cvt_pk_bf16(s[2 * 33], s[3 * 33]); o.z = cvt_pk_bf16(s[4 * 33], s[5 * 33]); o.w = cvt_pk_bf16(s[6 * 33], s[7 * 33]);
        *(u32x4*)(WT + (size_t)(n0 + n) * K + k0 + 8 * c) = o; }
    asm volatile("s_waitcnt lgkmcnt(0)" ::: "memory");
}

struct Args { const float* in[23]; float* out; unsigned char* ws; int ph_lo, ph_hi; };
enum { I_X = 0, I_P, I_GMIX, I_WIN, I_CONVW, I_CONVB, I_WRG, I_BRG, I_WIG, I_BIG, I_LAM, I_WRNN, I_QG, I_KG, I_SINK, I_WATT, I_WOUT, I_GMLP, I_WUP, I_WDN, I_GPLE, I_WGATE, I_WPLE };

__device__ __forceinline__ void convert_p(const Args& a, int G) {
    const int gt = blockIdx.x * 512 + threadIdx.x, NT = G * 512;
    const f32x4* p4 = (const f32x4*)a.in[I_P]; u32x2* pb = (u32x2*)(a.ws + WS_PB);
    for (int i = gt; i < M * PLE / 4; i += 4 * NT) { f32x4 v[4];
#pragma unroll
        for (int q = 0; q < 4; ++q) v[q] = (i + q * NT < M * PLE / 4) ? __builtin_nontemporal_load(p4 + i + q * NT) : (f32x4){0.f, 0.f, 0.f, 0.f};
#pragma unroll
        for (int q = 0; q < 4; ++q) if (i + q * NT < M * PLE / 4) { u32x2 w; w.x = cvt_pk_bf16(v[q].x, v[q].y); w.y = cvt_pk_bf16(v[q].z, v[q].w); __builtin_nontemporal_store(w, pb + i + q * NT); } }
}

enum { WJ_IN = 1, WJ_RNN = 2, WJ_ATT = 4, WJ_OUT = 8, WJ_UP = 16, WJ_DN = 32, WJ_GATE = 64, WJ_PLE = 128, WJ_RG = 256, WJ_IG = 512 };
template <unsigned MASK> __device__ __forceinline__ void convert_weights(const Args& a, LAS unsigned char* lds, int G) {
    const int tid = threadIdx.x, lane = tid & 63, wave = tid >> 6;
    unsigned char* ws = a.ws;
    LAS float* scr = (LAS float*)(lds + wave * 16384);
    const int gw = blockIdx.x * 8 + wave, NGW = G * 8;
    constexpr int N0 = (DM / 64) * (NIN / 32), N1 = (DM / 64) * (DM / 32), N5 = (DM / 64) * (DFF / 32), N6 = (DFF / 64) * (DM / 32), N8 = (PLE / 64) * (DM / 32), N9 = 32;
    constexpr int C_IN = (MASK & WJ_IN) ? N0 : 0, C_RNN = (MASK & WJ_RNN) ? N1 : 0, C_ATT = (MASK & WJ_ATT) ? N1 : 0, C_OUT = (MASK & WJ_OUT) ? N1 : 0, C_UP = (MASK & WJ_UP) ? N5 : 0,
                  C_DN = (MASK & WJ_DN) ? N6 : 0, C_GATE = (MASK & WJ_GATE) ? N1 : 0, C_PLE = (MASK & WJ_PLE) ? N8 : 0, C_RG = (MASK & WJ_RG) ? N9 : 0, C_IG = (MASK & WJ_IG) ? N9 : 0;
    constexpr int NITEMS = C_IN + C_RNN + C_ATT + C_OUT + C_UP + C_DN + C_GATE + C_PLE + C_RG + C_IG;
    for (int it = gw; it < NITEMS; it += NGW) {
        int r = it;
        if (r < C_IN) { p0_transpose_item(a.in[I_WIN], DM, NIN, (bf16_t*)(ws + WS_WIN), a.in[I_GMIX], scr, r, lane); continue; } r -= C_IN;
        if (r < C_RNN) { p0_transpose_item(a.in[I_WRNN], DM, DM, (bf16_t*)(ws + WS_WRNN), nullptr, scr, r, lane); continue; } r -= C_RNN;
        if (r < C_ATT) { p0_transpose_item(a.in[I_WATT], DM, DM, (bf16_t*)(ws + WS_WATT), nullptr, scr, r, lane); continue; } r -= C_ATT;
        if (r < C_OUT) { p0_transpose_item(a.in[I_WOUT], DM, DM, (bf16_t*)(ws + WS_WOUT), nullptr, scr, r, lane); continue; } r -= C_OUT;
        if (r < C_UP) { p0_transpose_item(a.in[I_WUP], DM, DFF, (bf16_t*)(ws + WS_WUP), a.in[I_GMLP], scr, r, lane); continue; } r -= C_UP;
        if (r < C_DN) { p0_transpose_item(a.in[I_WDN], DFF, DM, (bf16_t*)(ws + WS_WDN), nullptr, scr, r, lane); continue; } r -= C_DN;
        if (r < C_GATE) { p0_transpose_item(a.in[I_WGATE], DM, DM, (bf16_t*)(ws + WS_WGATE), a.in[I_GPLE], scr, r, lane); continue; } r -= C_GATE;
        if (r < C_PLE) { p0_transpose_item(a.in[I_WPLE], PLE, DM, (bf16_t*)(ws + WS_WPLE), nullptr, scr, r, lane); continue; } r -= C_PLE;
        if (r < C_RG) { p0_transpose_item(a.in[I_WRG] + (size_t)(r >> 1) * 4096, 64, 64, (bf16_t*)(ws + WS_WRG) + (size_t)(r >> 1) * 4096, nullptr, scr, r & 1, lane); continue; } r -= C_RG;
        if (r < C_IG) p0_transpose_item(a.in[I_WIG] + (size_t)(r >> 1) * 4096, 64, 64, (bf16_t*)(ws + WS_WIG) + (size_t)(r >> 1) * 4096, nullptr, scr, r & 1, lane);
    }
}

__device__ __forceinline__ void p0_prologue(const Args& a, LAS unsigned char* lds, int G) {
    const int tid = threadIdx.x, lane = tid & 63, wave = tid >> 6;
    unsigned char* ws = a.ws;
    const int gw = blockIdx.x * 8 + wave, NGW = G * 8;
    convert_weights<WJ_IN>(a, lds, G);
    const float* x = a.in[I_X]; bf16_t* XB = (bf16_t*)(ws + WS_XB); float* ssq0 = (float*)(ws + WS_SSQ0);
    for (int m4 = gw * 4; m4 < M; m4 += NGW * 4) {
        f32x4 v[4][4];
#pragma unroll
        for (int r = 0; r < 4; ++r) { const f32x4* xr = (const f32x4*)(x + (size_t)(m4 + r) * DM) + lane;
#pragma unroll
            for (int j = 0; j < 4; ++j) v[r][j] = __builtin_nontemporal_load(xr + 64 * j); }
#pragma unroll
        for (int r = 0; r < 4; ++r) { float s = 0.f;
#pragma unroll
            for (int j = 0; j < 4; ++j) s += (v[r][j].x * v[r][j].x + v[r][j].y * v[r][j].y) + (v[r][j].z * v[r][j].z + v[r][j].w * v[r][j].w);
            s = wave_sum(s); if (lane == 0) ssq0[m4 + r] = s;
            u32x2* o8 = (u32x2*)(XB + (size_t)(m4 + r) * DM) + lane;
#pragma unroll
            for (int j = 0; j < 4; ++j) { u32x2 w; w.x = cvt_pk_bf16(v[r][j].x, v[r][j].y); w.y = cvt_pk_bf16(v[r][j].z, v[r][j].w); o8[64 * j] = w; } }
    }
}
__device__ __forceinline__ void setup_misc(const Args& a, int G) {
    unsigned char* ws = a.ws;
    const int gt = blockIdx.x * 512 + threadIdx.x, NT = G * 512;
    { float* s1 = (float*)(ws + WS_SSQ1); float* s2 = (float*)(ws + WS_SSQ2); for (int i = gt; i < M; i += NT) { s1[i] = 0.f; s2[i] = 0.f; } }
    { float* ct = (float*)(ws + WS_COS); float* st = (float*)(ws + WS_SIN);
      for (int i = gt; i < SEQ * 32; i += NT) { const int pos = i >> 5, k = i & 31; const float inv = exp2f(-(float)k * 0.41524101186092029f); const float ang = (float)pos * inv; ct[i] = cosf(ang); st[i] = sinf(ang); } }
}

constexpr int R_XS = 0, R_GS = 18432, R_XCB = 36864, R_WR = 46080, R_WI = 55296, R_AF = 64512, R_BI = 81920, R_SEGP = 99328, R_SEGH = 101376, R_CARRY = 103424;
constexpr int RP = 144;
constexpr int FP = 68;
__device__ __forceinline__ void rnn_item(LAS unsigned char* lds, int item, const Args& a, bf16_t* yo, int ldy) {
    const int tid = threadIdx.x, lane = tid & 63, w = __builtin_amdgcn_readfirstlane(tid >> 6);
    const int b = item >> 4, blk = item & 15, c0 = blk * 64;
    bf16_t* zrg = (bf16_t*)(a.ws + WS_ZRG);
    const int c = lane, seg = w;
    const int lrow = tid >> 3, lpiece = tid & 7;
    { const bf16_t* wr = (const bf16_t*)(a.ws + WS_WRG) + blk * 4096; const bf16_t* wi = (const bf16_t*)(a.ws + WS_WIG) + blk * 4096;
      *(LAS u32x4*)(lds + R_WR + lrow * RP + lpiece * 16) = *(const u32x4*)(wr + lrow * 64 + lpiece * 8);
      *(LAS u32x4*)(lds + R_WI + lrow * RP + lpiece * 16) = *(const u32x4*)(wi + lrow * 64 + lpiece * 8); }
    const int ch = c0 + c;
    const float cw0 = a.in[I_CONVW][ch], cw1 = a.in[I_CONVW][1024 + ch], cw2 = a.in[I_CONVW][2048 + ch], cw3 = a.in[I_CONVW][3072 + ch], cb = a.in[I_CONVB][ch];
    float ebr[2], ebi[2], ec8[2];
#pragma unroll
    for (int q = 0; q < 2; ++q) { const int che = c0 + 16 * (2 * (w & 1) + q) + (lane & 15); ebr[q] = -1.44269504f * a.in[I_BRG][che]; ebi[q] = -1.44269504f * a.in[I_BIG][che]; ec8[q] = 1.44269504f * 8.f * log1pf(expf(-a.in[I_LAM][che])); }
    const size_t rowbase = (size_t)b * SEQ;
    const bf16_t* gx = zrg + (rowbase + lrow) * LDZ_RG + c0 + lpiece * 8;
    u32x4 xpre = *(const u32x4*)gx, gpre = *(const u32x4*)(gx + 1024);
    const int mt = w >> 1;
    for (int ci = 0; ci < SEQ / 64; ++ci) {
        const int cur = ci & 1;
        LAS unsigned char* XS = lds + R_XS + cur * 9216; LAS unsigned char* XSP = lds + R_XS + (cur ^ 1) * 9216; LAS unsigned char* GS = lds + R_GS + cur * 9216;
        *(LAS u32x4*)(XS + lrow * RP + lpiece * 16) = xpre; *(LAS u32x4*)(GS + lrow * RP + lpiece * 16) = gpre;
        if (ci + 1 < SEQ / 64) { const bf16_t* gn = gx + (size_t)(ci + 1) * 64 * LDZ_RG; xpre = *(const u32x4*)gn; gpre = *(const u32x4*)(gn + 1024); }
        __syncthreads();
        float xv[11];
#pragma unroll
        for (int k = 0; k < 11; ++k) { const int rr = seg * 8 - 3 + k;
            if (rr >= 0) xv[k] = __uint_as_float((unsigned)*(const LAS unsigned short*)(XS + rr * RP + c * 2) << 16);
            else xv[k] = (ci > 0) ? __uint_as_float((unsigned)*(const LAS unsigned short*)(XSP + (64 + rr) * RP + c * 2) << 16) : 0.f; }
        float xc[8];
#pragma unroll
        for (int j = 0; j < 8; ++j) { xc[j] = (((cb + xv[j] * cw0) + xv[j + 1] * cw1) + xv[j + 2] * cw2) + xv[j + 3] * cw3;
            *(LAS unsigned short*)(lds + R_XCB + (seg * 8 + j) * RP + c * 2) = (unsigned short)(cvt_pk_bf16(xc[j], 0.f) & 0xffffu); }
        __syncthreads();
        {
            bf16x8 af[2];
#pragma unroll
            for (int ks = 0; ks < 2; ++ks) af[ks] = *(const LAS bf16x8*)(lds + R_XCB + (16 * mt + (lane & 15)) * RP + ks * 64 + (lane >> 4) * 16);
#pragma unroll
            for (int q = 0; q < 2; ++q) { const int nt = 2 * (w & 1) + q;
                f32x4 ar = (f32x4){0.f, 0.f, 0.f, 0.f}, ai = (f32x4){0.f, 0.f, 0.f, 0.f};
#pragma unroll
                for (int ks = 0; ks < 2; ++ks) { const int boff = (16 * nt + (lane & 15)) * RP + ks * 64 + (lane >> 4) * 16;
                    ar = __builtin_amdgcn_mfma_f32_16x16x32_bf16(af[ks], *(const LAS bf16x8*)(lds + R_WR + boff), ar, 0, 0, 0);
                    ai = __builtin_amdgcn_mfma_f32_16x16x32_bf16(af[ks], *(const LAS bf16x8*)(lds + R_WI + boff), ai, 0, 0, 0); }
#pragma unroll
                for (int e = 0; e < 4; e += 2) { const int t = 16 * mt + 4 * (lane >> 4) + e, cc = 16 * nt + (lane & 15);
                    typedef float f32x2 __attribute__((ext_vector_type(2)));
                    const f32x2 tr = (f32x2){ar[e], ar[e + 1]} * -1.44269504f + ebr[q], ti = (f32x2){ai[e], ai[e + 1]} * -1.44269504f + ebi[q];
                    const f32x2 dr = (f32x2){__builtin_amdgcn_exp2f(tr.x), __builtin_amdgcn_exp2f(tr.y)} + 1.f, di = (f32x2){__builtin_amdgcn_exp2f(ti.x), __builtin_amdgcn_exp2f(ti.y)} + 1.f;
                    const f32x2 r = {__builtin_amdgcn_rcpf(dr.x), __builtin_amdgcn_rcpf(dr.y)}, ig = {__builtin_amdgcn_rcpf(di.x), __builtin_amdgcn_rcpf(di.y)};
                    const f32x2 la2 = r * -ec8[q];
                    const f32x2 av = {__builtin_amdgcn_exp2f(la2.x), __builtin_amdgcn_exp2f(la2.y)};
                    const f32x2 m2 = 1.f - av * av;
                    const f32x2 bi = (f32x2){__builtin_amdgcn_sqrtf(m2.x), __builtin_amdgcn_sqrtf(m2.y)} * ig;
                    ((LAS float*)(lds + R_AF))[t * FP + cc] = av.x; ((LAS float*)(lds + R_AF))[(t + 1) * FP + cc] = av.y;
                    ((LAS float*)(lds + R_BI))[t * FP + cc] = bi.x; ((LAS float*)(lds + R_BI))[(t + 1) * FP + cc] = bi.y; } }
        }
        __syncthreads();
        float av[8], bv[8]; float P = 1.f, h = 0.f;
#pragma unroll
        for (int j = 0; j < 8; ++j) { av[j] = ((const LAS float*)(lds + R_AF))[(seg * 8 + j) * FP + c]; bv[j] = ((const LAS float*)(lds + R_BI))[(seg * 8 + j) * FP + c] * xc[j]; h = av[j] * h + bv[j]; P *= av[j]; }
        ((LAS float*)(lds + R_SEGP))[seg * 64 + c] = P; ((LAS float*)(lds + R_SEGH))[seg * 64 + c] = h;
        __syncthreads();
        float hin = (ci > 0) ? ((const LAS float*)(lds + R_CARRY))[cur * 64 + c] : 0.f;
        for (int s = 0; s < seg; ++s) hin = ((const LAS float*)(lds + R_SEGP))[s * 64 + c] * hin + ((const LAS float*)(lds + R_SEGH))[s * 64 + c];
        h = hin;
        float hv[8];
#pragma unroll
        for (int j = 0; j < 8; ++j) { h = av[j] * h + bv[j]; hv[j] = h; }
#pragma unroll
        for (int j = 0; j < 8; j += 2) { typedef float f32x2 __attribute__((ext_vector_type(2)));
            const f32x2 gg = {__uint_as_float((unsigned)*(const LAS unsigned short*)(GS + (seg * 8 + j) * RP + c * 2) << 16), __uint_as_float((unsigned)*(const LAS unsigned short*)(GS + (seg * 8 + j + 1) * RP + c * 2) << 16)};
            const f32x2 wq = gg * (gg * gg * -0.10294324f + -2.3022082f);
            const f32x2 dn = (f32x2){__builtin_amdgcn_exp2f(wq.x), __builtin_amdgcn_exp2f(wq.y)} + 1.f;
            const f32x2 y = (f32x2){hv[j], hv[j + 1]} * gg * (f32x2){__builtin_amdgcn_rcpf(dn.x), __builtin_amdgcn_rcpf(dn.y)};
            *(LAS unsigned short*)(lds + R_XCB + (seg * 8 + j) * RP + c * 2) = (unsigned short)(cvt_pk_bf16(y.x, 0.f) & 0xffffu);
            *(LAS unsigned short*)(lds + R_XCB + (seg * 8 + j + 1) * RP + c * 2) = (unsigned short)(cvt_pk_bf16(y.y, 0.f) & 0xffffu); }
        if (seg == 7) ((LAS float*)(lds + R_CARRY))[(cur ^ 1) * 64 + c] = h;
        __syncthreads();
        *(u32x4*)(yo + (rowbase + (size_t)ci * 64 + lrow) * ldy + c0 + lpiece * 8) = *(const LAS u32x4*)(lds + R_XCB + lrow * RP + lpiece * 16);
    }
    __syncthreads();
}

constexpr int A_K = 0, A_V = 36864, KP = 144, VP = 520;
__device__ __forceinline__ void attn_kv_load(int item, const bf16_t* zq, int tid, u32x4 (&kr)[4], u32x2 (&vr)[8]) {
    const int b = item >> 6, n = (item >> 2) & 15, kvh = item & 3;
    const int key = tid >> 1, half = tid & 1; const int pos = (n - 1) * 128 + key;
    if (pos >= 0) {
        const bf16_t* kp = zq + (size_t)(b * SEQ + pos) * LDZ_QKV + 1024 + kvh * 64 + 16 * half;
        kr[0] = *(const u32x4*)kp; kr[1] = *(const u32x4*)(kp + 8); kr[2] = *(const u32x4*)(kp + 32); kr[3] = *(const u32x4*)(kp + 40);
    } else {
        const u32x4 z = (u32x4){0u, 0u, 0u, 0u};
#pragma unroll
        for (int i = 0; i < 4; ++i) kr[i] = z;
    }
    const int kp2 = tid >> 2, dq = tid & 3; const int vpos = (n - 1) * 128 + 2 * kp2;
    if (vpos >= 0) {
        const bf16_t* vp = zq + (size_t)(b * SEQ + vpos) * LDZ_QKV + 1280 + kvh * 64 + 4 * dq;
#pragma unroll
        for (int g = 0; g < 4; ++g) { vr[2 * g] = *(const u32x2*)(vp + 16 * g); vr[2 * g + 1] = *(const u32x2*)(vp + LDZ_QKV + 16 * g); }
    } else {
#pragma unroll
        for (int i = 0; i < 8; ++i) vr[i] = (u32x2){0u, 0u};
    }
}
__device__ __forceinline__ void attn_phase(LAS unsigned char* lds, const Args& a, bf16_t* oo, int ldo, int first, int step) {
    const int tid = threadIdx.x, lane = tid & 63, w = __builtin_amdgcn_readfirstlane(tid >> 6);
    const bf16_t* zq = (const bf16_t*)(a.ws + WS_ZQKV);
    const float* cosT = (const float*)(a.ws + WS_COS); const float* sinT = (const float*)(a.ws + WS_SIN);
    const int g = w >> 1, r = lane & 31, hh = lane >> 5;
    const float C2 = 0.125f * 1.44269504f;
    int item = first; if (item >= 1024) return;
    u32x4 kr[4]; u32x2 vr[8];
    attn_kv_load(item, zq, tid, kr, vr);
    for (; item < 1024; item += step) {
        const int b = item >> 6, n = (item >> 2) & 15, kvh = item & 3, head = kvh * 4 + g;
        u32x4 qr[2][4];
#pragma unroll
        for (int qt = 0; qt < 2; ++qt) { const bf16_t* qp = zq + (size_t)(b * SEQ + n * 128 + (w & 1) * 64 + qt * 32 + r) * LDZ_QKV + head * 64;
#pragma unroll
            for (int ks = 0; ks < 4; ++ks) qr[qt][ks] = *(const u32x4*)(qp + 16 * ks + 8 * hh); }
        {
            const int key = tid >> 1, half = tid & 1; const int pos = (n - 1) * 128 + key; const int posc = pos >= 0 ? pos : 0;
            float t1[16], t2[16];
            { f32x4 p, q; unpack8(kr[0], p, q); t1[0] = p[0]; t1[1] = p[1]; t1[2] = p[2]; t1[3] = p[3]; t1[4] = q[0]; t1[5] = q[1]; t1[6] = q[2]; t1[7] = q[3];
              unpack8(kr[1], p, q); t1[8] = p[0]; t1[9] = p[1]; t1[10] = p[2]; t1[11] = p[3]; t1[12] = q[0]; t1[13] = q[1]; t1[14] = q[2]; t1[15] = q[3];
              unpack8(kr[2], p, q); t2[0] = p[0]; t2[1] = p[1]; t2[2] = p[2]; t2[3] = p[3]; t2[4] = q[0]; t2[5] = q[1]; t2[6] = q[2]; t2[7] = q[3];
              unpack8(kr[3], p, q); t2[8] = p[0]; t2[9] = p[1]; t2[10] = p[2]; t2[11] = p[3]; t2[12] = q[0]; t2[13] = q[1]; t2[14] = q[2]; t2[15] = q[3]; }
            float ss = 0.f;
#pragma unroll
            for (int i = 0; i < 16; ++i) ss += t1[i] * t1[i] + t2[i] * t2[i];
            ss += __shfl_xor(ss, 1);
            const float rinv = __builtin_amdgcn_rsqf(ss * (1.f / 64.f) + EPS);
            const float* kg = a.in[I_KG] + 16 * half; const float* cp = cosT + posc * 32 + 16 * half; const float* sp = sinT + posc * 32 + 16 * half;
            float o1[16], o2[16];
#pragma unroll
            for (int i = 0; i < 16; ++i) { const float y1 = t1[i] * rinv * kg[i], y2 = t2[i] * rinv * kg[32 + i], cc = cp[i], sn = sp[i]; o1[i] = y1 * cc - y2 * sn; o2[i] = y2 * cc + y1 * sn; }
            LAS unsigned char* kd = lds + A_K + key * KP + 32 * half;
            *(LAS u32x4*)(kd) = pack8((f32x4){o1[0], o1[1], o1[2], o1[3]}, (f32x4){o1[4], o1[5], o1[6], o1[7]});
            *(LAS u32x4*)(kd + 16) = pack8((f32x4){o1[8], o1[9], o1[10], o1[11]}, (f32x4){o1[12], o1[13], o1[14], o1[15]});
            *(LAS u32x4*)(kd + 64) = pack8((f32x4){o2[0], o2[1], o2[2], o2[3]}, (f32x4){o2[4], o2[5], o2[6], o2[7]});
            *(LAS u32x4*)(kd + 80) = pack8((f32x4){o2[8], o2[9], o2[10], o2[11]}, (f32x4){o2[12], o2[13], o2[14], o2[15]});
            const int kp2 = tid >> 2, dq = tid & 3;
            LAS unsigned char* vd = lds + A_V + (4 * dq) * VP + kp2 * 4;
#pragma unroll
            for (int g = 0; g < 4; ++g) { const unsigned a0 = vr[2 * g].x, a1 = vr[2 * g].y, b0 = vr[2 * g + 1].x, b1 = vr[2 * g + 1].y;
                *(LAS unsigned*)(vd + (16 * g + 0) * VP) = (a0 & 0xffffu) | (b0 << 16);
                *(LAS unsigned*)(vd + (16 * g + 1) * VP) = (a0 >> 16) | (b0 & 0xffff0000u);
                *(LAS unsigned*)(vd + (16 * g + 2) * VP) = (a1 & 0xffffu) | (b1 << 16);
                *(LAS unsigned*)(vd + (16 * g + 3) * VP) = (a1 >> 16) | (b1 & 0xffff0000u); }
        }
        __syncthreads();
        if (item + step < 1024) attn_kv_load(item + step, zq, tid, kr, vr);
        const float sink2 = a.in[I_SINK][head] * 1.44269504f;
#pragma unroll
        for (int qt = 0; qt < 2; ++qt) {
            const int m0 = (w & 1) * 64 + qt * 32, i0 = m0 >> 5, q = m0 + r; const int pos = n * 128 + q;
            bf16_t* op = oo + (size_t)(b * SEQ + pos) * ldo + head * 64;
            float v[4][8];
#pragma unroll
            for (int ks = 0; ks < 4; ++ks) { f32x4 p0, p1; unpack8(qr[qt][ks], p0, p1);
                v[ks][0] = p0[0]; v[ks][1] = p0[1]; v[ks][2] = p0[2]; v[ks][3] = p0[3]; v[ks][4] = p1[0]; v[ks][5] = p1[1]; v[ks][6] = p1[2]; v[ks][7] = p1[3]; }
            float ss = 0.f;
#pragma unroll
            for (int ks = 0; ks < 4; ++ks)
#pragma unroll
                for (int j = 0; j < 8; ++j) ss += v[ks][j] * v[ks][j];
            ss += __shfl_xor(ss, 32);
            const float rinv = __builtin_amdgcn_rsqf(ss * (1.f / 64.f) + EPS) * C2;
            bf16x8 qf[4];
#pragma unroll
            for (int ks = 0; ks < 2; ++ks) { const int dl = 16 * ks + 8 * hh; float o1[8], o2[8];
#pragma unroll
                for (int j = 0; j < 8; ++j) { const float y1 = v[ks][j] * rinv * a.in[I_QG][dl + j], y2 = v[ks + 2][j] * rinv * a.in[I_QG][32 + dl + j], cc = cosT[pos * 32 + dl + j], sn = sinT[pos * 32 + dl + j];
                    o1[j] = y1 * cc - y2 * sn; o2[j] = y2 * cc + y1 * sn; }
                u32x4 w1 = pack8((f32x4){o1[0], o1[1], o1[2], o1[3]}, (f32x4){o1[4], o1[5], o1[6], o1[7]}), w2 = pack8((f32x4){o2[0], o2[1], o2[2], o2[3]}, (f32x4){o2[4], o2[5], o2[6], o2[7]});
                qf[ks] = __builtin_bit_cast(bf16x8, w1); qf[ks + 2] = __builtin_bit_cast(bf16x8, w2); }
            f32x16 sacc[5];
#pragma unroll
            for (int t = 0; t < 5; ++t) { const int kt = i0 + t;
                const f32x16 zero16 = {0.f, 0.f, 0.f, 0.f, 0.f, 0.f, 0.f, 0.f, 0.f, 0.f, 0.f, 0.f, 0.f, 0.f, 0.f, 0.f};
#pragma unroll
                for (int ks = 0; ks < 4; ++ks) sacc[t] = __builtin_amdgcn_mfma_f32_32x32x16_bf16(*(const LAS bf16x8*)(lds + A_K + (32 * kt + r) * KP + ks * 32 + hh * 16), qf[ks], ks == 0 ? zero16 : sacc[t], 0, 0, 0); }
            const float NEG = -INFINITY;
#pragma unroll
            for (int e = 0; e < 16; ++e) { const int kr_ = (e & 3) + 8 * (e >> 2) + 4 * hh;
                if (!(kr_ > r)) sacc[0][e] = NEG;
                if (!(kr_ <= r)) sacc[4][e] = NEG; }
            if (n == 0) {
#pragma unroll
                for (int t = 0; t < 4; ++t) if (i0 + t < 4) {
#pragma unroll
                    for (int e = 0; e < 16; ++e) sacc[t][e] = NEG; } }
            float mx = NEG;
#pragma unroll
            for (int t = 0; t < 5; ++t)
#pragma unroll
                for (int e = 0; e < 16; ++e) mx = fmaxf(mx, sacc[t][e]);
            mx = fmaxf(mx, __shfl_xor(mx, 32));
            mx = fmaxf(mx, sink2);
            typedef float f32x2v __attribute__((ext_vector_type(2)));
            f32x2v sum2 = {0.f, 0.f};
#pragma unroll
            for (int t = 0; t < 5; ++t)
#pragma unroll
                for (int e = 0; e < 16; e += 2) { const float p0 = __builtin_amdgcn_exp2f(sacc[t][e] - mx), p1 = __builtin_amdgcn_exp2f(sacc[t][e + 1] - mx); sacc[t][e] = p0; sacc[t][e + 1] = p1; sum2 += (f32x2v){p0, p1}; }
            float sum = sum2.x + sum2.y;
            sum += __shfl_xor(sum, 32);
            const float rden = 1.f / (sum + __builtin_amdgcn_exp2f(sink2 - mx));
            f32x16 oacc[2];
#pragma unroll
            for (int t = 0; t < 5; ++t) { const int kt = i0 + t;
#pragma unroll
                for (int s2 = 0; s2 < 2; ++s2) {
                    u32x4 pw; pw.x = cvt_pk_bf16(sacc[t][8 * s2 + 0], sacc[t][8 * s2 + 1]); pw.y = cvt_pk_bf16(sacc[t][8 * s2 + 2], sacc[t][8 * s2 + 3]); pw.z = cvt_pk_bf16(sacc[t][8 * s2 + 4], sacc[t][8 * s2 + 5]); pw.w = cvt_pk_bf16(sacc[t][8 * s2 + 6], sacc[t][8 * s2 + 7]);
                    const bf16x8 pf = __builtin_bit_cast(bf16x8, pw);
#pragma unroll
                    for (int dt = 0; dt < 2; ++dt) { const LAS unsigned char* vb = lds + A_V + (32 * dt + r) * VP + (32 * kt + 16 * s2 + 4 * hh) * 2;
                        const s16x4 lo = *(const LAS s16x4*)vb, hi = *(const LAS s16x4*)(vb + 16);
                        const bf16x8 vf = __builtin_shufflevector(lo, hi, 0, 1, 2, 3, 4, 5, 6, 7);
                        const f32x16 zero16 = {0.f, 0.f, 0.f, 0.f, 0.f, 0.f, 0.f, 0.f, 0.f, 0.f, 0.f, 0.f, 0.f, 0.f, 0.f, 0.f};
                        oacc[dt] = __builtin_amdgcn_mfma_f32_32x32x16_bf16(vf, pf, (t == 0 && s2 == 0) ? zero16 : oacc[dt], 0, 0, 0); } } }
#pragma unroll
            for (int dt = 0; dt < 2; ++dt)
#pragma unroll
                for (int gq = 0; gq < 4; ++gq) { u32x2 ow; ow.x = cvt_pk_bf16(oacc[dt][4 * gq + 0] * rden, oacc[dt][4 * gq + 1] * rden); ow.y = cvt_pk_bf16(oacc[dt][4 * gq + 2] * rden, oacc[dt][4 * gq + 3] * rden);
                    *(u32x2*)(op + 32 * dt + 8 * gq + 4 * hh) = ow; }
        }
        __syncthreads();
    }
}

#define XB_TMO      128
#define XB_XCNT(j)  (256  + 64 * (j))
#define XB_XSUB(j)  (1280 + 64 * (j))
#define XB_XGEN(j)  (2304 + 64 * (j))
#define XB_TOP      3328
#define XB_TOPGEN   3392
#define XCD_BAR_WORDS 3456
#define XB_SPIN_CAP (1u << 18)
__device__ __forceinline__ unsigned xb_ld(unsigned* p)              { return __hip_atomic_load(p, __ATOMIC_RELAXED, __HIP_MEMORY_SCOPE_AGENT); }
__device__ __forceinline__ unsigned xb_add(unsigned* p, unsigned v) { return __hip_atomic_fetch_add(p, v, __ATOMIC_RELAXED, __HIP_MEMORY_SCOPE_AGENT); }
__device__ __forceinline__ unsigned xb_xcc_id() { return (unsigned)__builtin_amdgcn_s_getreg((3 << 11) | 20) & 0xFu; }
#define XB_SPIN(cond, bar) do { unsigned _sp = 0; while (cond) { __builtin_amdgcn_s_sleep(1); \
    if ((++_sp & 255u) == 0u) { if (xb_ld(&(bar)[XB_TMO])) break; if (_sp > XB_SPIN_CAP) { atomicAdd(&(bar)[XB_TMO], 1u); break; } } } } while (0)
struct XcdBarrier { unsigned* bar; unsigned x; volatile LAS unsigned* st; };
__device__ __forceinline__ XcdBarrier xcd_barrier_post(unsigned* bar, volatile LAS unsigned* st) {
    XcdBarrier b; b.bar = bar; b.x = xb_xcc_id(); b.st = st;
    if (threadIdx.x == 0) (void)xb_add(&bar[XB_XCNT(b.x)], 1u);
    return b;
}
__device__ __forceinline__ void xcd_barrier_complete(unsigned* bar, unsigned x, unsigned& nloc, unsigned& nx) {
    const unsigned G = gridDim.x * gridDim.y * gridDim.z;
    unsigned sum, cnt, mine, sp = 0u;
    for (;;) {
        sum = 0u; cnt = 0u; mine = 0u;
#pragma unroll
        for (unsigned j = 0; j < 16; ++j) { const unsigned c = xb_ld(&bar[XB_XCNT(j)]); sum += c; cnt += (c > 0u) ? 1u : 0u; mine = (j == x) ? c : mine; }
        if (sum == G) break;
        __builtin_amdgcn_s_sleep(1);
        if ((++sp & 255u) == 0u) { if (xb_ld(&bar[XB_TMO])) break; if (sp > XB_SPIN_CAP) { atomicAdd(&bar[XB_TMO], 1u); break; } }
    }
    nloc = mine > 0u ? mine : 1u; nx = cnt > 0u ? cnt : 1u;
}
__device__ __forceinline__ void xcd_barrier(const XcdBarrier& b) {
    asm volatile("s_waitcnt vmcnt(0)" ::: "memory");
    __syncthreads();
    if (threadIdx.x == 0) {
        unsigned* bar = b.bar;
        __builtin_amdgcn_s_waitcnt(0);
        unsigned nloc = b.st[0], nx = b.st[1]; const unsigned xg = b.st[3];
        if (nloc == 0u) { xcd_barrier_complete(bar, b.x, nloc, nx); b.st[0] = nloc; b.st[1] = nx; }
        const unsigned old = xb_add(&bar[XB_XSUB(b.x)], 1u);
        const unsigned gen = old / nloc;
        if (old + 1u == (gen + 1u) * nloc) {
            __builtin_amdgcn_fence(__ATOMIC_RELEASE, "agent");
            asm volatile("s_waitcnt vmcnt(0)" ::: "memory");
            const unsigned og = xb_add(&bar[XB_TOP], 1u);
            const unsigned tg = og / nx;
            if (og + 1u == (tg + 1u) * nx) xb_add(&bar[XB_TOPGEN], 1u);
            else XB_SPIN(xb_ld(&bar[XB_TOPGEN]) == tg, bar);
            __builtin_amdgcn_fence(__ATOMIC_ACQUIRE, "agent");
            xb_add(&bar[XB_XGEN(b.x)], 1u);
            asm volatile("s_waitcnt vmcnt(0)" ::: "memory");
        } else {
            XB_SPIN(xb_ld(&bar[XB_XGEN(b.x)]) == xg, bar);
            __builtin_amdgcn_fence(__ATOMIC_ACQUIRE, "agent");
            asm volatile("s_waitcnt vmcnt(0)" ::: "memory");
        }
        b.st[3] = xg + 1u;
    }
    __syncthreads();
}
__device__ __forceinline__ void xcd_arrive(const XcdBarrier& b) {
    asm volatile("s_waitcnt vmcnt(0)" ::: "memory");
    __syncthreads();
    if (threadIdx.x == 0) {
        unsigned* bar = b.bar;
        __builtin_amdgcn_s_waitcnt(0);
        unsigned nloc = b.st[0], nx = b.st[1];
        if (nloc == 0u) { xcd_barrier_complete(bar, b.x, nloc, nx); b.st[0] = nloc; b.st[1] = nx; }
        const unsigned old = xb_add(&bar[XB_XSUB(b.x)], 1u);
        const unsigned gen = old / nloc;
        b.st[2] = gen;
        if (old + 1u == (gen + 1u) * nloc) {
            __builtin_amdgcn_fence(__ATOMIC_RELEASE, "agent");
            asm volatile("s_waitcnt vmcnt(0)" ::: "memory");
            const unsigned og = xb_add(&bar[XB_TOP], 1u);
            const unsigned tg = og / nx;
            if (og + 1u == (tg + 1u) * nx) xb_add(&bar[XB_TOPGEN], 1u);
        }
    }
}
__device__ __forceinline__ void xcd_wait(const XcdBarrier& b) {
    __syncthreads();
    if (threadIdx.x == 0) {
        unsigned* bar = b.bar;
        const unsigned gen = b.st[2];
        XB_SPIN(xb_ld(&bar[XB_TOPGEN]) == gen, bar);
        __builtin_amdgcn_fence(__ATOMIC_ACQUIRE, "agent");
        asm volatile("s_waitcnt vmcnt(0)" ::: "memory");
    }
    __syncthreads();
}

__global__ void __launch_bounds__(512) fwd_megakernel(Args a) {
    extern __shared__ __attribute__((aligned(16))) unsigned char lds_raw[];
    LAS unsigned char* lds = (LAS unsigned char*)lds_raw;
    cg::grid_group grid = cg::this_grid();
    const int G = gridDim.x, lo = a.ph_lo, hi = a.ph_hi;
    unsigned char* ws = a.ws;
    float* ssq0 = (float*)(ws + WS_SSQ0); float* ssq1 = (float*)(ws + WS_SSQ1); float* ssq2 = (float*)(ws + WS_SSQ2);
    bf16_t* XB = (bf16_t*)(ws + WS_XB); bf16_t* PB = (bf16_t*)(ws + WS_PB); bf16_t* ZRG = (bf16_t*)(ws + WS_ZRG); bf16_t* ZQKV = (bf16_t*)(ws + WS_ZQKV); bf16_t* ZG = (bf16_t*)(ws + WS_ZG);
    bf16_t* U = (bf16_t*)(ws + WS_U);
#define IN(k) (lo <= (k) && (k) < hi)
#define SEAM(k) do { if (IN(k) && IN((k) + 1)) xcd_barrier(bar); } while (0)
#define SEAM_FILL(k, filler) do { if (IN(k) && IN((k) + 1)) xcd_arrive(bar); if (IN(k)) { filler; } if (IN(k) && IN((k) + 1)) xcd_wait(bar); } while (0)
    volatile LAS unsigned* MISC = (volatile LAS unsigned*)(lds + 131072);
    if (threadIdx.x < 32) MISC[threadIdx.x] = 0u;
    __syncthreads();
    XcdBarrier bar; bar.bar = (unsigned*)(ws + WS_BAR); bar.x = 0; bar.st = MISC + 8;
    if (hi - lo > 1) bar = xcd_barrier_post((unsigned*)(ws + WS_BAR), MISC + 8);
    if (hi > 1000) grid.sync();
    if (IN(0)) {
#pragma nounroll
        for (int rep = 0; rep < (PROBE_MODE == 4 ? 2 : 1); ++rep) { p0_prologue(a, lds, G); __syncthreads(); }
    }
#if PROBE_MODE == 7
    for (int i = 0; i < 8; ++i) grid.sync();
#endif
    SEAM_FILL(0, (convert_weights<WJ_RNN | WJ_ATT | WJ_OUT | WJ_RG | WJ_IG | WJ_PLE>(a, lds, G), setup_misc(a, G)));
    if (IN(1)) { pg8::Gemm g{XB, (const bf16_t*)(ws + WS_WIN), M, NIN, DM, DM, DM, nullptr, nullptr, 0}; pg8::StaticOrder S; S.init(M, NIN, G, (int)blockIdx.x);
        EpiIn E{ZRG, ZQKV, ZG, ssq0}; pg8::gemm_phase(lds, g, S, E);
#if PROBE_MODE == 3
        pg8::gemm_phase(lds, g, S, E);
#endif
    }
    SEAM_FILL(1, convert_p(a, G));
    if (IN(2)) {
        attn_phase(lds, a, ZQKV, LDZ_QKV, (int)blockIdx.x, G);
        for (int it = blockIdx.x; it < 256; it += G) rnn_item(lds, it, a, ZRG + 1024, LDZ_RG);
#if PROBE_MODE == 1
        for (int it = blockIdx.x; it < 256; it += G) rnn_item(lds, it, a, XB, DM);
#elif PROBE_MODE == 2
        attn_phase(lds, a, XB, DM, (int)blockIdx.x, G);
#endif
    }
    SEAM_FILL(2, (convert_weights<WJ_UP>(a, lds, G)));
    bf16_t* XC = (bf16_t*)(ws + WS_XC);
    if (IN(3)) { pg8::Gemm g{ZRG + 1024, (const bf16_t*)(ws + WS_WRNN), M, DM, DM, LDZ_RG, DM, ZQKV, (const bf16_t*)(ws + WS_WATT), LDZ_QKV}; pg8::StaticOrder S; S.init(M, DM, G, (int)blockIdx.x);
        EpiMerge E{ZG, ZG + 1024, LDZ_G, ZRG, LDZ_RG}; pg8::gemm_phase<EpiMerge, true>(lds, g, S, E); }
    SEAM_FILL(3, (convert_weights<WJ_DN>(a, lds, G)));
    if (IN(5)) { pg8::Gemm g{ZRG, (const bf16_t*)(ws + WS_WOUT), M, DM, DM, LDZ_RG, DM, nullptr, nullptr, 0}; pg8::StaticOrder S; S.init(M, DM, G, (int)blockIdx.x);
        EpiRes<1> E{XB, XC, ssq1}; pg8::gemm_phase(lds, g, S, E); }
    SEAM_FILL(5, (convert_weights<WJ_GATE>(a, lds, G)));
    if (IN(6)) { pg8::Gemm g{XC, (const bf16_t*)(ws + WS_WUP), M, DFF, DM, DM, DM, nullptr, nullptr, 0}; pg8::StaticOrder S; S.init(M, DFF, G, (int)blockIdx.x);
        EpiUp E{ssq1, U}; pg8::gemm_phase(lds, g, S, E); }
#define PLE_FILLER(round) do { pg8::Gemm g{PB, (const bf16_t*)(ws + WS_WPLE), M, DM, PLE, PLE, PLE, nullptr, nullptr, 0}; pg8::StaticOrder S; S.init(M, DM, G, (int)blockIdx.x); S.i0 = (round); S.imax = 1; \
        EpiPlain E{XB}; pg8::gemm_phase(lds, g, S, E); } while (0)
    SEAM_FILL(6, PLE_FILLER(0));
    if (IN(7)) {
        { pg8::Gemm g{U, (const bf16_t*)(ws + WS_WDN), M, DM, DFF, DFF, DFF, nullptr, nullptr, 0}; pg8::StaticOrder S; S.init(M, DM, G, (int)blockIdx.x);
          EpiRes<2> E{XC, XC, ssq2}; pg8::gemm_phase(lds, g, S, E); }
    }
    SEAM_FILL(7, PLE_FILLER(1));
    if (IN(8)) { pg8::Gemm g{XC, (const bf16_t*)(ws + WS_WGATE), M, DM, DM, DM, DM, nullptr, nullptr, 0}; pg8::StaticOrder S; S.init(M, DM, G, (int)blockIdx.x);
        EpiFinal E{ssq2, XB, XC, a.out}; pg8::gemm_phase(lds, g, S, E); }
#undef IN
#undef SEAM
#undef SEAM_FILL
#undef PLE_FILLER
}

extern "C" void kernel_launch(void* const* d_in, const int* in_sizes, int n_in, void* d_out, int out_size, void* d_ws, size_t ws_size, hipStream_t stream) {
    static int grid = 0;
    if (grid == 0) {
        if (n_in != 23 || out_size != M * DM || ws_size < WS_END) { fprintf(stderr, "kernel_launch: unexpected shapes (n_in %d out %d ws %zu)\n", n_in, out_size, ws_size); grid = -1; return; }
        int dev = 0, cus = 0, per_cu = 0;
        hipGetDevice(&dev); hipDeviceGetAttribute(&cus, hipDeviceAttributeMultiprocessorCount, dev);
        hipFuncSetAttribute((const void*)fwd_megakernel, hipFuncAttributeMaxDynamicSharedMemorySize, LDS_BYTES);
        hipOccupancyMaxActiveBlocksPerMultiprocessor(&per_cu, (const void*)fwd_megakernel, 512, LDS_BYTES);
        (void)hipGetLastError();
        if (per_cu < 1) fprintf(stderr, "kernel_launch: occupancy query says %d\n", per_cu);
        grid = cus > 0 ? cus : 256;
    }
    if (grid < 0) return;
    Args a{};
    for (int i = 0; i < 23; ++i) a.in[i] = (const float*)d_in[i];
    a.out = (float*)d_out; a.ws = (unsigned char*)d_ws;
#if MK_N_LAUNCHES == 1
    a.ph_lo = 0; a.ph_hi = 9;
    void* args[] = {&a};
    (void)hipMemsetAsync((char*)d_ws + WS_BAR, 0, XCD_BAR_WORDS * 4, stream);
    hipError_t e = hipLaunchCooperativeKernel((const void*)fwd_megakernel, dim3(grid), dim3(512), args, LDS_BYTES, stream);
    if (e != hipSuccess) fprintf(stderr, "cooperative launch failed: %s (grid %d)\n", hipGetErrorString(e), grid);
#else
    for (int ph = 0; ph < 9; ++ph) { a.ph_lo = ph; a.ph_hi = ph + 1; hipLaunchKernelGGL(fwd_megakernel, dim3(grid), dim3(512), LDS_BYTES, stream, a); }
#endif
}
```

```cpp
#include <hip/hip_runtime.h>
#include <hip/hip_cooperative_groups.h>
#include <cstdio>
#include <cstdint>
namespace cg = cooperative_groups;

#ifndef MK_N_LAUNCHES
#define MK_N_LAUNCHES 1
#endif

#ifndef PROBE_MODE
#define PROBE_MODE 0
#endif
#define LAS __attribute__((address_space(3)))
typedef unsigned short bf16_t;
typedef short bf16x8 __attribute__((ext_vector_type(8)));
typedef short s16x4 __attribute__((ext_vector_type(4)));
typedef float f32x4 __attribute__((ext_vector_type(4)));
typedef float f32x16 __attribute__((ext_vector_type(16)));
typedef unsigned u32x4 __attribute__((ext_vector_type(4)));
typedef unsigned u32x2 __attribute__((ext_vector_type(2)));

constexpr int M = 32768, DM = 1024, SEQ = 2048, NIN = 5632, DFF = 4096, PLE = 256;
constexpr float EPS = 1e-6f;
constexpr int LDZ_RG = 2048, LDZ_QKV = 1536, LDZ_G = 2048;

constexpr size_t MiB = 1u << 20, KiB = 1u << 10;
constexpr size_t WS_SSQ0 = 0, WS_SSQ1 = 128 * KiB, WS_SSQ2 = 256 * KiB, WS_COS = 512 * KiB, WS_SIN = 768 * KiB;
constexpr size_t WS_BAR = 384 * KiB;
constexpr size_t WS_WRG = 1 * MiB, WS_WIG = 1 * MiB + 128 * KiB;
constexpr size_t WS_WIN = 2 * MiB, WS_WRNN = 13 * MiB, WS_WATT = 15 * MiB, WS_WOUT = 17 * MiB, WS_WUP = 19 * MiB, WS_WDN = 27 * MiB, WS_WGATE = 35 * MiB, WS_WPLE = 37 * MiB;
constexpr size_t WS_XB = 38 * MiB;
constexpr size_t WS_PB = 102 * MiB;
constexpr size_t WS_ZRG = 118 * MiB;
constexpr size_t WS_ZQKV = 246 * MiB;
constexpr size_t WS_ZG = 342 * MiB;
constexpr size_t WS_XC = 406 * MiB;
constexpr size_t WS_U = 118 * MiB;
constexpr size_t WS_END = 470 * MiB;

constexpr int LDS_BYTES = 147456;

__device__ __forceinline__ unsigned cvt_pk_bf16(float lo, float hi) { unsigned r; asm volatile("v_cvt_pk_bf16_f32 %0, %1, %2" : "=v"(r) : "v"(lo), "v"(hi)); return r; }
__device__ __forceinline__ float bflo(unsigned w) { return __uint_as_float(w << 16); }
__device__ __forceinline__ float bfhi(unsigned w) { return __uint_as_float(w & 0xffff0000u); }
__device__ __forceinline__ float sigm(float x) { return __builtin_amdgcn_rcpf(1.f + __builtin_amdgcn_exp2f(-1.44269504f * x)); }
__device__ __forceinline__ f32x4 exp2v(f32x4 v) { return (f32x4){__builtin_amdgcn_exp2f(v.x), __builtin_amdgcn_exp2f(v.y), __builtin_amdgcn_exp2f(v.z), __builtin_amdgcn_exp2f(v.w)}; }
__device__ __forceinline__ f32x4 rcpv(f32x4 v) { return (f32x4){__builtin_amdgcn_rcpf(v.x), __builtin_amdgcn_rcpf(v.y), __builtin_amdgcn_rcpf(v.z), __builtin_amdgcn_rcpf(v.w)}; }
__device__ __forceinline__ f32x4 maxv(f32x4 v, float lo) { return (f32x4){fmaxf(v.x, lo), fmaxf(v.y, lo), fmaxf(v.z, lo), fmaxf(v.w, lo)}; }
__device__ __forceinline__ f32x4 expnegv(f32x4 x) { return exp2v(maxv(x, -60.f) * -1.44269504f); }

namespace pg8 {
constexpr int BM = 256, BK = 64, HALF = 128, HTB = HALF * BK * 2, STAGE_BYTES = 8 * HTB, NXCD = 8, WGM = 8;
__host__ __device__ __forceinline__ int lds_byte(int r, int c) { const int st = (r >> 4) * 2 + (c >> 5), rr = r & 15, cc = c & 31, ob = rr * 64 + cc * 2; return st * 1024 + (ob ^ (((ob >> 9) & 1) << 5)); }
__host__ __device__ __forceinline__ void stage_rc(int b, int& R, int& C) { const int st = b / 1024, sb = b % 1024, swz = sb ^ (((sb >> 9) & 1) << 5); R = (st >> 1) * 16 + swz / 64; C = (st & 1) * 32 + (swz % 64) / 2; }
__host__ __device__ __forceinline__ int perm32(int rho) { const int n = rho >> 4, i = rho & 15; return 8 * (i >> 2) + 4 * n + (i & 3); }

struct Unit { int pm, pn; };
struct Gemm { const bf16_t* A; const bf16_t* Bt; int M, N, K, lda, ldb; const bf16_t* A1; const bf16_t* Bt1; int lda1; };

struct StaticOrder {
    int nM, nN, nwg, G, c, i0 = 0, imax = 1 << 30;
    __host__ __device__ void init(int M_, int N_, int G_, int c_) { nM = M_ / BM; nN = N_ / BM; nwg = nM * nN; G = G_; c = c_; }
    __host__ __device__ bool next(int i, Unit& u) const {
        if (i >= imax) return false;
        const long L = (long)(i + i0) * G + c; if (L >= nwg) return false;
        int wgid = (int)L; { const int q = nwg / NXCD, r = nwg % NXCD, xcd = wgid % NXCD, off = wgid / NXCD; wgid = (xcd < r ? xcd * (q + 1) : r * (q + 1) + (xcd - r) * q) + off; }
        const int nig = WGM * nN, gid = wgid / nig, fm = gid * WGM, gsz = (nM - fm) < WGM ? (nM - fm) : WGM;
        u.pm = fm + ((wgid % nig) % gsz); u.pn = (wgid % nig) / gsz; return true;
    }
};

template <class Epi, bool DUAL = false>
__device__ __forceinline__ void gemm_phase(LAS unsigned char* lds, const Gemm g, const StaticOrder& S, const Epi& E) {
    const int tid = threadIdx.x, wid = __builtin_amdgcn_readfirstlane(tid >> 6), lane = tid & 63, wr = wid >> 2, wc = wid & 3, fr = lane & 15, fq = lane >> 4;
    const int K = g.K, nt = K / BK;
    unsigned voffA0[2], voffA1[2], voffB[2];
#pragma unroll
    for (int i = 0; i < 2; ++i) { int R, C; stage_rc(tid * 16 + i * 8192, R, C); const int Rb = (R & ~31) + perm32(R & 31);
        voffA0[i] = (unsigned)(R * g.lda + C) * 2u; voffA1[i] = DUAL ? (unsigned)(R * g.lda1 + C) * 2u : voffA0[i]; voffB[i] = (unsigned)(Rb * g.ldb + C) * 2u; }
    const size_t kstep = (size_t)(BK * 2);
    const size_t hstepA0 = (size_t)HALF * g.lda * 2, hstepA1 = DUAL ? (size_t)HALF * g.lda1 * 2 : hstepA0, hstepB = (size_t)HALF * g.ldb * 2;
    const size_t tstepA0 = 2 * hstepA0, tstepA1 = 2 * hstepA1, tstepB = 2 * hstepB;
    const unsigned ldsw = (unsigned)wid * 1024u;
    const int aoff = lds_byte(wr * 64 + fr, fq * 8), boff = lds_byte(wc * 32 + fr, fq * 8);
#define PG8_SA(b, h) (((b) * 2 + (h)) * HTB)
#define PG8_SB(b, h) ((4 + (b) * 2 + (h)) * HTB)
#define PG8_STAGE2(bufoff, gbase, v0, v1) do { \
        __builtin_amdgcn_global_load_lds((const unsigned*)((const char*)(gbase) + (v0)), (LAS unsigned*)(lds + (bufoff) + ldsw), 16, 0, 0); \
        __builtin_amdgcn_global_load_lds((const unsigned*)((const char*)(gbase) + (v1)), (LAS unsigned*)(lds + (bufoff) + ldsw + 8192), 16, 0, 0); } while (0)
#define PG8_STAGEB(bufoff, gbase) PG8_STAGE2(bufoff, gbase, voffB[0], voffB[1])
#define PG8_LDA(dst, b, h) do { _Pragma("unroll") for (int m = 0; m < 4; ++m) _Pragma("unroll") for (int k = 0; k < 2; ++k) dst[m][k] = *(const LAS bf16x8*)(lds + PG8_SA(b, h) + aoff + m * 2048 + k * 1024); } while (0)
#define PG8_LDB(dst, b, h) do { _Pragma("unroll") for (int n = 0; n < 2; ++n) _Pragma("unroll") for (int k = 0; k < 2; ++k) dst[n][k] = *(const LAS bf16x8*)(lds + PG8_SB(b, h) + boff + n * 2048 + k * 1024); } while (0)
#define PG8_MMA(ai, bj, At, Bt) do { __builtin_amdgcn_s_setprio(1); _Pragma("unroll") for (int m = 0; m < 4; ++m) _Pragma("unroll") for (int n = 0; n < 2; ++n) _Pragma("unroll") for (int k = 0; k < 2; ++k) \
        acc[ai][bj][m][n] = __builtin_amdgcn_mfma_f32_16x16x32_bf16(Bt[n][k], At[m][k], acc[ai][bj][m][n], 0, 0, 0); __builtin_amdgcn_s_setprio(0); } while (0)
#define PG8_WAIT_V(n) asm volatile("s_waitcnt vmcnt(" #n ")" ::: "memory")
#define PG8_WAIT_L(n) asm volatile("s_waitcnt lgkmcnt(" #n ")" ::: "memory")
#define PG8_BAR __builtin_amdgcn_s_barrier()
#define PG8_SCHED __builtin_amdgcn_sched_barrier(0)
    Unit cur, nxt; int ui = 0;
    if (!S.next(0, cur)) return;
    f32x4 acc[2][2][4][2];
#pragma unroll
    for (int a = 0; a < 2; ++a)
#pragma unroll
        for (int b = 0; b < 2; ++b)
#pragma unroll
            for (int m = 0; m < 4; ++m)
#pragma unroll
                for (int n = 0; n < 2; ++n) acc[a][b][m][n] = (f32x4){0.f, 0.f, 0.f, 0.f};
    bf16x8 At[4][2], B0[2][2], B1[2][2];
    const char* cA = (const char*)g.A + (size_t)cur.pm * tstepA0; const char* cB = (const char*)g.Bt + (size_t)cur.pn * tstepB;
    PG8_STAGEB(PG8_SB(0, 0), cB); PG8_STAGEB(PG8_SB(0, 1), cB + hstepB); PG8_STAGE2(PG8_SA(0, 0), cA, voffA0[0], voffA0[1]); PG8_STAGE2(PG8_SA(0, 1), cA + hstepA0, voffA0[0], voffA0[1]);
    if (wr == 1) PG8_BAR;
    PG8_WAIT_V(2); PG8_BAR;
    PG8_STAGEB(PG8_SB(1, 0), cB + kstep); PG8_STAGE2(PG8_SA(1, 0), cA + kstep, voffA0[0], voffA0[1]); PG8_STAGEB(PG8_SB(1, 1), cB + hstepB + kstep);
    PG8_WAIT_V(6); PG8_BAR;
    for (;;) {
        const bool has_next = S.next(ui + 1, nxt);
#pragma unroll
        for (int sg = 0; sg < (DUAL ? 2 : 1); ++sg) {
            const bool to_seg1 = DUAL && sg == 0;
            const unsigned vc0 = sg ? voffA1[0] : voffA0[0], vc1 = sg ? voffA1[1] : voffA0[1]; const size_t hc = sg ? hstepA1 : hstepA0;
            const char* nA; const char* nB; unsigned vn0, vn1; size_t hn;
            if (to_seg1) { nA = (const char*)g.A1 + (size_t)cur.pm * tstepA1; nB = (const char*)g.Bt1 + (size_t)cur.pn * tstepB; vn0 = voffA1[0]; vn1 = voffA1[1]; hn = hstepA1; }
            else if (has_next) { nA = (const char*)g.A + (size_t)nxt.pm * tstepA0; nB = (const char*)g.Bt + (size_t)nxt.pn * tstepB; vn0 = voffA0[0]; vn1 = voffA0[1]; hn = hstepA0; }
            else { nA = cA; nB = cB; vn0 = vc0; vn1 = vc1; hn = hc; }
            for (int t = 0; t < nt; t += 2) {
                const bool last = (t == nt - 2);
                const char* a1 = cA + (size_t)(t + 1) * kstep;
                const char* a2 = last ? nA : cA + (size_t)(t + 2) * kstep; const char* b2 = last ? nB : cB + (size_t)(t + 2) * kstep;
                const char* a3 = a2 + kstep; const char* b3 = b2 + kstep;
                const unsigned vx0 = last ? vn0 : vc0, vx1 = last ? vn1 : vc1; const size_t hx = last ? hn : hc;
                PG8_LDB(B0, 0, 0); PG8_LDB(B1, 0, 1); PG8_SCHED; PG8_LDA(At, 0, 0); PG8_STAGE2(PG8_SA(1, 1), a1 + hc, vc0, vc1);
                PG8_WAIT_V(8); PG8_WAIT_L(0); PG8_BAR; PG8_MMA(0, 0, At, B0); PG8_MMA(0, 1, At, B1); PG8_BAR; PG8_SCHED;
                PG8_LDA(At, 0, 1); PG8_STAGEB(PG8_SB(0, 0), b2); PG8_STAGEB(PG8_SB(0, 1), b2 + hstepB); PG8_STAGE2(PG8_SA(0, 0), a2, vx0, vx1);
                PG8_WAIT_V(8); PG8_WAIT_L(0); PG8_BAR; PG8_MMA(1, 0, At, B0); PG8_MMA(1, 1, At, B1); PG8_BAR; PG8_SCHED;
                PG8_LDB(B0, 1, 0); PG8_LDB(B1, 1, 1); PG8_SCHED; PG8_LDA(At, 1, 0); PG8_STAGE2(PG8_SA(0, 1), a2 + hx, vx0, vx1);
                PG8_WAIT_V(8); PG8_WAIT_L(0); PG8_BAR; PG8_MMA(0, 0, At, B0); PG8_MMA(0, 1, At, B1); PG8_BAR; PG8_SCHED;
                PG8_LDA(At, 1, 1); PG8_STAGEB(PG8_SB(1, 0), b3); PG8_STAGEB(PG8_SB(1, 1), b3 + hstepB); PG8_STAGE2(PG8_SA(1, 0), a3, vx0, vx1);
                PG8_WAIT_V(8); PG8_WAIT_L(0); PG8_BAR; PG8_MMA(1, 0, At, B0); PG8_MMA(1, 1, At, B1); PG8_BAR; PG8_SCHED;
            }
            if constexpr (DUAL) { if (sg == 0) { PG8_SCHED; E.mid(acc, cur, wr, wc, fr, fq); PG8_SCHED; } }
            cA = nA; cB = nB;
        }
        if (wr == 0) PG8_BAR;
        E(acc, cur, wr, wc, fr, fq);
        if (!has_next) break;
        bf16x8 zfrag = {0, 0, 0, 0, 0, 0, 0, 0}; asm volatile("" : "+v"(zfrag));
#pragma unroll
        for (int a = 0; a < 2; ++a)
#pragma unroll
            for (int b = 0; b < 2; ++b)
#pragma unroll
                for (int m = 0; m < 4; ++m)
#pragma unroll
                    for (int n = 0; n < 2; ++n) acc[a][b][m][n] = __builtin_amdgcn_mfma_f32_16x16x32_bf16(zfrag, zfrag, (f32x4){0.f, 0.f, 0.f, 0.f}, 0, 0, 0);
        cur = nxt; ++ui;
        if (wr == 1) PG8_BAR;
    }
    PG8_WAIT_V(0);
    PG8_BAR;
#undef PG8_SA
#undef PG8_SB
#undef PG8_STAGE2
#undef PG8_STAGEB
#undef PG8_LDA
#undef PG8_LDB
#undef PG8_MMA
#undef PG8_WAIT_V
#undef PG8_WAIT_L
#undef PG8_BAR
#undef PG8_SCHED
}
}

typedef f32x4 AccT[2][2][4][2];
#define EPI_LOOP_ROWS  _Pragma("unroll") for (int ai = 0; ai < 2; ++ai) _Pragma("unroll") for (int m = 0; m < 4; ++m)
__device__ __forceinline__ u32x4 pack8(f32x4 v0, f32x4 v1) { u32x4 w; w.x = cvt_pk_bf16(v0[0], v0[1]); w.y = cvt_pk_bf16(v0[2], v0[3]); w.z = cvt_pk_bf16(v1[0], v1[1]); w.w = cvt_pk_bf16(v1[2], v1[3]); return w; }
__device__ __forceinline__ void unpack8(u32x4 w, f32x4& v0, f32x4& v1) { v0 = (f32x4){bflo(w.x), bfhi(w.x), bflo(w.y), bfhi(w.y)}; v1 = (f32x4){bflo(w.z), bfhi(w.z), bflo(w.w), bfhi(w.w)}; }

#define EPI_M _Pragma("unroll") for (int m = 0; m < 4; ++m)
#define EPI_BJ _Pragma("unroll") for (int bj = 0; bj < 2; ++bj)
struct EpiIn {
    bf16_t *zrg, *zqkv, *zg; const float* ssq;
    __device__ __forceinline__ void operator()(const AccT& acc, const pg8::Unit& u, int wr, int wc, int fr, int fq) const {
        bf16_t* base; int ld, colt;
        if (u.pn < 8) { base = zrg; ld = LDZ_RG; colt = u.pn * 256; } else if (u.pn < 14) { base = zqkv; ld = LDZ_QKV; colt = (u.pn - 8) * 256; } else { base = zg; ld = LDZ_G; colt = (u.pn - 14) * 256; }
        const int row0 = u.pm * 256 + wr * 64 + fr, col0 = colt + wc * 32 + 8 * fq;
        float sv[2][4];
        EPI_LOOP_ROWS sv[ai][m] = ssq[row0 + ai * 128 + m * 16];
        EPI_LOOP_ROWS { const int row = row0 + ai * 128 + m * 16; const float s = __builtin_amdgcn_rsqf(sv[ai][m] * (1.f / DM) + EPS); bf16_t* rowp = base + (size_t)row * ld + col0;
            EPI_BJ *(u32x4*)(rowp + bj * 128) = pack8(acc[ai][bj][m][0] * s, acc[ai][bj][m][1] * s); }
    }
};
struct EpiMerge {
    const bf16_t* ga; const bf16_t* gb; int ldg; bf16_t* O; int ldo;
    __device__ __forceinline__ void mid(AccT& acc, const pg8::Unit& u, int wr, int wc, int fr, int fq) const {
        int row0 = u.pm * 256 + wr * 64 + fr, col0 = u.pn * 256 + wc * 32 + 8 * fq;
        asm volatile("" : "+v"(row0), "+v"(col0));
        u32x4 av[2][2][2], bv[2][2][2];
#pragma unroll
        for (int b = 0; b < 5; ++b) {
            if (b < 4) {
#pragma unroll
                for (int mm = 0; mm < 2; ++mm) EPI_BJ { const size_t off = (size_t)(row0 + (b >> 1) * 128 + (2 * (b & 1) + mm) * 16) * ldg + col0 + bj * 128; av[b & 1][mm][bj] = *(const u32x4*)(ga + off); bv[b & 1][mm][bj] = *(const u32x4*)(gb + off); }
            }
            if (b >= 1) { const int c = b - 1, ai = c >> 1;
#pragma unroll
                for (int mm = 0; mm < 2; ++mm) { const int m = 2 * (c & 1) + mm;
                    EPI_BJ { f32x4 a0, a1, b0, b1; unpack8(av[c & 1][mm][bj], a0, a1); unpack8(bv[c & 1][mm][bj], b0, b1);
                        acc[ai][bj][m][0] *= (expnegv(b0) + 1.f) * rcpv(exp2v(a0 * -1.44269504f) + 1.f);
                        acc[ai][bj][m][1] *= (expnegv(b1) + 1.f) * rcpv(exp2v(a1 * -1.44269504f) + 1.f); }
                    asm volatile("" : "+v"(acc[ai][0][m][0]), "+v"(acc[ai][0][m][1]), "+v"(acc[ai][1][m][0]), "+v"(acc[ai][1][m][1]) :: "memory"); }
            }
        }
    }
    __device__ __forceinline__ void operator()(const AccT& acc, const pg8::Unit& u, int wr, int wc, int fr, int fq) const {
        const int row0 = u.pm * 256 + wr * 64 + fr, col0 = u.pn * 256 + wc * 32 + 8 * fq;
        u32x4 bv[2][4][2];
        EPI_LOOP_ROWS EPI_BJ bv[ai][m][bj] = *(const u32x4*)(gb + (size_t)(row0 + ai * 128 + m * 16) * ldg + col0 + bj * 128);
        EPI_LOOP_ROWS EPI_BJ { f32x4 b0, b1; unpack8(bv[ai][m][bj], b0, b1);
            const f32x4 v0 = acc[ai][bj][m][0] * rcpv(expnegv(b0) + 1.f), v1 = acc[ai][bj][m][1] * rcpv(expnegv(b1) + 1.f);
            *(u32x4*)(O + (size_t)(row0 + ai * 128 + m * 16) * ldo + col0 + bj * 128) = pack8(v0, v1); }
    }
};
template <int NB  > struct EpiRes {
    const bf16_t* rbf; bf16_t* xb; float* ssq;
    __device__ __forceinline__ void operator()(const AccT& acc, const pg8::Unit& u, int wr, int wc, int fr, int fq) const {
        const int row0 = u.pm * 256 + wr * 64 + fr, col0 = u.pn * 256 + wc * 32 + 8 * fq;
#pragma unroll
        for (int h = 0; h < NB; ++h) {
            u32x4 rb[2][4][2];
#pragma unroll
            for (int ai = (NB == 2 ? h : 0); ai < (NB == 2 ? h + 1 : 2); ++ai) EPI_M EPI_BJ rb[ai][m][bj] = *(const u32x4*)(rbf + (size_t)(row0 + ai * 128 + m * 16) * DM + col0 + bj * 128);
#pragma unroll
            for (int ai = (NB == 2 ? h : 0); ai < (NB == 2 ? h + 1 : 2); ++ai) EPI_M { const int row = row0 + ai * 128 + m * 16; float sq = 0.f;
                EPI_BJ { const size_t off = (size_t)row * DM + col0 + bj * 128; f32x4 r0, r1; unpack8(rb[ai][m][bj], r0, r1);
                    const f32x4 v0 = acc[ai][bj][m][0] + r0, v1 = acc[ai][bj][m][1] + r1;
                    *(u32x4*)(xb + off) = pack8(v0, v1);
                    const f32x4 q4 = v0 * v0 + v1 * v1; sq += (q4[0] + q4[1]) + (q4[2] + q4[3]); }
                sq += __shfl_xor(sq, 16); sq += __shfl_xor(sq, 32);
                if (fq == 0) unsafeAtomicAdd(ssq + row, sq); }
        }
    }
};
struct EpiUp {
    const float* ssq; bf16_t* O;
    __device__ __forceinline__ void operator()(const AccT& acc, const pg8::Unit& u, int wr, int wc, int fr, int fq) const {
        const int row0 = u.pm * 256 + wr * 64 + fr, col0 = u.pn * 256 + wc * 32 + 8 * fq;
        float sv[2][4];
        EPI_LOOP_ROWS sv[ai][m] = ssq[row0 + ai * 128 + m * 16];
        EPI_LOOP_ROWS { const int row = row0 + ai * 128 + m * 16; const float s = __builtin_amdgcn_rsqf(sv[ai][m] * (1.f / DM) + EPS);
            EPI_BJ { const f32x4 r0 = maxv(acc[ai][bj][m][0] * s, 0.f), r1 = maxv(acc[ai][bj][m][1] * s, 0.f);
                *(u32x4*)(O + (size_t)row * DFF + col0 + bj * 128) = pack8(r0 * r0, r1 * r1); } }
    }
};
struct EpiPlain {
    bf16_t* O;
    __device__ __forceinline__ void operator()(const AccT& acc, const pg8::Unit& u, int wr, int wc, int fr, int fq) const {
        const int row0 = u.pm * 256 + wr * 64 + fr, col0 = u.pn * 256 + wc * 32 + 8 * fq;
        EPI_LOOP_ROWS { const int row = row0 + ai * 128 + m * 16;
            EPI_BJ *(u32x4*)(O + (size_t)row * DM + col0 + bj * 128) = pack8(acc[ai][bj][m][0], acc[ai][bj][m][1]); }
    }
};
struct EpiFinal {
    const float* ssq; const bf16_t* Eb; const bf16_t* xin; float* out;
    __device__ __forceinline__ void operator()(const AccT& acc, const pg8::Unit& u, int wr, int wc, int fr, int fq) const {
        const int row0 = u.pm * 256 + wr * 64 + fr, col0 = u.pn * 256 + wc * 32 + 8 * fq;
        float sv[2][4];
        EPI_LOOP_ROWS sv[ai][m] = ssq[row0 + ai * 128 + m * 16];
        u32x4 xv[2][2][2], ev[2][2][2];
#pragma unroll
        for (int b = 0; b < 5; ++b) {
            if (b < 4) {
#pragma unroll
                for (int mm = 0; mm < 2; ++mm) EPI_BJ { const size_t off = (size_t)(row0 + (b >> 1) * 128 + (2 * (b & 1) + mm) * 16) * DM + col0 + bj * 128; xv[b & 1][mm][bj] = *(const u32x4*)(xin + off); ev[b & 1][mm][bj] = *(const u32x4*)(Eb + off); }
            }
            if (b >= 1) { const int c = b - 1, ai = c >> 1;
#pragma unroll
                for (int mm = 0; mm < 2; ++mm) { const int m = 2 * (c & 1) + mm; const float sc = __builtin_amdgcn_rsqf(sv[ai][m] * (1.f / DM) + EPS);
                    EPI_BJ { const size_t off = (size_t)(row0 + ai * 128 + m * 16) * DM + col0 + bj * 128; f32x4 e0, e1, v0, v1; unpack8(ev[c & 1][mm][bj], e0, e1); unpack8(xv[c & 1][mm][bj], v0, v1);
                        const float nsc = -1.44269504f * sc;
                        v0 += e0 * rcpv(exp2v(acc[ai][bj][m][0] * nsc) + 1.f); v1 += e1 * rcpv(exp2v(acc[ai][bj][m][1] * nsc) + 1.f);
                        __builtin_nontemporal_store(v0, (f32x4*)(out + off)); __builtin_nontemporal_store(v1, (f32x4*)(out + off + 4)); } }
            }
        }
    }
};

__device__ __forceinline__ float wave_sum(float v) {
#pragma unroll
    for (int o = 1; o < 64; o <<= 1) v += __shfl_xor(v, o);
    return v;
}
__device__ __forceinline__ void p0_transpose_item(const float* W, int K, int N, bf16_t* WT, const float* g, LAS float* scr, int item, int lane) {
    const int nblk = N / 32, kb = item / nblk, nb = item % nblk, k0 = 64 * kb, n0 = 32 * nb;
#pragma unroll
    for (int i = 0; i < 32; ++i) { const int kk = 2 * i + (lane >> 5); const float gv = g ? g[k0 + kk] : 1.f; scr[kk * 33 + (lane & 31)] = __builtin_nontemporal_load(W + (size_t)(k0 + kk) * N + n0 + (lane & 31)) * gv; }
    asm volatile("s_waitcnt lgkmcnt(0)" ::: "memory");
    const int c = lane & 7;
#pragma unroll
    for (int j = 0; j < 4; ++j) { const int n = (lane >> 3) + 8 * j; const LAS float* s = scr + (8 * c) * 33 + n;
        u32x4 o; o.x = cvt_pk_bf16(s[0 * 33], s[1 * 33]); o.y = cvt_pk_bf16(s[2 * 33], s[3 * 33]); o.z = cvt_pk_bf16(s[4 * 33], s[5 * 33]); o.w = cvt_pk_bf16(s[6 * 33], s[7 * 33]);
        *(u32x4*)(WT + (size_t)(n0 + n) * K + k0 + 8 * c) = o; }
    asm volatile("s_waitcnt lgkmcnt(0)" ::: "memory");
}

struct Args { const float* in[23]; float* out; unsigned char* ws; int ph_lo, ph_hi; };
enum { I_X = 0, I_P, I_GMIX, I_WIN, I_CONVW, I_CONVB, I_WRG, I_BRG, I_WIG, I_BIG, I_LAM, I_WRNN, I_QG, I_KG, I_SINK, I_WATT, I_WOUT, I_GMLP, I_WUP, I_WDN, I_GPLE, I_WGATE, I_WPLE };

__device__ __forceinline__ void convert_p(const Args& a, int G) {
    const int gt = blockIdx.x * 512 + threadIdx.x, NT = G * 512;
    const f32x4* p4 = (const f32x4*)a.in[I_P]; u32x2* pb = (u32x2*)(a.ws + WS_PB);
    for (int i = gt; i < M * PLE / 4; i += 4 * NT) { f32x4 v[4];
#pragma unroll
        for (int q = 0; q < 4; ++q) v[q] = (i + q * NT < M * PLE / 4) ? __builtin_nontemporal_load(p4 + i + q * NT) : (f32x4){0.f, 0.f, 0.f, 0.f};
#pragma unroll
        for (int q = 0; q < 4; ++q) if (i + q * NT < M * PLE / 4) { u32x2 w; w.x = cvt_pk_bf16(v[q].x, v[q].y); w.y = cvt_pk_bf16(v[q].z, v[q].w); __builtin_nontemporal_store(w, pb + i + q * NT); } }
}

enum { WJ_IN = 1, WJ_RNN = 2, WJ_ATT = 4, WJ_OUT = 8, WJ_UP = 16, WJ_DN = 32, WJ_GATE = 64, WJ_PLE = 128, WJ_RG = 256, WJ_IG = 512 };
template <unsigned MASK> __device__ __forceinline__ void convert_weights(const Args& a, LAS unsigned char* lds, int G) {
    const int tid = threadIdx.x, lane = tid & 63, wave = tid >> 6;
    unsigned char* ws = a.ws;
    LAS float* scr = (LAS float*)(lds + wave * 16384);
    const int gw = blockIdx.x * 8 + wave, NGW = G * 8;
    constexpr int N0 = (DM / 64) * (NIN / 32), N1 = (DM / 64) * (DM / 32), N5 = (DM / 64) * (DFF / 32), N6 = (DFF / 64) * (DM / 32), N8 = (PLE / 64) * (DM / 32), N9 = 32;
    constexpr int C_IN = (MASK & WJ_IN) ? N0 : 0, C_RNN = (MASK & WJ_RNN) ? N1 : 0, C_ATT = (MASK & WJ_ATT) ? N1 : 0, C_OUT = (MASK & WJ_OUT) ? N1 : 0, C_UP = (MASK & WJ_UP) ? N5 : 0,
                  C_DN = (MASK & WJ_DN) ? N6 : 0, C_GATE = (MASK & WJ_GATE) ? N1 : 0, C_PLE = (MASK & WJ_PLE) ? N8 : 0, C_RG = (MASK & WJ_RG) ? N9 : 0, C_IG = (MASK & WJ_IG) ? N9 : 0;
    constexpr int NITEMS = C_IN + C_RNN + C_ATT + C_OUT + C_UP + C_DN + C_GATE + C_PLE + C_RG + C_IG;
    for (int it = gw; it < NITEMS; it += NGW) {
        int r = it;
        if (r < C_IN) { p0_transpose_item(a.in[I_WIN], DM, NIN, (bf16_t*)(ws + WS_WIN), a.in[I_GMIX], scr, r, lane); continue; } r -= C_IN;
        if (r < C_RNN) { p0_transpose_item(a.in[I_WRNN], DM, DM, (bf16_t*)(ws + WS_WRNN), nullptr, scr, r, lane); continue; } r -= C_RNN;
        if (r < C_ATT) { p0_transpose_item(a.in[I_WATT], DM, DM, (bf16_t*)(ws + WS_WATT), nullptr, scr, r, lane); continue; } r -= C_ATT;
        if (r < C_OUT) { p0_transpose_item(a.in[I_WOUT], DM, DM, (bf16_t*)(ws + WS_WOUT), nullptr, scr, r, lane); continue; } r -= C_OUT;
        if (r < C_UP) { p0_transpose_item(a.in[I_WUP], DM, DFF, (bf16_t*)(ws + WS_WUP), a.in[I_GMLP], scr, r, lane); continue; } r -= C_UP;
        if (r < C_DN) { p0_transpose_item(a.in[I_WDN], DFF, DM, (bf16_t*)(ws + WS_WDN), nullptr, scr, r, lane); continue; } r -= C_DN;
        if (r < C_GATE) { p0_transpose_item(a.in[I_WGATE], DM, DM, (bf16_t*)(ws + WS_WGATE), a.in[I_GPLE], scr, r, lane); continue; } r -= C_GATE;
        if (r < C_PLE) { p0_transpose_item(a.in[I_WPLE], PLE, DM, (bf16_t*)(ws + WS_WPLE), nullptr, scr, r, lane); continue; } r -= C_PLE;
        if (r < C_RG) { p0_transpose_item(a.in[I_WRG] + (size_t)(r >> 1) * 4096, 64, 64, (bf16_t*)(ws + WS_WRG) + (size_t)(r >> 1) * 4096, nullptr, scr, r & 1, lane); continue; } r -= C_RG;
        if (r < C_IG) p0_transpose_item(a.in[I_WIG] + (size_t)(r >> 1) * 4096, 64, 64, (bf16_t*)(ws + WS_WIG) + (size_t)(r >> 1) * 4096, nullptr, scr, r & 1, lane);
    }
}

__device__ __forceinline__ void p0_prologue(const Args& a, LAS unsigned char* lds, int G) {
    const int tid = threadIdx.x, lane = tid & 63, wave = tid >> 6;
    unsigned char* ws = a.ws;
    const int gw = blockIdx.x * 8 + wave, NGW = G * 8;
    convert_weights<WJ_IN>(a, lds, G);
    const float* x = a.in[I_X]; bf16_t* XB = (bf16_t*)(ws + WS_XB); float* ssq0 = (float*)(ws + WS_SSQ0);
    for (int m4 = gw * 4; m4 < M; m4 += NGW * 4) {
        f32x4 v[4][4];
#pragma unroll
        for (int r = 0; r < 4; ++r) { const f32x4* xr = (const f32x4*)(x + (size_t)(m4 + r) * DM) + lane;
#pragma unroll
            for (int j = 0; j < 4; ++j) v[r][j] = __builtin_nontemporal_load(xr + 64 * j); }
#pragma unroll
        for (int r = 0; r < 4; ++r) { float s = 0.f;
#pragma unroll
            for (int j = 0; j < 4; ++j) s += (v[r][j].x * v[r][j].x + v[r][j].y * v[r][j].y) + (v[r][j].z * v[r][j].z + v[r][j].w * v[r][j].w);
            s = wave_sum(s); if (lane == 0) ssq0[m4 + r] = s;
            u32x2* o8 = (u32x2*)(XB + (size_t)(m4 + r) * DM) + lane;
#pragma unroll
            for (int j = 0; j < 4; ++j) { u32x2 w; w.x = cvt_pk_bf16(v[r][j].x, v[r][j].y); w.y = cvt_pk_bf16(v[r][j].z, v[r][j].w); o8[64 * j] = w; } }
    }
}
__device__ __forceinline__ void setup_misc(const Args& a, int G) {
    unsigned char* ws = a.ws;
    const int gt = blockIdx.x * 512 + threadIdx.x, NT = G * 512;
    { float* s1 = (float*)(ws + WS_SSQ1); float* s2 = (float*)(ws + WS_SSQ2); for (int i = gt; i < M; i += NT) { s1[i] = 0.f; s2[i] = 0.f; } }
    { float* ct = (float*)(ws + WS_COS); float* st = (float*)(ws + WS_SIN);
      for (int i = gt; i < SEQ * 32; i += NT) { const int pos = i >> 5, k = i & 31; const float inv = exp2f(-(float)k * 0.41524101186092029f); const float ang = (float)pos * inv; ct[i] = cosf(ang); st[i] = sinf(ang); } }
}

constexpr int R_XS = 0, R_GS = 18432, R_XCB = 36864, R_WR = 46080, R_WI = 55296, R_AF = 64512, R_BI = 81920, R_SEGP = 99328, R_SEGH = 101376, R_CARRY = 103424;
constexpr int RP = 144;
constexpr int FP = 68;
__device__ __forceinline__ void rnn_item(LAS unsigned char* lds, int item, const Args& a, bf16_t* yo, int ldy) {
    const int tid = threadIdx.x, lane = tid & 63, w = __builtin_amdgcn_readfirstlane(tid >> 6);
    const int b = item >> 4, blk = item & 15, c0 = blk * 64;
    bf16_t* zrg = (bf16_t*)(a.ws + WS_ZRG);
    const int c = lane, seg = w;
    const int lrow = tid >> 3, lpiece = tid & 7;
    { const bf16_t* wr = (const bf16_t*)(a.ws + WS_WRG) + blk * 4096; const bf16_t* wi = (const bf16_t*)(a.ws + WS_WIG) + blk * 4096;
      *(LAS u32x4*)(lds + R_WR + lrow * RP + lpiece * 16) = *(const u32x4*)(wr + lrow * 64 + lpiece * 8);
      *(LAS u32x4*)(lds + R_WI + lrow * RP + lpiece * 16) = *(const u32x4*)(wi + lrow * 64 + lpiece * 8); }
    const int ch = c0 + c;
    const float cw0 = a.in[I_CONVW][ch], cw1 = a.in[I_CONVW][1024 + ch], cw2 = a.in[I_CONVW][2048 + ch], cw3 = a.in[I_CONVW][3072 + ch], cb = a.in[I_CONVB][ch];
    float ebr[2], ebi[2], ec8[2];
#pragma unroll
    for (int q = 0; q < 2; ++q) { const int che = c0 + 16 * (2 * (w & 1) + q) + (lane & 15); ebr[q] = -1.44269504f * a.in[I_BRG][che]; ebi[q] = -1.44269504f * a.in[I_BIG][che]; ec8[q] = 1.44269504f * 8.f * log1pf(expf(-a.in[I_LAM][che])); }
    const size_t rowbase = (size_t)b * SEQ;
    const bf16_t* gx = zrg + (rowbase + lrow) * LDZ_RG + c0 + lpiece * 8;
    u32x4 xpre[2], gpre[2];
    xpre[0] = *(const u32x4*)gx; gpre[0] = *(const u32x4*)(gx + 1024);
    { const bf16_t* g1 = gx + (size_t)64 * LDZ_RG; xpre[1] = *(const u32x4*)g1; gpre[1] = *(const u32x4*)(g1 + 1024); }
    const int mt = w >> 1;
#pragma unroll 2
    for (int ci = 0; ci < SEQ / 64; ++ci) {
        const int cur = ci & 1;
        LAS unsigned char* XS = lds + R_XS + cur * 9216; LAS unsigned char* XSP = lds + R_XS + (cur ^ 1) * 9216; LAS unsigned char* GS = lds + R_GS + cur * 9216;
        *(LAS u32x4*)(XS + lrow * RP + lpiece * 16) = xpre[ci & 1]; *(LAS u32x4*)(GS + lrow * RP + lpiece * 16) = gpre[ci & 1];
        if (ci + 2 < SEQ / 64) { const bf16_t* gn = gx + (size_t)(ci + 2) * 64 * LDZ_RG; xpre[ci & 1] = *(const u32x4*)gn; gpre[ci & 1] = *(const u32x4*)(gn + 1024); }
        __syncthreads();
        float xv[11];
#pragma unroll
        for (int k = 0; k < 11; ++k) { const int rr = seg * 8 - 3 + k;
            if (rr >= 0) xv[k] = __uint_as_float((unsigned)*(const LAS unsigned short*)(XS + rr * RP + c * 2) << 16);
            else xv[k] = (ci > 0) ? __uint_as_float((unsigned)*(const LAS unsigned short*)(XSP + (64 + rr) * RP + c * 2) << 16) : 0.f; }
        float xc[8];
#pragma unroll
        for (int j = 0; j < 8; ++j) { xc[j] = (((cb + xv[j] * cw0) + xv[j + 1] * cw1) + xv[j + 2] * cw2) + xv[j + 3] * cw3;
            *(LAS unsigned short*)(lds + R_XCB + (seg * 8 + j) * RP + c * 2) = (unsigned short)(cvt_pk_bf16(xc[j], 0.f) & 0xffffu); }
        __syncthreads();
        {
            bf16x8 af[2];
#pragma unroll
            for (int ks = 0; ks < 2; ++ks) af[ks] = *(const LAS bf16x8*)(lds + R_XCB + (16 * mt + (lane & 15)) * RP + ks * 64 + (lane >> 4) * 16);
#pragma unroll
            for (int q = 0; q < 2; ++q) { const int nt = 2 * (w & 1) + q;
                f32x4 ar = (f32x4){0.f, 0.f, 0.f, 0.f}, ai = (f32x4){0.f, 0.f, 0.f, 0.f};
#pragma unroll
                for (int ks = 0; ks < 2; ++ks) { const int boff = (16 * nt + (lane & 15)) * RP + ks * 64 + (lane >> 4) * 16;
                    ar = __builtin_amdgcn_mfma_f32_16x16x32_bf16(af[ks], *(const LAS bf16x8*)(lds + R_WR + boff), ar, 0, 0, 0);
                    ai = __builtin_amdgcn_mfma_f32_16x16x32_bf16(af[ks], *(const LAS bf16x8*)(lds + R_WI + boff), ai, 0, 0, 0); }
#pragma unroll
                for (int e = 0; e < 4; e += 2) { const int t = 16 * mt + 4 * (lane >> 4) + e, cc = 16 * nt + (lane & 15);
                    typedef float f32x2 __attribute__((ext_vector_type(2)));
                    const f32x2 tr = (f32x2){ar[e], ar[e + 1]} * -1.44269504f + ebr[q], ti = (f32x2){ai[e], ai[e + 1]} * -1.44269504f + ebi[q];
                    const f32x2 dr = (f32x2){__builtin_amdgcn_exp2f(tr.x), __builtin_amdgcn_exp2f(tr.y)} + 1.f, di = (f32x2){__builtin_amdgcn_exp2f(ti.x), __builtin_amdgcn_exp2f(ti.y)} + 1.f;
                    const f32x2 r = {__builtin_amdgcn_rcpf(dr.x), __builtin_amdgcn_rcpf(dr.y)}, ig = {__builtin_amdgcn_rcpf(di.x), __builtin_amdgcn_rcpf(di.y)};
                    const f32x2 la2 = r * -ec8[q];
                    const f32x2 av = {__builtin_amdgcn_exp2f(la2.x), __builtin_amdgcn_exp2f(la2.y)};
                    const f32x2 m2 = 1.f - av * av;
                    const f32x2 bi = (f32x2){__builtin_amdgcn_sqrtf(m2.x), __builtin_amdgcn_sqrtf(m2.y)} * ig;
                    ((LAS float*)(lds + R_AF))[t * FP + cc] = av.x; ((LAS float*)(lds + R_AF))[(t + 1) * FP + cc] = av.y;
                    ((LAS float*)(lds + R_BI))[t * FP + cc] = bi.x; ((LAS float*)(lds + R_BI))[(t + 1) * FP + cc] = bi.y; } }
        }
        __syncthreads();
        float av[8], bv[8]; float P = 1.f, h = 0.f;
#pragma unroll
        for (int j = 0; j < 8; ++j) { av[j] = ((const LAS float*)(lds + R_AF))[(seg * 8 + j) * FP + c]; bv[j] = ((const LAS float*)(lds + R_BI))[(seg * 8 + j) * FP + c] * xc[j]; h = av[j] * h + bv[j]; P *= av[j]; }
        ((LAS float*)(lds + R_SEGP))[seg * 64 + c] = P; ((LAS float*)(lds + R_SEGH))[seg * 64 + c] = h;
        __syncthreads();
        float hin = (ci > 0) ? ((const LAS float*)(lds + R_CARRY))[cur * 64 + c] : 0.f;
        for (int s = 0; s < seg; ++s) hin = ((const LAS float*)(lds + R_SEGP))[s * 64 + c] * hin + ((const LAS float*)(lds + R_SEGH))[s * 64 + c];
        h = hin;
        float hv[8];
#pragma unroll
        for (int j = 0; j < 8; ++j) { h = av[j] * h + bv[j]; hv[j] = h; }
#pragma unroll
        for (int j = 0; j < 8; j += 2) { typedef float f32x2 __attribute__((ext_vector_type(2)));
            const f32x2 gg = {__uint_as_float((unsigned)*(const LAS unsigned short*)(GS + (seg * 8 + j) * RP + c * 2) << 16), __uint_as_float((unsigned)*(const LAS unsigned short*)(GS + (seg * 8 + j + 1) * RP + c * 2) << 16)};
            const f32x2 wq = gg * (gg * gg * -0.10294324f + -2.3022082f);
            const f32x2 dn = (f32x2){__builtin_amdgcn_exp2f(wq.x), __builtin_amdgcn_exp2f(wq.y)} + 1.f;
            const f32x2 y = (f32x2){hv[j], hv[j + 1]} * gg * (f32x2){__builtin_amdgcn_rcpf(dn.x), __builtin_amdgcn_rcpf(dn.y)};
            *(LAS unsigned short*)(lds + R_XCB + (seg * 8 + j) * RP + c * 2) = (unsigned short)(cvt_pk_bf16(y.x, 0.f) & 0xffffu);
            *(LAS unsigned short*)(lds + R_XCB + (seg * 8 + j + 1) * RP + c * 2) = (unsigned short)(cvt_pk_bf16(y.y, 0.f) & 0xffffu); }
        if (seg == 7) ((LAS float*)(lds + R_CARRY))[(cur ^ 1) * 64 + c] = h;
        __syncthreads();
        *(u32x4*)(yo + (rowbase + (size_t)ci * 64 + lrow) * ldy + c0 + lpiece * 8) = *(const LAS u32x4*)(lds + R_XCB + lrow * RP + lpiece * 16);
    }
    __syncthreads();
}

constexpr int A_K = 0, A_V = 36864, KP = 144, VP = 520;
__device__ __forceinline__ void attn_kv_load(int item, const bf16_t* zq, int tid, u32x4 (&kr)[4], u32x2 (&vr)[8]) {
    const int b = item >> 6, n = (item >> 2) & 15, kvh = item & 3;
    const int key = tid >> 1, half = tid & 1; const int pos = (n - 1) * 128 + key;
    if (pos >= 0) {
        const bf16_t* kp = zq + (size_t)(b * SEQ + pos) * LDZ_QKV + 1024 + kvh * 64 + 16 * half;
        kr[0] = *(const u32x4*)kp; kr[1] = *(const u32x4*)(kp + 8); kr[2] = *(const u32x4*)(kp + 32); kr[3] = *(const u32x4*)(kp + 40);
    } else {
        const u32x4 z = (u32x4){0u, 0u, 0u, 0u};
#pragma unroll
        for (int i = 0; i < 4; ++i) kr[i] = z;
    }
    const int kp2 = tid >> 2, dq = tid & 3; const int vpos = (n - 1) * 128 + 2 * kp2;
    if (vpos >= 0) {
        const bf16_t* vp = zq + (size_t)(b * SEQ + vpos) * LDZ_QKV + 1280 + kvh * 64 + 4 * dq;
#pragma unroll
        for (int g = 0; g < 4; ++g) { vr[2 * g] = *(const u32x2*)(vp + 16 * g); vr[2 * g + 1] = *(const u32x2*)(vp + LDZ_QKV + 16 * g); }
    } else {
#pragma unroll
        for (int i = 0; i < 8; ++i) vr[i] = (u32x2){0u, 0u};
    }
}
__device__ __forceinline__ void attn_phase(LAS unsigned char* lds, const Args& a, bf16_t* oo, int ldo, int first, int step) {
    const int tid = threadIdx.x, lane = tid & 63, w = __builtin_amdgcn_readfirstlane(tid >> 6);
    const bf16_t* zq = (const bf16_t*)(a.ws + WS_ZQKV);
    const float* cosT = (const float*)(a.ws + WS_COS); const float* sinT = (const float*)(a.ws + WS_SIN);
    const int g = w >> 1, r = lane & 31, hh = lane >> 5;
    const float C2 = 0.125f * 1.44269504f;
    int item = first; if (item >= 1024) return;
    u32x4 kr[4]; u32x2 vr[8];
    attn_kv_load(item, zq, tid, kr, vr);
    for (; item < 1024; item += step) {
        const int b = item >> 6, n = (item >> 2) & 15, kvh = item & 3, head = kvh * 4 + g;
        u32x4 qr[2][4];
#pragma unroll
        for (int qt = 0; qt < 2; ++qt) { const bf16_t* qp = zq + (size_t)(b * SEQ + n * 128 + (w & 1) * 64 + qt * 32 + r) * LDZ_QKV + head * 64;
#pragma unroll
            for (int ks = 0; ks < 4; ++ks) qr[qt][ks] = *(const u32x4*)(qp + 16 * ks + 8 * hh); }
        {
            const int key = tid >> 1, half = tid & 1; const int pos = (n - 1) * 128 + key; const int posc = pos >= 0 ? pos : 0;
            float t1[16], t2[16];
            { f32x4 p, q; unpack8(kr[0], p, q); t1[0] = p[0]; t1[1] = p[1]; t1[2] = p[2]; t1[3] = p[3]; t1[4] = q[0]; t1[5] = q[1]; t1[6] = q[2]; t1[7] = q[3];
              unpack8(kr[1], p, q); t1[8] = p[0]; t1[9] = p[1]; t1[10] = p[2]; t1[11] = p[3]; t1[12] = q[0]; t1[13] = q[1]; t1[14] = q[2]; t1[15] = q[3];
              unpack8(kr[2], p, q); t2[0] = p[0]; t2[1] = p[1]; t2[2] = p[2]; t2[3] = p[3]; t2[4] = q[0]; t2[5] = q[1]; t2[6] = q[2]; t2[7] = q[3];
              unpack8(kr[3], p, q); t2[8] = p[0]; t2[9] = p[1]; t2[10] = p[2]; t2[11] = p[3]; t2[12] = q[0]; t2[13] = q[1]; t2[14] = q[2]; t2[15] = q[3]; }
            float ss = 0.f;
#pragma unroll
            for (int i = 0; i < 16; ++i) ss += t1[i] * t1[i] + t2[i] * t2[i];
            ss += __shfl_xor(ss, 1);
            const float rinv = __builtin_amdgcn_rsqf(ss * (1.f / 64.f) + EPS);
            const float* kg = a.in[I_KG] + 16 * half; const float* cp = cosT + posc * 32 + 16 * half; const float* sp = sinT + posc * 32 + 16 * half;
            float o1[16], o2[16];
#pragma unroll
            for (int i = 0; i < 16; ++i) { const float y1 = t1[i] * rinv * kg[i], y2 = t2[i] * rinv * kg[32 + i], cc = cp[i], sn = sp[i]; o1[i] = y1 * cc - y2 * sn; o2[i] = y2 * cc + y1 * sn; }
            LAS unsigned char* kd = lds + A_K + key * KP + 32 * half;
            *(LAS u32x4*)(kd) = pack8((f32x4){o1[0], o1[1], o1[2], o1[3]}, (f32x4){o1[4], o1[5], o1[6], o1[7]});
            *(LAS u32x4*)(kd + 16) = pack8((f32x4){o1[8], o1[9], o1[10], o1[11]}, (f32x4){o1[12], o1[13], o1[14], o1[15]});
            *(LAS u32x4*)(kd + 64) = pack8((f32x4){o2[0], o2[1], o2[2], o2[3]}, (f32x4){o2[4], o2[5], o2[6], o2[7]});
            *(LAS u32x4*)(kd + 80) = pack8((f32x4){o2[8], o2[9], o2[10], o2[11]}, (f32x4){o2[12], o2[13], o2[14], o2[15]});
            const int kp2 = tid >> 2, dq = tid & 3;
            LAS unsigned char* vd = lds + A_V + (4 * dq) * VP + kp2 * 4;
#pragma unroll
            for (int g = 0; g < 4; ++g) { const unsigned a0 = vr[2 * g].x, a1 = vr[2 * g].y, b0 = vr[2 * g + 1].x, b1 = vr[2 * g + 1].y;
                *(LAS unsigned*)(vd + (16 * g + 0) * VP) = (a0 & 0xffffu) | (b0 << 16);
                *(LAS unsigned*)(vd + (16 * g + 1) * VP) = (a0 >> 16) | (b0 & 0xffff0000u);
                *(LAS unsigned*)(vd + (16 * g + 2) * VP) = (a1 & 0xffffu) | (b1 << 16);
                *(LAS unsigned*)(vd + (16 * g + 3) * VP) = (a1 >> 16) | (b1 & 0xffff0000u); }
        }
        __syncthreads();
        if (item + step < 1024) attn_kv_load(item + step, zq, tid, kr, vr);
        const float sink2 = a.in[I_SINK][head] * 1.44269504f;
#pragma unroll
        for (int qt = 0; qt < 2; ++qt) {
            const int m0 = (w & 1) * 64 + qt * 32, i0 = m0 >> 5, q = m0 + r; const int pos = n * 128 + q;
            bf16_t* op = oo + (size_t)(b * SEQ + pos) * ldo + head * 64;
            float v[4][8];
#pragma unroll
            for (int ks = 0; ks < 4; ++ks) { f32x4 p0, p1; unpack8(qr[qt][ks], p0, p1);
                v[ks][0] = p0[0]; v[ks][1] = p0[1]; v[ks][2] = p0[2]; v[ks][3] = p0[3]; v[ks][4] = p1[0]; v[ks][5] = p1[1]; v[ks][6] = p1[2]; v[ks][7] = p1[3]; }
            float ss = 0.f;
#pragma unroll
            for (int ks = 0; ks < 4; ++ks)
#pragma unroll
                for (int j = 0; j < 8; ++j) ss += v[ks][j] * v[ks][j];
            ss += __shfl_xor(ss, 32);
            const float rinv = __builtin_amdgcn_rsqf(ss * (1.f / 64.f) + EPS) * C2;
            bf16x8 qf[4];
#pragma unroll
            for (int ks = 0; ks < 2; ++ks) { const int dl = 16 * ks + 8 * hh; float o1[8], o2[8];
#pragma unroll
                for (int j = 0; j < 8; ++j) { const float y1 = v[ks][j] * rinv * a.in[I_QG][dl + j], y2 = v[ks + 2][j] * rinv * a.in[I_QG][32 + dl + j], cc = cosT[pos * 32 + dl + j], sn = sinT[pos * 32 + dl + j];
                    o1[j] = y1 * cc - y2 * sn; o2[j] = y2 * cc + y1 * sn; }
                u32x4 w1 = pack8((f32x4){o1[0], o1[1], o1[2], o1[3]}, (f32x4){o1[4], o1[5], o1[6], o1[7]}), w2 = pack8((f32x4){o2[0], o2[1], o2[2], o2[3]}, (f32x4){o2[4], o2[5], o2[6], o2[7]});
                qf[ks] = __builtin_bit_cast(bf16x8, w1); qf[ks + 2] = __builtin_bit_cast(bf16x8, w2); }
            f32x16 sacc[5];
#pragma unroll
            for (int t = 0; t < 5; ++t) { const int kt = i0 + t;
                const f32x16 zero16 = {0.f, 0.f, 0.f, 0.f, 0.f, 0.f, 0.f, 0.f, 0.f, 0.f, 0.f, 0.f, 0.f, 0.f, 0.f, 0.f};
#pragma unroll
                for (int ks = 0; ks < 4; ++ks) sacc[t] = __builtin_amdgcn_mfma_f32_32x32x16_bf16(*(const LAS bf16x8*)(lds + A_K + (32 * kt + r) * KP + ks * 32 + hh * 16), qf[ks], ks == 0 ? zero16 : sacc[t], 0, 0, 0); }
            const float NEG = -INFINITY;
#pragma unroll
            for (int e = 0; e < 16; ++e) { const int kr_ = (e & 3) + 8 * (e >> 2) + 4 * hh;
                if (!(kr_ > r)) sacc[0][e] = NEG;
                if (!(kr_ <= r)) sacc[4][e] = NEG; }
            if (n == 0) {
#pragma unroll
                for (int t = 0; t < 4; ++t) if (i0 + t < 4) {
#pragma unroll
                    for (int e = 0; e < 16; ++e) sacc[t][e] = NEG; } }
            float mx = NEG;
#pragma unroll
            for (int t = 0; t < 5; ++t)
#pragma unroll
                for (int e = 0; e < 16; ++e) mx = fmaxf(mx, sacc[t][e]);
            mx = fmaxf(mx, __shfl_xor(mx, 32));
            mx = fmaxf(mx, sink2);
            typedef float f32x2v __attribute__((ext_vector_type(2)));
            f32x2v sum2 = {0.f, 0.f};
#pragma unroll
            for (int t = 0; t < 5; ++t)
#pragma unroll
                for (int e = 0; e < 16; e += 2) { const float p0 = __builtin_amdgcn_exp2f(sacc[t][e] - mx), p1 = __builtin_amdgcn_exp2f(sacc[t][e + 1] - mx); sacc[t][e] = p0; sacc[t][e + 1] = p1; sum2 += (f32x2v){p0, p1}; }
            float sum = sum2.x + sum2.y;
            sum += __shfl_xor(sum, 32);
            const float rden = 1.f / (sum + __builtin_amdgcn_exp2f(sink2 - mx));
            f32x16 oacc[2];
#pragma unroll
            for (int t = 0; t < 5; ++t) { const int kt = i0 + t;
#pragma unroll
                for (int s2 = 0; s2 < 2; ++s2) {
                    u32x4 pw; pw.x = cvt_pk_bf16(sacc[t][8 * s2 + 0], sacc[t][8 * s2 + 1]); pw.y = cvt_pk_bf16(sacc[t][8 * s2 + 2], sacc[t][8 * s2 + 3]); pw.z = cvt_pk_bf16(sacc[t][8 * s2 + 4], sacc[t][8 * s2 + 5]); pw.w = cvt_pk_bf16(sacc[t][8 * s2 + 6], sacc[t][8 * s2 + 7]);
                    const bf16x8 pf = __builtin_bit_cast(bf16x8, pw);
#pragma unroll
                    for (int dt = 0; dt < 2; ++dt) { const LAS unsigned char* vb = lds + A_V + (32 * dt + r) * VP + (32 * kt + 16 * s2 + 4 * hh) * 2;
                        const s16x4 lo = *(const LAS s16x4*)vb, hi = *(const LAS s16x4*)(vb + 16);
                        const bf16x8 vf = __builtin_shufflevector(lo, hi, 0, 1, 2, 3, 4, 5, 6, 7);
                        const f32x16 zero16 = {0.f, 0.f, 0.f, 0.f, 0.f, 0.f, 0.f, 0.f, 0.f, 0.f, 0.f, 0.f, 0.f, 0.f, 0.f, 0.f};
                        oacc[dt] = __builtin_amdgcn_mfma_f32_32x32x16_bf16(vf, pf, (t == 0 && s2 == 0) ? zero16 : oacc[dt], 0, 0, 0); } } }
#pragma unroll
            for (int dt = 0; dt < 2; ++dt)
#pragma unroll
                for (int gq = 0; gq < 4; ++gq) { u32x2 ow; ow.x = cvt_pk_bf16(oacc[dt][4 * gq + 0] * rden, oacc[dt][4 * gq + 1] * rden); ow.y = cvt_pk_bf16(oacc[dt][4 * gq + 2] * rden, oacc[dt][4 * gq + 3] * rden);
                    *(u32x2*)(op + 32 * dt + 8 * gq + 4 * hh) = ow; }
        }
        __syncthreads();
    }
}

#define XB_TMO      128
#define XB_XCNT(j)  (256  + 64 * (j))
#define XB_XSUB(j)  (1280 + 64 * (j))
#define XB_XGEN(j)  (2304 + 64 * (j))
#define XB_TOP      3328
#define XB_TOPGEN   3392
#define XCD_BAR_WORDS 3456
#define XB_SPIN_CAP (1u << 18)
__device__ __forceinline__ unsigned xb_ld(unsigned* p)              { return __hip_atomic_load(p, __ATOMIC_RELAXED, __HIP_MEMORY_SCOPE_AGENT); }
__device__ __forceinline__ unsigned xb_add(unsigned* p, unsigned v) { return __hip_atomic_fetch_add(p, v, __ATOMIC_RELAXED, __HIP_MEMORY_SCOPE_AGENT); }
__device__ __forceinline__ unsigned xb_xcc_id() { return (unsigned)__builtin_amdgcn_s_getreg((3 << 11) | 20) & 0xFu; }
#define XB_SPIN(cond, bar) do { unsigned _sp = 0; while (cond) { __builtin_amdgcn_s_sleep(1); \
    if ((++_sp & 255u) == 0u) { if (xb_ld(&(bar)[XB_TMO])) break; if (_sp > XB_SPIN_CAP) { atomicAdd(&(bar)[XB_TMO], 1u); break; } } } } while (0)
struct XcdBarrier { unsigned* bar; unsigned x; volatile LAS unsigned* st; };
__device__ __forceinline__ XcdBarrier xcd_barrier_post(unsigned* bar, volatile LAS unsigned* st) {
    XcdBarrier b; b.bar = bar; b.x = xb_xcc_id(); b.st = st;
    if (threadIdx.x == 0) (void)xb_add(&bar[XB_XCNT(b.x)], 1u);
    return b;
}
__device__ __forceinline__ void xcd_barrier_complete(unsigned* bar, unsigned x, unsigned& nloc, unsigned& nx) {
    const unsigned G = gridDim.x * gridDim.y * gridDim.z;
    unsigned sum, cnt, mine, sp = 0u;
    for (;;) {
        sum = 0u; cnt = 0u; mine = 0u;
#pragma unroll
        for (unsigned j = 0; j < 16; ++j) { const unsigned c = xb_ld(&bar[XB_XCNT(j)]); sum += c; cnt += (c > 0u) ? 1u : 0u; mine = (j == x) ? c : mine; }
        if (sum == G) break;
        __builtin_amdgcn_s_sleep(1);
        if ((++sp & 255u) == 0u) { if (xb_ld(&bar[XB_TMO])) break; if (sp > XB_SPIN_CAP) { atomicAdd(&bar[XB_TMO], 1u); break; } }
    }
    nloc = mine > 0u ? mine : 1u; nx = cnt > 0u ? cnt : 1u;
}
__device__ __forceinline__ void xcd_barrier(const XcdBarrier& b) {
    asm volatile("s_waitcnt vmcnt(0)" ::: "memory");
    __syncthreads();
    if (threadIdx.x == 0) {
        unsigned* bar = b.bar;
        __builtin_amdgcn_s_waitcnt(0);
        unsigned nloc = b.st[0], nx = b.st[1]; const unsigned xg = b.st[3];
        if (nloc == 0u) { xcd_barrier_complete(bar, b.x, nloc, nx); b.st[0] = nloc; b.st[1] = nx; }
        const unsigned old = xb_add(&bar[XB_XSUB(b.x)], 1u);
        const unsigned gen = old / nloc;
        if (old + 1u == (gen + 1u) * nloc) {
            __builtin_amdgcn_fence(__ATOMIC_RELEASE, "agent");
            asm volatile("s_waitcnt vmcnt(0)" ::: "memory");
            const unsigned og = xb_add(&bar[XB_TOP], 1u);
            const unsigned tg = og / nx;
            if (og + 1u == (tg + 1u) * nx) xb_add(&bar[XB_TOPGEN], 1u);
            else XB_SPIN(xb_ld(&bar[XB_TOPGEN]) == tg, bar);
            __builtin_amdgcn_fence(__ATOMIC_ACQUIRE, "agent");
            xb_add(&bar[XB_XGEN(b.x)], 1u);
            asm volatile("s_waitcnt vmcnt(0)" ::: "memory");
        } else {
            XB_SPIN(xb_ld(&bar[XB_XGEN(b.x)]) == xg, bar);
            __builtin_amdgcn_fence(__ATOMIC_ACQUIRE, "agent");
            asm volatile("s_waitcnt vmcnt(0)" ::: "memory");
        }
        b.st[3] = xg + 1u;
    }
    __syncthreads();
}
__device__ __forceinline__ void xcd_arrive(const XcdBarrier& b) {
    asm volatile("s_waitcnt vmcnt(0)" ::: "memory");
    __syncthreads();
    if (threadIdx.x == 0) {
        unsigned* bar = b.bar;
        __builtin_amdgcn_s_waitcnt(0);
        unsigned nloc = b.st[0], nx = b.st[1];
        if (nloc == 0u) { xcd_barrier_complete(bar, b.x, nloc, nx); b.st[0] = nloc; b.st[1] = nx; }
        const unsigned old = xb_add(&bar[XB_XSUB(b.x)], 1u);
        const unsigned gen = old / nloc;
        b.st[2] = gen;
        if (old + 1u == (gen + 1u) * nloc) {
            __builtin_amdgcn_fence(__ATOMIC_RELEASE, "agent");
            asm volatile("s_waitcnt vmcnt(0)" ::: "memory");
            const unsigned og = xb_add(&bar[XB_TOP], 1u);
            const unsigned tg = og / nx;
            if (og + 1u == (tg + 1u) * nx) xb_add(&bar[XB_TOPGEN], 1u);
        }
    }
}
__device__ __forceinline__ void xcd_wait(const XcdBarrier& b) {
    __syncthreads();
    if (threadIdx.x == 0) {
        unsigned* bar = b.bar;
        const unsigned gen = b.st[2];
        XB_SPIN(xb_ld(&bar[XB_TOPGEN]) == gen, bar);
        __builtin_amdgcn_fence(__ATOMIC_ACQUIRE, "agent");
        asm volatile("s_waitcnt vmcnt(0)" ::: "memory");
    }
    __syncthreads();
}

__global__ void __launch_bounds__(512) fwd_megakernel(Args a) {
    extern __shared__ __attribute__((aligned(16))) unsigned char lds_raw[];
    LAS unsigned char* lds = (LAS unsigned char*)lds_raw;
    cg::grid_group grid = cg::this_grid();
    const int G = gridDim.x, lo = a.ph_lo, hi = a.ph_hi;
    unsigned char* ws = a.ws;
    float* ssq0 = (float*)(ws + WS_SSQ0); float* ssq1 = (float*)(ws + WS_SSQ1); float* ssq2 = (float*)(ws + WS_SSQ2);
    bf16_t* XB = (bf16_t*)(ws + WS_XB); bf16_t* PB = (bf16_t*)(ws + WS_PB); bf16_t* ZRG = (bf16_t*)(ws + WS_ZRG); bf16_t* ZQKV = (bf16_t*)(ws + WS_ZQKV); bf16_t* ZG = (bf16_t*)(ws + WS_ZG);
    bf16_t* U = (bf16_t*)(ws + WS_U);
#define IN(k) (lo <= (k) && (k) < hi)
#define SEAM(k) do { if (IN(k) && IN((k) + 1)) xcd_barrier(bar); } while (0)
#define SEAM_FILL(k, filler) do { if (IN(k) && IN((k) + 1)) xcd_arrive(bar); if (IN(k)) { filler; } if (IN(k) && IN((k) + 1)) xcd_wait(bar); } while (0)
    volatile LAS unsigned* MISC = (volatile LAS unsigned*)(lds + 131072);
    if (threadIdx.x < 32) MISC[threadIdx.x] = 0u;
    __syncthreads();
    XcdBarrier bar; bar.bar = (unsigned*)(ws + WS_BAR); bar.x = 0; bar.st = MISC + 8;
    if (hi - lo > 1) bar = xcd_barrier_post((unsigned*)(ws + WS_BAR), MISC + 8);
    if (hi > 1000) grid.sync();
    if (IN(0)) {
#pragma nounroll
        for (int rep = 0; rep < (PROBE_MODE == 4 ? 2 : 1); ++rep) { p0_prologue(a, lds, G); __syncthreads(); }
    }
#if PROBE_MODE == 7
    for (int i = 0; i < 8; ++i) grid.sync();
#endif
    SEAM_FILL(0, (convert_weights<WJ_RNN | WJ_ATT | WJ_OUT | WJ_RG | WJ_IG | WJ_PLE>(a, lds, G), setup_misc(a, G)));
    if (IN(1)) { pg8::Gemm g{XB, (const bf16_t*)(ws + WS_WIN), M, NIN, DM, DM, DM, nullptr, nullptr, 0}; pg8::StaticOrder S; S.init(M, NIN, G, (int)blockIdx.x);
        EpiIn E{ZRG, ZQKV, ZG, ssq0}; pg8::gemm_phase(lds, g, S, E);
#if PROBE_MODE == 3
        pg8::gemm_phase(lds, g, S, E);
#endif
    }
    SEAM_FILL(1, convert_p(a, G));
    if (IN(2)) {
        attn_phase(lds, a, ZQKV, LDZ_QKV, (int)blockIdx.x, G);
        for (int it = blockIdx.x; it < 256; it += G) rnn_item(lds, it, a, ZRG + 1024, LDZ_RG);
#if PROBE_MODE == 1
        for (int it = blockIdx.x; it < 256; it += G) rnn_item(lds, it, a, XB, DM);
#elif PROBE_MODE == 2
        attn_phase(lds, a, XB, DM, (int)blockIdx.x, G);
#endif
    }
    SEAM_FILL(2, (convert_weights<WJ_UP>(a, lds, G)));
    bf16_t* XC = (bf16_t*)(ws + WS_XC);
    if (IN(3)) { pg8::Gemm g{ZRG + 1024, (const bf16_t*)(ws + WS_WRNN), M, DM, DM, LDZ_RG, DM, ZQKV, (const bf16_t*)(ws + WS_WATT), LDZ_QKV}; pg8::StaticOrder S; S.init(M, DM, G, (int)blockIdx.x);
        EpiMerge E{ZG, ZG + 1024, LDZ_G, ZRG, LDZ_RG}; pg8::gemm_phase<EpiMerge, true>(lds, g, S, E); }
    SEAM_FILL(3, (convert_weights<WJ_DN>(a, lds, G)));
    if (IN(5)) { pg8::Gemm g{ZRG, (const bf16_t*)(ws + WS_WOUT), M, DM, DM, LDZ_RG, DM, nullptr, nullptr, 0}; pg8::StaticOrder S; S.init(M, DM, G, (int)blockIdx.x);
        EpiRes<1> E{XB, XC, ssq1}; pg8::gemm_phase(lds, g, S, E); }
    SEAM_FILL(5, (convert_weights<WJ_GATE>(a, lds, G)));
    if (IN(6)) { pg8::Gemm g{XC, (const bf16_t*)(ws + WS_WUP), M, DFF, DM, DM, DM, nullptr, nullptr, 0}; pg8::StaticOrder S; S.init(M, DFF, G, (int)blockIdx.x);
        EpiUp E{ssq1, U}; pg8::gemm_phase(lds, g, S, E); }
#define PLE_FILLER(round) do { pg8::Gemm g{PB, (const bf16_t*)(ws + WS_WPLE), M, DM, PLE, PLE, PLE, nullptr, nullptr, 0}; pg8::StaticOrder S; S.init(M, DM, G, (int)blockIdx.x); S.i0 = (round); S.imax = 1; \
        EpiPlain E{XB}; pg8::gemm_phase(lds, g, S, E); } while (0)
    SEAM_FILL(6, PLE_FILLER(0));
    if (IN(7)) {
        { pg8::Gemm g{U, (const bf16_t*)(ws + WS_WDN), M, DM, DFF, DFF, DFF, nullptr, nullptr, 0}; pg8::StaticOrder S; S.init(M, DM, G, (int)blockIdx.x);
          EpiRes<2> E{XC, XC, ssq2}; pg8::gemm_phase(lds, g, S, E); }
    }
    SEAM_FILL(7, PLE_FILLER(1));
    if (IN(8)) { pg8::Gemm g{XC, (const bf16_t*)(ws + WS_WGATE), M, DM, DM, DM, DM, nullptr, nullptr, 0}; pg8::StaticOrder S; S.init(M, DM, G, (int)blockIdx.x);
        EpiFinal E{ssq2, XB, XC, a.out}; pg8::gemm_phase(lds, g, S, E); }
#undef IN
#undef SEAM
#undef SEAM_FILL
#undef PLE_FILLER
}

extern "C" void kernel_launch(void* const* d_in, const int* in_sizes, int n_in, void* d_out, int out_size, void* d_ws, size_t ws_size, hipStream_t stream) {
    static int grid = 0;
    if (grid == 0) {
        if (n_in != 23 || out_size != M * DM || ws_size < WS_END) { fprintf(stderr, "kernel_launch: unexpected shapes (n_in %d out %d ws %zu)\n", n_in, out_size, ws_size); grid = -1; return; }
        int dev = 0, cus = 0, per_cu = 0;
        hipGetDevice(&dev); hipDeviceGetAttribute(&cus, hipDeviceAttributeMultiprocessorCount, dev);
        hipFuncSetAttribute((const void*)fwd_megakernel, hipFuncAttributeMaxDynamicSharedMemorySize, LDS_BYTES);
        hipOccupancyMaxActiveBlocksPerMultiprocessor(&per_cu, (const void*)fwd_megakernel, 512, LDS_BYTES);
        (void)hipGetLastError();
        if (per_cu < 1) fprintf(stderr, "kernel_launch: occupancy query says %d\n", per_cu);
        grid = cus > 0 ? cus : 256;
    }
    if (grid < 0) return;
    Args a{};
    for (int i = 0; i < 23; ++i) a.in[i] = (const float*)d_in[i];
    a.out = (float*)d_out; a.ws = (unsigned char*)d_ws;
#if MK_N_LAUNCHES == 1
    a.ph_lo = 0; a.ph_hi = 9;
    void* args[] = {&a};
    (void)hipMemsetAsync((char*)d_ws + WS_BAR, 0, XCD_BAR_WORDS * 4, stream);
    hipError_t e = hipLaunchCooperativeKernel((const void*)fwd_megakernel, dim3(grid), dim3(512), args, LDS_BYTES, stream);
    if (e != hipSuccess) fprintf(stderr, "cooperative launch failed: %s (grid %d)\n", hipGetErrorString(e), grid);
#else
    for (int ph = 0; ph < 9; ++ph) { a.ph_lo = ph; a.ph_hi = ph + 1; hipLaunchKernelGGL(fwd_megakernel, dim3(grid), dim3(512), LDS_BYTES, stream, a); }
#endif
}
```

```cpp
#include <hip/hip_runtime.h>
#include <hip/hip_cooperative_groups.h>
#include <cstdio>
#include <cstdint>
namespace cg = cooperative_groups;

#ifndef MK_N_LAUNCHES
#define MK_N_LAUNCHES 1
#endif

#ifndef PROBE_MODE
#define PROBE_MODE 0
#endif
#define LAS __attribute__((address_space(3)))
typedef unsigned short bf16_t;
typedef short bf16x8 __attribute__((ext_vector_type(8)));
typedef short s16x4 __attribute__((ext_vector_type(4)));
typedef float f32x4 __attribute__((ext_vector_type(4)));
typedef float f32x16 __attribute__((ext_vector_type(16)));
typedef unsigned u32x4 __attribute__((ext_vector_type(4)));
typedef unsigned u32x2 __attribute__((ext_vector_type(2)));

constexpr int M = 32768, DM = 1024, SEQ = 2048, NIN = 5632, DFF = 4096, PLE = 256;
constexpr float EPS = 1e-6f;
constexpr int LDZ_RG = 2048, LDZ_QKV = 1536, LDZ_G = 2048;

constexpr size_t MiB = 1u << 20, KiB = 1u << 10;
constexpr size_t WS_SSQ0 = 0, WS_SSQ1 = 128 * KiB, WS_SSQ2 = 256 * KiB, WS_COS = 512 * KiB, WS_SIN = 768 * KiB;
constexpr size_t WS_BAR = 384 * KiB;
constexpr size_t WS_WRG = 1 * MiB, WS_WIG = 1 * MiB + 128 * KiB;
constexpr size_t WS_WIN = 2 * MiB, WS_WRNN = 13 * MiB, WS_WATT = 15 * MiB, WS_WOUT = 17 * MiB, WS_WUP = 19 * MiB, WS_WDN = 27 * MiB, WS_WGATE = 35 * MiB, WS_WPLE = 37 * MiB;
constexpr size_t WS_XB = 38 * MiB;
constexpr size_t WS_PB = 102 * MiB;
constexpr size_t WS_ZRG = 118 * MiB;
constexpr size_t WS_ZQKV = 246 * MiB;
constexpr size_t WS_ZG = 342 * MiB;
constexpr size_t WS_XC = 406 * MiB;
constexpr size_t WS_U = 118 * MiB;
constexpr size_t WS_END = 470 * MiB;

constexpr int LDS_BYTES = 147456;

__device__ __forceinline__ unsigned cvt_pk_bf16(float lo, float hi) { unsigned r; asm volatile("v_cvt_pk_bf16_f32 %0, %1, %2" : "=v"(r) : "v"(lo), "v"(hi)); return r; }
__device__ __forceinline__ float bflo(unsigned w) { return __uint_as_float(w << 16); }
__device__ __forceinline__ float bfhi(unsigned w) { return __uint_as_float(w & 0xffff0000u); }
__device__ __forceinline__ float sigm(float x) { return __builtin_amdgcn_rcpf(1.f + __builtin_amdgcn_exp2f(-1.44269504f * x)); }
__device__ __forceinline__ f32x4 exp2v(f32x4 v) { return (f32x4){__builtin_amdgcn_exp2f(v.x), __builtin_amdgcn_exp2f(v.y), __builtin_amdgcn_exp2f(v.z), __builtin_amdgcn_exp2f(v.w)}; }
__device__ __forceinline__ f32x4 rcpv(f32x4 v) { return (f32x4){__builtin_amdgcn_rcpf(v.x), __builtin_amdgcn_rcpf(v.y), __builtin_amdgcn_rcpf(v.z), __builtin_amdgcn_rcpf(v.w)}; }
__device__ __forceinline__ f32x4 maxv(f32x4 v, float lo) { return (f32x4){fmaxf(v.x, lo), fmaxf(v.y, lo), fmaxf(v.z, lo), fmaxf(v.w, lo)}; }
__device__ __forceinline__ f32x4 expnegv(f32x4 x) { return exp2v(maxv(x, -60.f) * -1.44269504f); }

namespace pg8 {
constexpr int BM = 256, BK = 64, HALF = 128, HTB = HALF * BK * 2, STAGE_BYTES = 8 * HTB, NXCD = 8, WGM = 8;
__host__ __device__ __forceinline__ int lds_byte(int r, int c) { const int st = (r >> 4) * 2 + (c >> 5), rr = r & 15, cc = c & 31, ob = rr * 64 + cc * 2; return st * 1024 + (ob ^ (((ob >> 9) & 1) << 5)); }
__host__ __device__ __forceinline__ void stage_rc(int b, int& R, int& C) { const int st = b / 1024, sb = b % 1024, swz = sb ^ (((sb >> 9) & 1) << 5); R = (st >> 1) * 16 + swz / 64; C = (st & 1) * 32 + (swz % 64) / 2; }
__host__ __device__ __forceinline__ int perm32(int rho) { const int n = rho >> 4, i = rho & 15; return 8 * (i >> 2) + 4 * n + (i & 3); }

struct Unit { int pm, pn; };
struct Gemm { const bf16_t* A; const bf16_t* Bt; int M, N, K, lda, ldb; const bf16_t* A1; const bf16_t* Bt1; int lda1; };

struct StaticOrder {
    int nM, nN, nwg, G, c, i0 = 0, imax = 1 << 30;
    __host__ __device__ void init(int M_, int N_, int G_, int c_) { nM = M_ / BM; nN = N_ / BM; nwg = nM * nN; G = G_; c = c_; }
    __host__ __device__ bool next(int i, Unit& u) const {
        if (i >= imax) return false;
        const long L = (long)(i + i0) * G + c; if (L >= nwg) return false;
        int wgid = (int)L; { const int q = nwg / NXCD, r = nwg % NXCD, xcd = wgid % NXCD, off = wgid / NXCD; wgid = (xcd < r ? xcd * (q + 1) : r * (q + 1) + (xcd - r) * q) + off; }
        const int nig = WGM * nN, gid = wgid / nig, fm = gid * WGM, gsz = (nM - fm) < WGM ? (nM - fm) : WGM;
        u.pm = fm + ((wgid % nig) % gsz); u.pn = (wgid % nig) / gsz; return true;
    }
};

template <class Epi, bool DUAL = false>
__device__ __forceinline__ void gemm_phase(LAS unsigned char* lds, const Gemm g, const StaticOrder& S, const Epi& E) {
    const int tid = threadIdx.x, wid = __builtin_amdgcn_readfirstlane(tid >> 6), lane = tid & 63, wr = wid >> 2, wc = wid & 3, fr = lane & 15, fq = lane >> 4;
    const int K = g.K, nt = K / BK;
    unsigned voffA0[2], voffA1[2], voffB[2];
#pragma unroll
    for (int i = 0; i < 2; ++i) { int R, C; stage_rc(tid * 16 + i * 8192, R, C); const int Rb = (R & ~31) + perm32(R & 31);
        voffA0[i] = (unsigned)(R * g.lda + C) * 2u; voffA1[i] = DUAL ? (unsigned)(R * g.lda1 + C) * 2u : voffA0[i]; voffB[i] = (unsigned)(Rb * g.ldb + C) * 2u; }
    const size_t kstep = (size_t)(BK * 2);
    const size_t hstepA0 = (size_t)HALF * g.lda * 2, hstepA1 = DUAL ? (size_t)HALF * g.lda1 * 2 : hstepA0, hstepB = (size_t)HALF * g.ldb * 2;
    const size_t tstepA0 = 2 * hstepA0, tstepA1 = 2 * hstepA1, tstepB = 2 * hstepB;
    const unsigned ldsw = (unsigned)wid * 1024u;
    const int aoff = lds_byte(wr * 64 + fr, fq * 8), boff = lds_byte(wc * 32 + fr, fq * 8);
#define PG8_SA(b, h) (((b) * 2 + (h)) * HTB)
#define PG8_SB(b, h) ((4 + (b) * 2 + (h)) * HTB)
#define PG8_STAGE2(bufoff, gbase, v0, v1) do { \
        __builtin_amdgcn_global_load_lds((const unsigned*)((const char*)(gbase) + (v0)), (LAS unsigned*)(lds + (bufoff) + ldsw), 16, 0, 0); \
        __builtin_amdgcn_global_load_lds((const unsigned*)((const char*)(gbase) + (v1)), (LAS unsigned*)(lds + (bufoff) + ldsw + 8192), 16, 0, 0); } while (0)
#define PG8_STAGEB(bufoff, gbase) PG8_STAGE2(bufoff, gbase, voffB[0], voffB[1])
#define PG8_LDA(dst, b, h) do { _Pragma("unroll") for (int m = 0; m < 4; ++m) _Pragma("unroll") for (int k = 0; k < 2; ++k) dst[m][k] = *(const LAS bf16x8*)(lds + PG8_SA(b, h) + aoff + m * 2048 + k * 1024); } while (0)
#define PG8_LDB(dst, b, h) do { _Pragma("unroll") for (int n = 0; n < 2; ++n) _Pragma("unroll") for (int k = 0; k < 2; ++k) dst[n][k] = *(const LAS bf16x8*)(lds + PG8_SB(b, h) + boff + n * 2048 + k * 1024); } while (0)
#define PG8_MMA(ai, bj, At, Bt) do { __builtin_amdgcn_s_setprio(1); _Pragma("unroll") for (int m = 0; m < 4; ++m) _Pragma("unroll") for (int n = 0; n < 2; ++n) _Pragma("unroll") for (int k = 0; k < 2; ++k) \
        acc[ai][bj][m][n] = __builtin_amdgcn_mfma_f32_16x16x32_bf16(Bt[n][k], At[m][k], acc[ai][bj][m][n], 0, 0, 0); __builtin_amdgcn_s_setprio(0); } while (0)
#define PG8_WAIT_V(n) asm volatile("s_waitcnt vmcnt(" #n ")" ::: "memory")
#define PG8_WAIT_L(n) asm volatile("s_waitcnt lgkmcnt(" #n ")" ::: "memory")
#define PG8_BAR __builtin_amdgcn_s_barrier()
#define PG8_SCHED __builtin_amdgcn_sched_barrier(0)
    Unit cur, nxt; int ui = 0;
    if (!S.next(0, cur)) return;
    f32x4 acc[2][2][4][2];
#pragma unroll
    for (int a = 0; a < 2; ++a)
#pragma unroll
        for (int b = 0; b < 2; ++b)
#pragma unroll
            for (int m = 0; m < 4; ++m)
#pragma unroll
                for (int n = 0; n < 2; ++n) acc[a][b][m][n] = (f32x4){0.f, 0.f, 0.f, 0.f};
    bf16x8 At[4][2], B0[2][2], B1[2][2];
    const char* cA = (const char*)g.A + (size_t)cur.pm * tstepA0; const char* cB = (const char*)g.Bt + (size_t)cur.pn * tstepB;
    PG8_STAGEB(PG8_SB(0, 0), cB); PG8_STAGEB(PG8_SB(0, 1), cB + hstepB); PG8_STAGE2(PG8_SA(0, 0), cA, voffA0[0], voffA0[1]); PG8_STAGE2(PG8_SA(0, 1), cA + hstepA0, voffA0[0], voffA0[1]);
    if (wr == 1) PG8_BAR;
    PG8_WAIT_V(2); PG8_BAR;
    PG8_STAGEB(PG8_SB(1, 0), cB + kstep); PG8_STAGE2(PG8_SA(1, 0), cA + kstep, voffA0[0], voffA0[1]); PG8_STAGEB(PG8_SB(1, 1), cB + hstepB + kstep);
    PG8_WAIT_V(6); PG8_BAR;
    for (;;) {
        const bool has_next = S.next(ui + 1, nxt);
#pragma unroll
        for (int sg = 0; sg < (DUAL ? 2 : 1); ++sg) {
            const bool to_seg1 = DUAL && sg == 0;
            const unsigned vc0 = sg ? voffA1[0] : voffA0[0], vc1 = sg ? voffA1[1] : voffA0[1]; const size_t hc = sg ? hstepA1 : hstepA0;
            const char* nA; const char* nB; unsigned vn0, vn1; size_t hn;
            if (to_seg1) { nA = (const char*)g.A1 + (size_t)cur.pm * tstepA1; nB = (const char*)g.Bt1 + (size_t)cur.pn * tstepB; vn0 = voffA1[0]; vn1 = voffA1[1]; hn = hstepA1; }
            else if (has_next) { nA = (const char*)g.A + (size_t)nxt.pm * tstepA0; nB = (const char*)g.Bt + (size_t)nxt.pn * tstepB; vn0 = voffA0[0]; vn1 = voffA0[1]; hn = hstepA0; }
            else { nA = cA; nB = cB; vn0 = vc0; vn1 = vc1; hn = hc; }
            for (int t = 0; t < nt; t += 2) {
                const bool last = (t == nt - 2);
                const char* a1 = cA + (size_t)(t + 1) * kstep;
                const char* a2 = last ? nA : cA + (size_t)(t + 2) * kstep; const char* b2 = last ? nB : cB + (size_t)(t + 2) * kstep;
                const char* a3 = a2 + kstep; const char* b3 = b2 + kstep;
                const unsigned vx0 = last ? vn0 : vc0, vx1 = last ? vn1 : vc1; const size_t hx = last ? hn : hc;
                PG8_LDB(B0, 0, 0); PG8_LDB(B1, 0, 1); PG8_SCHED; PG8_LDA(At, 0, 0); PG8_STAGE2(PG8_SA(1, 1), a1 + hc, vc0, vc1);
                PG8_WAIT_V(8); PG8_WAIT_L(0); PG8_BAR; PG8_MMA(0, 0, At, B0); PG8_MMA(0, 1, At, B1); PG8_BAR; PG8_SCHED;
                PG8_LDA(At, 0, 1); PG8_STAGEB(PG8_SB(0, 0), b2); PG8_STAGEB(PG8_SB(0, 1), b2 + hstepB); PG8_STAGE2(PG8_SA(0, 0), a2, vx0, vx1);
                PG8_WAIT_V(8); PG8_WAIT_L(0); PG8_BAR; PG8_MMA(1, 0, At, B0); PG8_MMA(1, 1, At, B1); PG8_BAR; PG8_SCHED;
                PG8_LDB(B0, 1, 0); PG8_LDB(B1, 1, 1); PG8_SCHED; PG8_LDA(At, 1, 0); PG8_STAGE2(PG8_SA(0, 1), a2 + hx, vx0, vx1);
                PG8_WAIT_V(8); PG8_WAIT_L(0); PG8_BAR; PG8_MMA(0, 0, At, B0); PG8_MMA(0, 1, At, B1); PG8_BAR; PG8_SCHED;
                PG8_LDA(At, 1, 1); PG8_STAGEB(PG8_SB(1, 0), b3); PG8_STAGEB(PG8_SB(1, 1), b3 + hstepB); PG8_STAGE2(PG8_SA(1, 0), a3, vx0, vx1);
                PG8_WAIT_V(8); PG8_WAIT_L(0); PG8_BAR; PG8_MMA(1, 0, At, B0); PG8_MMA(1, 1, At, B1); PG8_BAR; PG8_SCHED;
            }
            if constexpr (DUAL) { if (sg == 0) { PG8_SCHED; E.mid(acc, cur, wr, wc, fr, fq); PG8_SCHED; } }
            cA = nA; cB = nB;
        }
        if (wr == 0) PG8_BAR;
        E(acc, cur, wr, wc, fr, fq);
        if (!has_next) break;
        bf16x8 zfrag = {0, 0, 0, 0, 0, 0, 0, 0}; asm volatile("" : "+v"(zfrag));
#pragma unroll
        for (int a = 0; a < 2; ++a)
#pragma unroll
            for (int b = 0; b < 2; ++b)
#pragma unroll
                for (int m = 0; m < 4; ++m)
#pragma unroll
                    for (int n = 0; n < 2; ++n) acc[a][b][m][n] = __builtin_amdgcn_mfma_f32_16x16x32_bf16(zfrag, zfrag, (f32x4){0.f, 0.f, 0.f, 0.f}, 0, 0, 0);
        cur = nxt; ++ui;
        if (wr == 1) PG8_BAR;
    }
    PG8_WAIT_V(0);
    PG8_BAR;
#undef PG8_SA
#undef PG8_SB
#undef PG8_STAGE2
#undef PG8_STAGEB
#undef PG8_LDA
#undef PG8_LDB
#undef PG8_MMA
#undef PG8_WAIT_V
#undef PG8_WAIT_L
#undef PG8_BAR
#undef PG8_SCHED
}
}

typedef f32x4 AccT[2][2][4][2];
#define EPI_LOOP_ROWS  _Pragma("unroll") for (int ai = 0; ai < 2; ++ai) _Pragma("unroll") for (int m = 0; m < 4; ++m)
__device__ __forceinline__ u32x4 pack8(f32x4 v0, f32x4 v1) { u32x4 w; w.x = cvt_pk_bf16(v0[0], v0[1]); w.y = cvt_pk_bf16(v0[2], v0[3]); w.z = cvt_pk_bf16(v1[0], v1[1]); w.w = cvt_pk_bf16(v1[2], v1[3]); return w; }
__device__ __forceinline__ void unpack8(u32x4 w, f32x4& v0, f32x4& v1) { v0 = (f32x4){bflo(w.x), bfhi(w.x), bflo(w.y), bfhi(w.y)}; v1 = (f32x4){bflo(w.z), bfhi(w.z), bflo(w.w), bfhi(w.w)}; }

#define EPI_M _Pragma("unroll") for (int m = 0; m < 4; ++m)
#define EPI_BJ _Pragma("unroll") for (int bj = 0; bj < 2; ++bj)
struct EpiIn {
    bf16_t *zrg, *zqkv, *zg; const float* ssq;
    __device__ __forceinline__ void operator()(const AccT& acc, const pg8::Unit& u, int wr, int wc, int fr, int fq) const {
        bf16_t* base; int ld, colt;
        if (u.pn < 8) { base = zrg; ld = LDZ_RG; colt = u.pn * 256; } else if (u.pn < 14) { base = zqkv; ld = LDZ_QKV; colt = (u.pn - 8) * 256; } else { base = zg; ld = LDZ_G; colt = (u.pn - 14) * 256; }
        const int row0 = u.pm * 256 + wr * 64 + fr, col0 = colt + wc * 32 + 8 * fq;
        float sv[2][4];
        EPI_LOOP_ROWS sv[ai][m] = ssq[row0 + ai * 128 + m * 16];
        EPI_LOOP_ROWS { const int row = row0 + ai * 128 + m * 16; const float s = __builtin_amdgcn_rsqf(sv[ai][m] * (1.f / DM) + EPS); bf16_t* rowp = base + (size_t)row * ld + col0;
            EPI_BJ *(u32x4*)(rowp + bj * 128) = pack8(acc[ai][bj][m][0] * s, acc[ai][bj][m][1] * s); }
    }
};
struct EpiMerge {
    const bf16_t* ga; const bf16_t* gb; int ldg; bf16_t* O; int ldo;
    __device__ __forceinline__ void mid(AccT& acc, const pg8::Unit& u, int wr, int wc, int fr, int fq) const {
        int row0 = u.pm * 256 + wr * 64 + fr, col0 = u.pn * 256 + wc * 32 + 8 * fq;
        asm volatile("" : "+v"(row0), "+v"(col0));
        u32x4 av[2][2][2], bv[2][2][2];
#pragma unroll
        for (int b = 0; b < 5; ++b) {
            if (b < 4) {
#pragma unroll
                for (int mm = 0; mm < 2; ++mm) EPI_BJ { const size_t off = (size_t)(row0 + (b >> 1) * 128 + (2 * (b & 1) + mm) * 16) * ldg + col0 + bj * 128; av[b & 1][mm][bj] = *(const u32x4*)(ga + off); bv[b & 1][mm][bj] = *(const u32x4*)(gb + off); }
            }
            if (b >= 1) { const int c = b - 1, ai = c >> 1;
#pragma unroll
                for (int mm = 0; mm < 2; ++mm) { const int m = 2 * (c & 1) + mm;
                    EPI_BJ { f32x4 a0, a1, b0, b1; unpack8(av[c & 1][mm][bj], a0, a1); unpack8(bv[c & 1][mm][bj], b0, b1);
                        acc[ai][bj][m][0] *= (expnegv(b0) + 1.f) * rcpv(exp2v(a0 * -1.44269504f) + 1.f);
                        acc[ai][bj][m][1] *= (expnegv(b1) + 1.f) * rcpv(exp2v(a1 * -1.44269504f) + 1.f); }
                    asm volatile("" : "+v"(acc[ai][0][m][0]), "+v"(acc[ai][0][m][1]), "+v"(acc[ai][1][m][0]), "+v"(acc[ai][1][m][1]) :: "memory"); }
            }
        }
    }
    __device__ __forceinline__ void operator()(const AccT& acc, const pg8::Unit& u, int wr, int wc, int fr, int fq) const {
        const int row0 = u.pm * 256 + wr * 64 + fr, col0 = u.pn * 256 + wc * 32 + 8 * fq;
        u32x4 bv[2][4][2];
        EPI_LOOP_ROWS EPI_BJ bv[ai][m][bj] = *(const u32x4*)(gb + (size_t)(row0 + ai * 128 + m * 16) * ldg + col0 + bj * 128);
        EPI_LOOP_ROWS EPI_BJ { f32x4 b0, b1; unpack8(bv[ai][m][bj], b0, b1);
            const f32x4 v0 = acc[ai][bj][m][0] * rcpv(expnegv(b0) + 1.f), v1 = acc[ai][bj][m][1] * rcpv(expnegv(b1) + 1.f);
            *(u32x4*)(O + (size_t)(row0 + ai * 128 + m * 16) * ldo + col0 + bj * 128) = pack8(v0, v1); }
    }
};
template <int NB  > struct EpiRes {
    const bf16_t* rbf; bf16_t* xb; float* ssq;
    __device__ __forceinline__ void operator()(const AccT& acc, const pg8::Unit& u, int wr, int wc, int fr, int fq) const {
        const int row0 = u.pm * 256 + wr * 64 + fr, col0 = u.pn * 256 + wc * 32 + 8 * fq;
#pragma unroll
        for (int h = 0; h < NB; ++h) {
            u32x4 rb[2][4][2];
#pragma unroll
            for (int ai = (NB == 2 ? h : 0); ai < (NB == 2 ? h + 1 : 2); ++ai) EPI_M EPI_BJ rb[ai][m][bj] = *(const u32x4*)(rbf + (size_t)(row0 + ai * 128 + m * 16) * DM + col0 + bj * 128);
#pragma unroll
            for (int ai = (NB == 2 ? h : 0); ai < (NB == 2 ? h + 1 : 2); ++ai) EPI_M { const int row = row0 + ai * 128 + m * 16; float sq = 0.f;
                EPI_BJ { const size_t off = (size_t)row * DM + col0 + bj * 128; f32x4 r0, r1; unpack8(rb[ai][m][bj], r0, r1);
                    const f32x4 v0 = acc[ai][bj][m][0] + r0, v1 = acc[ai][bj][m][1] + r1;
                    *(u32x4*)(xb + off) = pack8(v0, v1);
                    const f32x4 q4 = v0 * v0 + v1 * v1; sq += (q4[0] + q4[1]) + (q4[2] + q4[3]); }
                sq += __shfl_xor(sq, 16); sq += __shfl_xor(sq, 32);
                if (fq == 0) unsafeAtomicAdd(ssq + row, sq); }
        }
    }
};
struct EpiUp {
    const float* ssq; bf16_t* O;
    __device__ __forceinline__ void operator()(const AccT& acc, const pg8::Unit& u, int wr, int wc, int fr, int fq) const {
        const int row0 = u.pm * 256 + wr * 64 + fr, col0 = u.pn * 256 + wc * 32 + 8 * fq;
        float sv[2][4];
        EPI_LOOP_ROWS sv[ai][m] = ssq[row0 + ai * 128 + m * 16];
        EPI_LOOP_ROWS { const int row = row0 + ai * 128 + m * 16; const float s = __builtin_amdgcn_rsqf(sv[ai][m] * (1.f / DM) + EPS);
            EPI_BJ { const f32x4 r0 = maxv(acc[ai][bj][m][0] * s, 0.f), r1 = maxv(acc[ai][bj][m][1] * s, 0.f);
                *(u32x4*)(O + (size_t)row * DFF + col0 + bj * 128) = pack8(r0 * r0, r1 * r1); } }
    }
};
struct EpiPlain {
    bf16_t* O;
    __device__ __forceinline__ void operator()(const AccT& acc, const pg8::Unit& u, int wr, int wc, int fr, int fq) const {
        const int row0 = u.pm * 256 + wr * 64 + fr, col0 = u.pn * 256 + wc * 32 + 8 * fq;
        EPI_LOOP_ROWS { const int row = row0 + ai * 128 + m * 16;
            EPI_BJ *(u32x4*)(O + (size_t)row * DM + col0 + bj * 128) = pack8(acc[ai][bj][m][0], acc[ai][bj][m][1]); }
    }
};
struct EpiFinal {
    const float* ssq; const bf16_t* Eb; const bf16_t* xin; float* out;
    __device__ __forceinline__ void operator()(const AccT& acc, const pg8::Unit& u, int wr, int wc, int fr, int fq) const {
        const int row0 = u.pm * 256 + wr * 64 + fr, col0 = u.pn * 256 + wc * 32 + 8 * fq;
        float sv[2][4];
        EPI_LOOP_ROWS sv[ai][m] = ssq[row0 + ai * 128 + m * 16];
        u32x4 xv[2][2][2], ev[2][2][2];
#pragma unroll
        for (int b = 0; b < 5; ++b) {
            if (b < 4) {
#pragma unroll
                for (int mm = 0; mm < 2; ++mm) EPI_BJ { const size_t off = (size_t)(row0 + (b >> 1) * 128 + (2 * (b & 1) + mm) * 16) * DM + col0 + bj * 128; xv[b & 1][mm][bj] = *(const u32x4*)(xin + off); ev[b & 1][mm][bj] = *(const u32x4*)(Eb + off); }
            }
            if (b >= 1) { const int c = b - 1, ai = c >> 1;
#pragma unroll
                for (int mm = 0; mm < 2; ++mm) { const int m = 2 * (c & 1) + mm; const float sc = __builtin_amdgcn_rsqf(sv[ai][m] * (1.f / DM) + EPS);
                    EPI_BJ { const size_t off = (size_t)(row0 + ai * 128 + m * 16) * DM + col0 + bj * 128; f32x4 e0, e1, v0, v1; unpack8(ev[c & 1][mm][bj], e0, e1); unpack8(xv[c & 1][mm][bj], v0, v1);
                        const float nsc = -1.44269504f * sc;
                        v0 += e0 * rcpv(exp2v(acc[ai][bj][m][0] * nsc) + 1.f); v1 += e1 * rcpv(exp2v(acc[ai][bj][m][1] * nsc) + 1.f);
                        __builtin_nontemporal_store(v0, (f32x4*)(out + off)); __builtin_nontemporal_store(v1, (f32x4*)(out + off + 4)); } }
            }
        }
    }
};

__device__ __forceinline__ float wave_sum(float v) {
#pragma unroll
    for (int o = 1; o < 64; o <<= 1) v += __shfl_xor(v, o);
    return v;
}
__device__ __forceinline__ void p0_transpose_item(const float* W, int K, int N, bf16_t* WT, const float* g, LAS float* scr, int item, int lane) {
    const int nblk = N / 32, kb = item / nblk, nb = item % nblk, k0 = 64 * kb, n0 = 32 * nb;
#pragma unroll
    for (int i = 0; i < 32; ++i) { const int kk = 2 * i + (lane >> 5); const float gv = g ? g[k0 + kk] : 1.f; scr[kk * 33 + (lane & 31)] = __builtin_nontemporal_load(W + (size_t)(k0 + kk) * N + n0 + (lane & 31)) * gv; }
    asm volatile("s_waitcnt lgkmcnt(0)" ::: "memory");
    const int c = lane & 7;
#pragma unroll
    for (int j = 0; j < 4; ++j) { const int n = (lane >> 3) + 8 * j; const LAS float* s = scr + (8 * c) * 33 + n;
        u32x4 o; o.x = cvt_pk_bf16(s[0 * 33], s[1 * 33]); o.y = cvt_pk_bf16(s[2 * 33], s[3 * 33]); o.z = cvt_pk_bf16(s[4 * 33], s[5 * 33]); o.w = cvt_pk_bf16(s[6 * 33], s[7 * 33]);
        *(u32x4*)(WT + (size_t)(n0 + n) * K + k0 + 8 * c) = o; }
    asm volatile("s_waitcnt lgkmcnt(0)" ::: "memory");
}

struct Args { const float* in[23]; float* out; unsigned char* ws; int ph_lo, ph_hi; };
enum { I_X = 0, I_P, I_GMIX, I_WIN, I_CONVW, I_CONVB, I_WRG, I_BRG, I_WIG, I_BIG, I_LAM, I_WRNN, I_QG, I_KG, I_SINK, I_WATT, I_WOUT, I_GMLP, I_WUP, I_WDN, I_GPLE, I_WGATE, I_WPLE };

__device__ __forceinline__ void convert_p(const Args& a, int G) {
    const int gt = blockIdx.x * 512 + threadIdx.x, NT = G * 512;
    const f32x4* p4 = (const f32x4*)a.in[I_P]; u32x2* pb = (u32x2*)(a.ws + WS_PB);
    for (int i = gt; i < M * PLE / 4; i += 4 * NT) { f32x4 v[4];
#pragma unroll
        for (int q = 0; q < 4; ++q) v[q] = (i + q * NT < M * PLE / 4) ? __builtin_nontemporal_load(p4 + i + q * NT) : (f32x4){0.f, 0.f, 0.f, 0.f};
#pragma unroll
        for (int q = 0; q < 4; ++q) if (i + q * NT < M * PLE / 4) { u32x2 w; w.x = cvt_pk_bf16(v[q].x, v[q].y); w.y = cvt_pk_bf16(v[q].z, v[q].w); __builtin_nontemporal_store(w, pb + i + q * NT); } }
}

enum { WJ_IN = 1, WJ_RNN = 2, WJ_ATT = 4, WJ_OUT = 8, WJ_UP = 16, WJ_DN = 32, WJ_GATE = 64, WJ_PLE = 128, WJ_RG = 256, WJ_IG = 512 };
template <unsigned MASK> __device__ __forceinline__ void convert_weights(const Args& a, LAS unsigned char* lds, int G) {
    const int tid = threadIdx.x, lane = tid & 63, wave = tid >> 6;
    unsigned char* ws = a.ws;
    LAS float* scr = (LAS float*)(lds + wave * 16384);
    const int gw = blockIdx.x * 8 + wave, NGW = G * 8;
    constexpr int N0 = (DM / 64) * (NIN / 32), N1 = (DM / 64) * (DM / 32), N5 = (DM / 64) * (DFF / 32), N6 = (DFF / 64) * (DM / 32), N8 = (PLE / 64) * (DM / 32), N9 = 32;
    constexpr int C_IN = (MASK & WJ_IN) ? N0 : 0, C_RNN = (MASK & WJ_RNN) ? N1 : 0, C_ATT = (MASK & WJ_ATT) ? N1 : 0, C_OUT = (MASK & WJ_OUT) ? N1 : 0, C_UP = (MASK & WJ_UP) ? N5 : 0,
                  C_DN = (MASK & WJ_DN) ? N6 : 0, C_GATE = (MASK & WJ_GATE) ? N1 : 0, C_PLE = (MASK & WJ_PLE) ? N8 : 0, C_RG = (MASK & WJ_RG) ? N9 : 0, C_IG = (MASK & WJ_IG) ? N9 : 0;
    constexpr int NITEMS = C_IN + C_RNN + C_ATT + C_OUT + C_UP + C_DN + C_GATE + C_PLE + C_RG + C_IG;
    for (int it = gw; it < NITEMS; it += NGW) {
        int r = it;
        if (r < C_IN) { p0_transpose_item(a.in[I_WIN], DM, NIN, (bf16_t*)(ws + WS_WIN), a.in[I_GMIX], scr, r, lane); continue; } r -= C_IN;
        if (r < C_RNN) { p0_transpose_item(a.in[I_WRNN], DM, DM, (bf16_t*)(ws + WS_WRNN), nullptr, scr, r, lane); continue; } r -= C_RNN;
        if (r < C_ATT) { p0_transpose_item(a.in[I_WATT], DM, DM, (bf16_t*)(ws + WS_WATT), nullptr, scr, r, lane); continue; } r -= C_ATT;
        if (r < C_OUT) { p0_transpose_item(a.in[I_WOUT], DM, DM, (bf16_t*)(ws + WS_WOUT), nullptr, scr, r, lane); continue; } r -= C_OUT;
        if (r < C_UP) { p0_transpose_item(a.in[I_WUP], DM, DFF, (bf16_t*)(ws + WS_WUP), a.in[I_GMLP], scr, r, lane); continue; } r -= C_UP;
        if (r < C_DN) { p0_transpose_item(a.in[I_WDN], DFF, DM, (bf16_t*)(ws + WS_WDN), nullptr, scr, r, lane); continue; } r -= C_DN;
        if (r < C_GATE) { p0_transpose_item(a.in[I_WGATE], DM, DM, (bf16_t*)(ws + WS_WGATE), a.in[I_GPLE], scr, r, lane); continue; } r -= C_GATE;
        if (r < C_PLE) { p0_transpose_item(a.in[I_WPLE], PLE, DM, (bf16_t*)(ws + WS_WPLE), nullptr, scr, r, lane); continue; } r -= C_PLE;
        if (r < C_RG) { p0_transpose_item(a.in[I_WRG] + (size_t)(r >> 1) * 4096, 64, 64, (bf16_t*)(ws + WS_WRG) + (size_t)(r >> 1) * 4096, nullptr, scr, r & 1, lane); continue; } r -= C_RG;
        if (r < C_IG) p0_transpose_item(a.in[I_WIG] + (size_t)(r >> 1) * 4096, 64, 64, (bf16_t*)(ws + WS_WIG) + (size_t)(r >> 1) * 4096, nullptr, scr, r & 1, lane);
    }
}

__device__ __forceinline__ void p0_prologue(const Args& a, LAS unsigned char* lds, int G) {
    const int tid = threadIdx.x, lane = tid & 63, wave = tid >> 6;
    unsigned char* ws = a.ws;
    const int gw = blockIdx.x * 8 + wave, NGW = G * 8;
    convert_weights<WJ_IN>(a, lds, G);
    const float* x = a.in[I_X]; bf16_t* XB = (bf16_t*)(ws + WS_XB); float* ssq0 = (float*)(ws + WS_SSQ0);
    for (int m4 = gw * 4; m4 < M; m4 += NGW * 4) {
        f32x4 v[4][4];
#pragma unroll
        for (int r = 0; r < 4; ++r) { const f32x4* xr = (const f32x4*)(x + (size_t)(m4 + r) * DM) + lane;
#pragma unroll
            for (int j = 0; j < 4; ++j) v[r][j] = __builtin_nontemporal_load(xr + 64 * j); }
#pragma unroll
        for (int r = 0; r < 4; ++r) { float s = 0.f;
#pragma unroll
            for (int j = 0; j < 4; ++j) s += (v[r][j].x * v[r][j].x + v[r][j].y * v[r][j].y) + (v[r][j].z * v[r][j].z + v[r][j].w * v[r][j].w);
            s = wave_sum(s); if (lane == 0) ssq0[m4 + r] = s;
            u32x2* o8 = (u32x2*)(XB + (size_t)(m4 + r) * DM) + lane;
#pragma unroll
            for (int j = 0; j < 4; ++j) { u32x2 w; w.x = cvt_pk_bf16(v[r][j].x, v[r][j].y); w.y = cvt_pk_bf16(v[r][j].z, v[r][j].w); o8[64 * j] = w; } }
    }
}
__device__ __forceinline__ void setup_misc(const Args& a, int G) {
    unsigned char* ws = a.ws;
    const int gt = blockIdx.x * 512 + threadIdx.x, NT = G * 512;
    { float* s1 = (float*)(ws + WS_SSQ1); float* s2 = (float*)(ws + WS_SSQ2); for (int i = gt; i < M; i += NT) { s1[i] = 0.f; s2[i] = 0.f; } }
    { float* ct = (float*)(ws + WS_COS); float* st = (float*)(ws + WS_SIN);
      for (int i = gt; i < SEQ * 32; i += NT) { const int pos = i >> 5, k = i & 31; const float inv = exp2f(-(float)k * 0.41524101186092029f); const float ang = (float)pos * inv; ct[i] = cosf(ang); st[i] = sinf(ang); } }
}

constexpr int R_XS = 0, R_GS = 18432, R_XCB = 36864, R_WR = 46080, R_WI = 55296, R_AF = 64512, R_BI = 81920, R_SEGP = 99328, R_SEGH = 101376, R_CARRY = 103424;
constexpr int RP = 144;
constexpr int FP = 68;
__device__ __forceinline__ void rnn_item(LAS unsigned char* lds, int item, const Args& a, bf16_t* yo, int ldy) {
    const int tid = threadIdx.x, lane = tid & 63, w = __builtin_amdgcn_readfirstlane(tid >> 6);
    const int b = item >> 4, blk = item & 15, c0 = blk * 64;
    bf16_t* zrg = (bf16_t*)(a.ws + WS_ZRG);
    const int c = lane, seg = w;
    const int lrow = tid >> 3, lpiece = tid & 7;
    { const bf16_t* wr = (const bf16_t*)(a.ws + WS_WRG) + blk * 4096; const bf16_t* wi = (const bf16_t*)(a.ws + WS_WIG) + blk * 4096;
      *(LAS u32x4*)(lds + R_WR + lrow * RP + lpiece * 16) = *(const u32x4*)(wr + lrow * 64 + lpiece * 8);
      *(LAS u32x4*)(lds + R_WI + lrow * RP + lpiece * 16) = *(const u32x4*)(wi + lrow * 64 + lpiece * 8); }
    const int ch = c0 + c;
    const float cw0 = a.in[I_CONVW][ch], cw1 = a.in[I_CONVW][1024 + ch], cw2 = a.in[I_CONVW][2048 + ch], cw3 = a.in[I_CONVW][3072 + ch], cb = a.in[I_CONVB][ch];
    float ebr[2], ebi[2], ec8[2];
#pragma unroll
    for (int q = 0; q < 2; ++q) { const int che = c0 + 16 * (2 * (w & 1) + q) + (lane & 15); ebr[q] = -1.44269504f * a.in[I_BRG][che]; ebi[q] = -1.44269504f * a.in[I_BIG][che]; ec8[q] = 1.44269504f * 8.f * log1pf(expf(-a.in[I_LAM][che])); }
    const size_t rowbase = (size_t)b * SEQ;
    const bf16_t* gx = zrg + (rowbase + lrow) * LDZ_RG + c0 + lpiece * 8;
    u32x4 xpre[2], gpre[2];
    xpre[0] = *(const u32x4*)gx; gpre[0] = *(const u32x4*)(gx + 1024);
    { const bf16_t* g1 = gx + (size_t)64 * LDZ_RG; xpre[1] = *(const u32x4*)g1; gpre[1] = *(const u32x4*)(g1 + 1024); }
    const int mt = w >> 1;
#pragma unroll 2
    for (int ci = 0; ci < SEQ / 64; ++ci) {
        const int cur = ci & 1;
        LAS unsigned char* XS = lds + R_XS + cur * 9216; LAS unsigned char* XSP = lds + R_XS + (cur ^ 1) * 9216; LAS unsigned char* GS = lds + R_GS + cur * 9216;
        *(LAS u32x4*)(XS + lrow * RP + lpiece * 16) = xpre[ci & 1]; *(LAS u32x4*)(GS + lrow * RP + lpiece * 16) = gpre[ci & 1];
        if (ci + 2 < SEQ / 64) { const bf16_t* gn = gx + (size_t)(ci + 2) * 64 * LDZ_RG; xpre[ci & 1] = *(const u32x4*)gn; gpre[ci & 1] = *(const u32x4*)(gn + 1024); }
        __syncthreads();
        float xv[11];
#pragma unroll
        for (int k = 0; k < 11; ++k) { const int rr = seg * 8 - 3 + k;
            if (rr >= 0) xv[k] = __uint_as_float((unsigned)*(const LAS unsigned short*)(XS + rr * RP + c * 2) << 16);
            else xv[k] = (ci > 0) ? __uint_as_float((unsigned)*(const LAS unsigned short*)(XSP + (64 + rr) * RP + c * 2) << 16) : 0.f; }
        float xc[8];
#pragma unroll
        for (int j = 0; j < 8; ++j) { xc[j] = (((cb + xv[j] * cw0) + xv[j + 1] * cw1) + xv[j + 2] * cw2) + xv[j + 3] * cw3;
            *(LAS unsigned short*)(lds + R_XCB + (seg * 8 + j) * RP + c * 2) = (unsigned short)(cvt_pk_bf16(xc[j], 0.f) & 0xffffu); }
        __syncthreads();
        {
            bf16x8 af[2];
#pragma unroll
            for (int ks = 0; ks < 2; ++ks) af[ks] = *(const LAS bf16x8*)(lds + R_XCB + (16 * mt + (lane & 15)) * RP + ks * 64 + (lane >> 4) * 16);
#pragma unroll
            for (int q = 0; q < 2; ++q) { const int nt = 2 * (w & 1) + q;
                f32x4 ar = (f32x4){0.f, 0.f, 0.f, 0.f}, ai = (f32x4){0.f, 0.f, 0.f, 0.f};
#pragma unroll
                for (int ks = 0; ks < 2; ++ks) { const int boff = (16 * nt + (lane & 15)) * RP + ks * 64 + (lane >> 4) * 16;
                    ar = __builtin_amdgcn_mfma_f32_16x16x32_bf16(af[ks], *(const LAS bf16x8*)(lds + R_WR + boff), ar, 0, 0, 0);
                    ai = __builtin_amdgcn_mfma_f32_16x16x32_bf16(af[ks], *(const LAS bf16x8*)(lds + R_WI + boff), ai, 0, 0, 0); }
#pragma unroll
                for (int e = 0; e < 4; e += 2) { const int t = 16 * mt + 4 * (lane >> 4) + e, cc = 16 * nt + (lane & 15);
                    typedef float f32x2 __attribute__((ext_vector_type(2)));
                    const f32x2 tr = (f32x2){ar[e], ar[e + 1]} * -1.44269504f + ebr[q], ti = (f32x2){ai[e], ai[e + 1]} * -1.44269504f + ebi[q];
                    const f32x2 dr = (f32x2){__builtin_amdgcn_exp2f(tr.x), __builtin_amdgcn_exp2f(tr.y)} + 1.f, di = (f32x2){__builtin_amdgcn_exp2f(ti.x), __builtin_amdgcn_exp2f(ti.y)} + 1.f;
                    const f32x2 r = {__builtin_amdgcn_rcpf(dr.x), __builtin_amdgcn_rcpf(dr.y)}, ig = {__builtin_amdgcn_rcpf(di.x), __builtin_amdgcn_rcpf(di.y)};
                    const f32x2 la2 = r * -ec8[q];
                    const f32x2 av = {__builtin_amdgcn_exp2f(la2.x), __builtin_amdgcn_exp2f(la2.y)};
                    const f32x2 m2 = 1.f - av * av;
                    const f32x2 bi = (f32x2){__builtin_amdgcn_sqrtf(m2.x), __builtin_amdgcn_sqrtf(m2.y)} * ig;
                    ((LAS float*)(lds + R_AF))[t * FP + cc] = av.x; ((LAS float*)(lds + R_AF))[(t + 1) * FP + cc] = av.y;
                    ((LAS float*)(lds + R_BI))[t * FP + cc] = bi.x; ((LAS float*)(lds + R_BI))[(t + 1) * FP + cc] = bi.y; } }
        }
        __syncthreads();
        float av[8], bv[8]; float P = 1.f, h = 0.f;
#pragma unroll
        for (int j = 0; j < 8; ++j) { av[j] = ((const LAS float*)(lds + R_AF))[(seg * 8 + j) * FP + c]; bv[j] = ((const LAS float*)(lds + R_BI))[(seg * 8 + j) * FP + c] * xc[j]; h = av[j] * h + bv[j]; P *= av[j]; }
        ((LAS float*)(lds + R_SEGP))[seg * 64 + c] = P; ((LAS float*)(lds + R_SEGH))[seg * 64 + c] = h;
        __syncthreads();
        float hin = (ci > 0) ? ((const LAS float*)(lds + R_CARRY))[cur * 64 + c] : 0.f;
        {
            float sp[7], sh[7];
#pragma unroll
            for (int s = 0; s < 7; ++s) { sp[s] = ((const LAS float*)(lds + R_SEGP))[s * 64 + c]; sh[s] = ((const LAS float*)(lds + R_SEGH))[s * 64 + c]; }
#pragma unroll
            for (int s = 0; s < 7; ++s) if (s < seg) hin = sp[s] * hin + sh[s];
        }
        h = hin;
        float hv[8];
#pragma unroll
        for (int j = 0; j < 8; ++j) { h = av[j] * h + bv[j]; hv[j] = h; }
#pragma unroll
        for (int j = 0; j < 8; j += 2) { typedef float f32x2 __attribute__((ext_vector_type(2)));
            const f32x2 gg = {__uint_as_float((unsigned)*(const LAS unsigned short*)(GS + (seg * 8 + j) * RP + c * 2) << 16), __uint_as_float((unsigned)*(const LAS unsigned short*)(GS + (seg * 8 + j + 1) * RP + c * 2) << 16)};
            const f32x2 wq = gg * (gg * gg * -0.10294324f + -2.3022082f);
            const f32x2 dn = (f32x2){__builtin_amdgcn_exp2f(wq.x), __builtin_amdgcn_exp2f(wq.y)} + 1.f;
            const f32x2 y = (f32x2){hv[j], hv[j + 1]} * gg * (f32x2){__builtin_amdgcn_rcpf(dn.x), __builtin_amdgcn_rcpf(dn.y)};
            *(LAS unsigned short*)(lds + R_XCB + (seg * 8 + j) * RP + c * 2) = (unsigned short)(cvt_pk_bf16(y.x, 0.f) & 0xffffu);
            *(LAS unsigned short*)(lds + R_XCB + (seg * 8 + j + 1) * RP + c * 2) = (unsigned short)(cvt_pk_bf16(y.y, 0.f) & 0xffffu); }
        if (seg == 7) ((LAS float*)(lds + R_CARRY))[(cur ^ 1) * 64 + c] = h;
        __syncthreads();
        *(u32x4*)(yo + (rowbase + (size_t)ci * 64 + lrow) * ldy + c0 + lpiece * 8) = *(const LAS u32x4*)(lds + R_XCB + lrow * RP + lpiece * 16);
    }
    __syncthreads();
}

constexpr int A_K = 0, A_V = 36864, KP = 144, VP = 520;
__device__ __forceinline__ void attn_kv_load(int item, const bf16_t* zq, int tid, u32x4 (&kr)[4], u32x2 (&vr)[8]) {
    const int b = item >> 6, n = (item >> 2) & 15, kvh = item & 3;
    const int key = tid >> 1, half = tid & 1; const int pos = (n - 1) * 128 + key;
    if (pos >= 0) {
        const bf16_t* kp = zq + (size_t)(b * SEQ + pos) * LDZ_QKV + 1024 + kvh * 64 + 16 * half;
        kr[0] = *(const u32x4*)kp; kr[1] = *(const u32x4*)(kp + 8); kr[2] = *(const u32x4*)(kp + 32); kr[3] = *(const u32x4*)(kp + 40);
    } else {
        const u32x4 z = (u32x4){0u, 0u, 0u, 0u};
#pragma unroll
        for (int i = 0; i < 4; ++i) kr[i] = z;
    }
    const int kp2 = tid >> 2, dq = tid & 3; const int vpos = (n - 1) * 128 + 2 * kp2;
    if (vpos >= 0) {
        const bf16_t* vp = zq + (size_t)(b * SEQ + vpos) * LDZ_QKV + 1280 + kvh * 64 + 4 * dq;
#pragma unroll
        for (int g = 0; g < 4; ++g) { vr[2 * g] = *(const u32x2*)(vp + 16 * g); vr[2 * g + 1] = *(const u32x2*)(vp + LDZ_QKV + 16 * g); }
    } else {
#pragma unroll
        for (int i = 0; i < 8; ++i) vr[i] = (u32x2){0u, 0u};
    }
}
__device__ __forceinline__ void attn_phase(LAS unsigned char* lds, const Args& a, bf16_t* oo, int ldo, int first, int step) {
    const int tid = threadIdx.x, lane = tid & 63, w = __builtin_amdgcn_readfirstlane(tid >> 6);
    const bf16_t* zq = (const bf16_t*)(a.ws + WS_ZQKV);
    const float* cosT = (const float*)(a.ws + WS_COS); const float* sinT = (const float*)(a.ws + WS_SIN);
    const int g = w >> 1, r = lane & 31, hh = lane >> 5;
    const float C2 = 0.125f * 1.44269504f;
    int item = first; if (item >= 1024) return;
    u32x4 kr[4]; u32x2 vr[8];
    attn_kv_load(item, zq, tid, kr, vr);
    for (; item < 1024; item += step) {
        const int b = item >> 6, n = (item >> 2) & 15, kvh = item & 3, head = kvh * 4 + g;
        u32x4 qr[2][4];
#pragma unroll
        for (int qt = 0; qt < 2; ++qt) { const bf16_t* qp = zq + (size_t)(b * SEQ + n * 128 + (w & 1) * 64 + qt * 32 + r) * LDZ_QKV + head * 64;
#pragma unroll
            for (int ks = 0; ks < 4; ++ks) qr[qt][ks] = *(const u32x4*)(qp + 16 * ks + 8 * hh); }
        {
            const int key = tid >> 1, half = tid & 1; const int pos = (n - 1) * 128 + key; const int posc = pos >= 0 ? pos : 0;
            float t1[16], t2[16];
            { f32x4 p, q; unpack8(kr[0], p, q); t1[0] = p[0]; t1[1] = p[1]; t1[2] = p[2]; t1[3] = p[3]; t1[4] = q[0]; t1[5] = q[1]; t1[6] = q[2]; t1[7] = q[3];
              unpack8(kr[1], p, q); t1[8] = p[0]; t1[9] = p[1]; t1[10] = p[2]; t1[11] = p[3]; t1[12] = q[0]; t1[13] = q[1]; t1[14] = q[2]; t1[15] = q[3];
              unpack8(kr[2], p, q); t2[0] = p[0]; t2[1] = p[1]; t2[2] = p[2]; t2[3] = p[3]; t2[4] = q[0]; t2[5] = q[1]; t2[6] = q[2]; t2[7] = q[3];
              unpack8(kr[3], p, q); t2[8] = p[0]; t2[9] = p[1]; t2[10] = p[2]; t2[11] = p[3]; t2[12] = q[0]; t2[13] = q[1]; t2[14] = q[2]; t2[15] = q[3]; }
            float ss = 0.f;
#pragma unroll
            for (int i = 0; i < 16; ++i) ss += t1[i] * t1[i] + t2[i] * t2[i];
            ss += __shfl_xor(ss, 1);
            const float rinv = __builtin_amdgcn_rsqf(ss * (1.f / 64.f) + EPS);
            const float* kg = a.in[I_KG] + 16 * half; const float* cp = cosT + posc * 32 + 16 * half; const float* sp = sinT + posc * 32 + 16 * half;
            float o1[16], o2[16];
#pragma unroll
            for (int i = 0; i < 16; ++i) { const float y1 = t1[i] * rinv * kg[i], y2 = t2[i] * rinv * kg[32 + i], cc = cp[i], sn = sp[i]; o1[i] = y1 * cc - y2 * sn; o2[i] = y2 * cc + y1 * sn; }
            LAS unsigned char* kd = lds + A_K + key * KP + 32 * half;
            *(LAS u32x4*)(kd) = pack8((f32x4){o1[0], o1[1], o1[2], o1[3]}, (f32x4){o1[4], o1[5], o1[6], o1[7]});
            *(LAS u32x4*)(kd + 16) = pack8((f32x4){o1[8], o1[9], o1[10], o1[11]}, (f32x4){o1[12], o1[13], o1[14], o1[15]});
            *(LAS u32x4*)(kd + 64) = pack8((f32x4){o2[0], o2[1], o2[2], o2[3]}, (f32x4){o2[4], o2[5], o2[6], o2[7]});
            *(LAS u32x4*)(kd + 80) = pack8((f32x4){o2[8], o2[9], o2[10], o2[11]}, (f32x4){o2[12], o2[13], o2[14], o2[15]});
            const int kp2 = tid >> 2, dq = tid & 3;
            LAS unsigned char* vd = lds + A_V + (4 * dq) * VP + kp2 * 4;
#pragma unroll
            for (int g = 0; g < 4; ++g) { const unsigned a0 = vr[2 * g].x, a1 = vr[2 * g].y, b0 = vr[2 * g + 1].x, b1 = vr[2 * g + 1].y;
                *(LAS unsigned*)(vd + (16 * g + 0) * VP) = (a0 & 0xffffu) | (b0 << 16);
                *(LAS unsigned*)(vd + (16 * g + 1) * VP) = (a0 >> 16) | (b0 & 0xffff0000u);
                *(LAS unsigned*)(vd + (16 * g + 2) * VP) = (a1 & 0xffffu) | (b1 << 16);
                *(LAS unsigned*)(vd + (16 * g + 3) * VP) = (a1 >> 16) | (b1 & 0xffff0000u); }
        }
        __syncthreads();
        if (item + step < 1024) attn_kv_load(item + step, zq, tid, kr, vr);
        const float sink2 = a.in[I_SINK][head] * 1.44269504f;
#pragma unroll
        for (int qt = 0; qt < 2; ++qt) {
            const int m0 = (w & 1) * 64 + qt * 32, i0 = m0 >> 5, q = m0 + r; const int pos = n * 128 + q;
            bf16_t* op = oo + (size_t)(b * SEQ + pos) * ldo + head * 64;
            float v[4][8];
#pragma unroll
            for (int ks = 0; ks < 4; ++ks) { f32x4 p0, p1; unpack8(qr[qt][ks], p0, p1);
                v[ks][0] = p0[0]; v[ks][1] = p0[1]; v[ks][2] = p0[2]; v[ks][3] = p0[3]; v[ks][4] = p1[0]; v[ks][5] = p1[1]; v[ks][6] = p1[2]; v[ks][7] = p1[3]; }
            float ss = 0.f;
#pragma unroll
            for (int ks = 0; ks < 4; ++ks)
#pragma unroll
                for (int j = 0; j < 8; ++j) ss += v[ks][j] * v[ks][j];
            ss += __shfl_xor(ss, 32);
            const float rinv = __builtin_amdgcn_rsqf(ss * (1.f / 64.f) + EPS) * C2;
            bf16x8 qf[4];
#pragma unroll
            for (int ks = 0; ks < 2; ++ks) { const int dl = 16 * ks + 8 * hh; float o1[8], o2[8];
#pragma unroll
                for (int j = 0; j < 8; ++j) { const float y1 = v[ks][j] * rinv * a.in[I_QG][dl + j], y2 = v[ks + 2][j] * rinv * a.in[I_QG][32 + dl + j], cc = cosT[pos * 32 + dl + j], sn = sinT[pos * 32 + dl + j];
                    o1[j] = y1 * cc - y2 * sn; o2[j] = y2 * cc + y1 * sn; }
                u32x4 w1 = pack8((f32x4){o1[0], o1[1], o1[2], o1[3]}, (f32x4){o1[4], o1[5], o1[6], o1[7]}), w2 = pack8((f32x4){o2[0], o2[1], o2[2], o2[3]}, (f32x4){o2[4], o2[5], o2[6], o2[7]});
                qf[ks] = __builtin_bit_cast(bf16x8, w1); qf[ks + 2] = __builtin_bit_cast(bf16x8, w2); }
            f32x16 sacc[5];
#pragma unroll
            for (int t = 0; t < 5; ++t) { const int kt = i0 + t;
                const f32x16 zero16 = {0.f, 0.f, 0.f, 0.f, 0.f, 0.f, 0.f, 0.f, 0.f, 0.f, 0.f, 0.f, 0.f, 0.f, 0.f, 0.f};
#pragma unroll
                for (int ks = 0; ks < 4; ++ks) sacc[t] = __builtin_amdgcn_mfma_f32_32x32x16_bf16(*(const LAS bf16x8*)(lds + A_K + (32 * kt + r) * KP + ks * 32 + hh * 16), qf[ks], ks == 0 ? zero16 : sacc[t], 0, 0, 0); }
            const float NEG = -INFINITY;
#pragma unroll
            for (int e = 0; e < 16; ++e) { const int kr_ = (e & 3) + 8 * (e >> 2) + 4 * hh;
                if (!(kr_ > r)) sacc[0][e] = NEG;
                if (!(kr_ <= r)) sacc[4][e] = NEG; }
            if (n == 0) {
#pragma unroll
                for (int t = 0; t < 4; ++t) if (i0 + t < 4) {
#pragma unroll
                    for (int e = 0; e < 16; ++e) sacc[t][e] = NEG; } }
            float mx = NEG;
#pragma unroll
            for (int t = 0; t < 5; ++t)
#pragma unroll
                for (int e = 0; e < 16; ++e) mx = fmaxf(mx, sacc[t][e]);
            mx = fmaxf(mx, __shfl_xor(mx, 32));
            mx = fmaxf(mx, sink2);
            typedef float f32x2v __attribute__((ext_vector_type(2)));
            f32x2v sum2 = {0.f, 0.f};
#pragma unroll
            for (int t = 0; t < 5; ++t)
#pragma unroll
                for (int e = 0; e < 16; e += 2) { const float p0 = __builtin_amdgcn_exp2f(sacc[t][e] - mx), p1 = __builtin_amdgcn_exp2f(sacc[t][e + 1] - mx); sacc[t][e] = p0; sacc[t][e + 1] = p1; sum2 += (f32x2v){p0, p1}; }
            float sum = sum2.x + sum2.y;
            sum += __shfl_xor(sum, 32);
            const float rden = 1.f / (sum + __builtin_amdgcn_exp2f(sink2 - mx));
            f32x16 oacc[2];
#pragma unroll
            for (int t = 0; t < 5; ++t) { const int kt = i0 + t;
#pragma unroll
                for (int s2 = 0; s2 < 2; ++s2) {
                    u32x4 pw; pw.x = cvt_pk_bf16(sacc[t][8 * s2 + 0], sacc[t][8 * s2 + 1]); pw.y = cvt_pk_bf16(sacc[t][8 * s2 + 2], sacc[t][8 * s2 + 3]); pw.z = cvt_pk_bf16(sacc[t][8 * s2 + 4], sacc[t][8 * s2 + 5]); pw.w = cvt_pk_bf16(sacc[t][8 * s2 + 6], sacc[t][8 * s2 + 7]);
                    const bf16x8 pf = __builtin_bit_cast(bf16x8, pw);
#pragma unroll
                    for (int dt = 0; dt < 2; ++dt) { const LAS unsigned char* vb = lds + A_V + (32 * dt + r) * VP + (32 * kt + 16 * s2 + 4 * hh) * 2;
                        const s16x4 lo = *(const LAS s16x4*)vb, hi = *(const LAS s16x4*)(vb + 16);
                        const bf16x8 vf = __builtin_shufflevector(lo, hi, 0, 1, 2, 3, 4, 5, 6, 7);
                        const f32x16 zero16 = {0.f, 0.f, 0.f, 0.f, 0.f, 0.f, 0.f, 0.f, 0.f, 0.f, 0.f, 0.f, 0.f, 0.f, 0.f, 0.f};
                        oacc[dt] = __builtin_amdgcn_mfma_f32_32x32x16_bf16(vf, pf, (t == 0 && s2 == 0) ? zero16 : oacc[dt], 0, 0, 0); } } }
#pragma unroll
            for (int dt = 0; dt < 2; ++dt)
#pragma unroll
                for (int gq = 0; gq < 4; ++gq) { u32x2 ow; ow.x = cvt_pk_bf16(oacc[dt][4 * gq + 0] * rden, oacc[dt][4 * gq + 1] * rden); ow.y = cvt_pk_bf16(oacc[dt][4 * gq + 2] * rden, oacc[dt][4 * gq + 3] * rden);
                    *(u32x2*)(op + 32 * dt + 8 * gq + 4 * hh) = ow; }
        }
        __syncthreads();
    }
}

#define XB_TMO      128
#define XB_XCNT(j)  (256  + 64 * (j))
#define XB_XSUB(j)  (1280 + 64 * (j))
#define XB_XGEN(j)  (2304 + 64 * (j))
#define XB_TOP      3328
#define XB_TOPGEN   3392
#define XCD_BAR_WORDS 3456
#define XB_SPIN_CAP (1u << 18)
__device__ __forceinline__ unsigned xb_ld(unsigned* p)              { return __hip_atomic_load(p, __ATOMIC_RELAXED, __HIP_MEMORY_SCOPE_AGENT); }
__device__ __forceinline__ unsigned xb_add(unsigned* p, unsigned v) { return __hip_atomic_fetch_add(p, v, __ATOMIC_RELAXED, __HIP_MEMORY_SCOPE_AGENT); }
__device__ __forceinline__ unsigned xb_xcc_id() { return (unsigned)__builtin_amdgcn_s_getreg((3 << 11) | 20) & 0xFu; }
#define XB_SPIN(cond, bar) do { unsigned _sp = 0; while (cond) { __builtin_amdgcn_s_sleep(1); \
    if ((++_sp & 255u) == 0u) { if (xb_ld(&(bar)[XB_TMO])) break; if (_sp > XB_SPIN_CAP) { atomicAdd(&(bar)[XB_TMO], 1u); break; } } } } while (0)
struct XcdBarrier { unsigned* bar; unsigned x; volatile LAS unsigned* st; };
__device__ __forceinline__ XcdBarrier xcd_barrier_post(unsigned* bar, volatile LAS unsigned* st) {
    XcdBarrier b; b.bar = bar; b.x = xb_xcc_id(); b.st = st;
    if (threadIdx.x == 0) (void)xb_add(&bar[XB_XCNT(b.x)], 1u);
    return b;
}
__device__ __forceinline__ void xcd_barrier_complete(unsigned* bar, unsigned x, unsigned& nloc, unsigned& nx) {
    const unsigned G = gridDim.x * gridDim.y * gridDim.z;
    unsigned sum, cnt, mine, sp = 0u;
    for (;;) {
        sum = 0u; cnt = 0u; mine = 0u;
#pragma unroll
        for (unsigned j = 0; j < 16; ++j) { const unsigned c = xb_ld(&bar[XB_XCNT(j)]); sum += c; cnt += (c > 0u) ? 1u : 0u; mine = (j == x) ? c : mine; }
        if (sum == G) break;
        __builtin_amdgcn_s_sleep(1);
        if ((++sp & 255u) == 0u) { if (xb_ld(&bar[XB_TMO])) break; if (sp > XB_SPIN_CAP) { atomicAdd(&bar[XB_TMO], 1u); break; } }
    }
    nloc = mine > 0u ? mine : 1u; nx = cnt > 0u ? cnt : 1u;
}
__device__ __forceinline__ void xcd_barrier(const XcdBarrier& b) {
    asm volatile("s_waitcnt vmcnt(0)" ::: "memory");
    __syncthreads();
    if (threadIdx.x == 0) {
        unsigned* bar = b.bar;
        __builtin_amdgcn_s_waitcnt(0);
        unsigned nloc = b.st[0], nx = b.st[1]; const unsigned xg = b.st[3];
        if (nloc == 0u) { xcd_barrier_complete(bar, b.x, nloc, nx); b.st[0] = nloc; b.st[1] = nx; }
        const unsigned old = xb_add(&bar[XB_XSUB(b.x)], 1u);
        const unsigned gen = old / nloc;
        if (old + 1u == (gen + 1u) * nloc) {
            __builtin_amdgcn_fence(__ATOMIC_RELEASE, "agent");
            asm volatile("s_waitcnt vmcnt(0)" ::: "memory");
            const unsigned og = xb_add(&bar[XB_TOP], 1u);
            const unsigned tg = og / nx;
            if (og + 1u == (tg + 1u) * nx) xb_add(&bar[XB_TOPGEN], 1u);
            else XB_SPIN(xb_ld(&bar[XB_TOPGEN]) == tg, bar);
            __builtin_amdgcn_fence(__ATOMIC_ACQUIRE, "agent");
            xb_add(&bar[XB_XGEN(b.x)], 1u);
            asm volatile("s_waitcnt vmcnt(0)" ::: "memory");
        } else {
            XB_SPIN(xb_ld(&bar[XB_XGEN(b.x)]) == xg, bar);
            __builtin_amdgcn_fence(__ATOMIC_ACQUIRE, "agent");
            asm volatile("s_waitcnt vmcnt(0)" ::: "memory");
        }
        b.st[3] = xg + 1u;
    }
    __syncthreads();
}
__device__ __forceinline__ void xcd_arrive(const XcdBarrier& b) {
    asm volatile("s_waitcnt vmcnt(0)" ::: "memory");
    __syncthreads();
    if (threadIdx.x == 0) {
        unsigned* bar = b.bar;
        __builtin_amdgcn_s_waitcnt(0);
        unsigned nloc = b.st[0], nx = b.st[1];
        if (nloc == 0u) { xcd_barrier_complete(bar, b.x, nloc, nx); b.st[0] = nloc; b.st[1] = nx; }
        const unsigned old = xb_add(&bar[XB_XSUB(b.x)], 1u);
        const unsigned gen = old / nloc;
        b.st[2] = gen;
        if (old + 1u == (gen + 1u) * nloc) {
            __builtin_amdgcn_fence(__ATOMIC_RELEASE, "agent");
            asm volatile("s_waitcnt vmcnt(0)" ::: "memory");
            const unsigned og = xb_add(&bar[XB_TOP], 1u);
            const unsigned tg = og / nx;
            if (og + 1u == (tg + 1u) * nx) xb_add(&bar[XB_TOPGEN], 1u);
        }
    }
}
__device__ __forceinline__ void xcd_wait(const XcdBarrier& b) {
    __syncthreads();
    if (threadIdx.x == 0) {
        unsigned* bar = b.bar;
        const unsigned gen = b.st[2];
        XB_SPIN(xb_ld(&bar[XB_TOPGEN]) == gen, bar);
        __builtin_amdgcn_fence(__ATOMIC_ACQUIRE, "agent");
        asm volatile("s_waitcnt vmcnt(0)" ::: "memory");
    }
    __syncthreads();
}

__global__ void __launch_bounds__(512) fwd_megakernel(Args a) {
    extern __shared__ __attribute__((aligned(16))) unsigned char lds_raw[];
    LAS unsigned char* lds = (LAS unsigned char*)lds_raw;
    cg::grid_group grid = cg::this_grid();
    const int G = gridDim.x, lo = a.ph_lo, hi = a.ph_hi;
    unsigned char* ws = a.ws;
    float* ssq0 = (float*)(ws + WS_SSQ0); float* ssq1 = (float*)(ws + WS_SSQ1); float* ssq2 = (float*)(ws + WS_SSQ2);
    bf16_t* XB = (bf16_t*)(ws + WS_XB); bf16_t* PB = (bf16_t*)(ws + WS_PB); bf16_t* ZRG = (bf16_t*)(ws + WS_ZRG); bf16_t* ZQKV = (bf16_t*)(ws + WS_ZQKV); bf16_t* ZG = (bf16_t*)(ws + WS_ZG);
    bf16_t* U = (bf16_t*)(ws + WS_U);
#define IN(k) (lo <= (k) && (k) < hi)
#define SEAM(k) do { if (IN(k) && IN((k) + 1)) xcd_barrier(bar); } while (0)
#define SEAM_FILL(k, filler) do { if (IN(k) && IN((k) + 1)) xcd_arrive(bar); if (IN(k)) { filler; } if (IN(k) && IN((k) + 1)) xcd_wait(bar); } while (0)
    volatile LAS unsigned* MISC = (volatile LAS unsigned*)(lds + 131072);
    if (threadIdx.x < 32) MISC[threadIdx.x] = 0u;
    __syncthreads();
    XcdBarrier bar; bar.bar = (unsigned*)(ws + WS_BAR); bar.x = 0; bar.st = MISC + 8;
    if (hi - lo > 1) bar = xcd_barrier_post((unsigned*)(ws + WS_BAR), MISC + 8);
    if (hi > 1000) grid.sync();
    if (IN(0)) {
#pragma nounroll
        for (int rep = 0; rep < (PROBE_MODE == 4 ? 2 : 1); ++rep) { p0_prologue(a, lds, G); __syncthreads(); }
    }
#if PROBE_MODE == 7
    for (int i = 0; i < 8; ++i) grid.sync();
#endif
    SEAM_FILL(0, (convert_weights<WJ_RNN | WJ_ATT | WJ_OUT | WJ_RG | WJ_IG | WJ_PLE>(a, lds, G), setup_misc(a, G)));
    if (IN(1)) { pg8::Gemm g{XB, (const bf16_t*)(ws + WS_WIN), M, NIN, DM, DM, DM, nullptr, nullptr, 0}; pg8::StaticOrder S; S.init(M, NIN, G, (int)blockIdx.x);
        EpiIn E{ZRG, ZQKV, ZG, ssq0}; pg8::gemm_phase(lds, g, S, E);
#if PROBE_MODE == 3
        pg8::gemm_phase(lds, g, S, E);
#endif
    }
    SEAM_FILL(1, convert_p(a, G));
    if (IN(2)) {
        attn_phase(lds, a, ZQKV, LDZ_QKV, (int)blockIdx.x, G);
        for (int it = blockIdx.x; it < 256; it += G) rnn_item(lds, it, a, ZRG + 1024, LDZ_RG);
#if PROBE_MODE == 1
        for (int it = blockIdx.x; it < 256; it += G) rnn_item(lds, it, a, XB, DM);
#elif PROBE_MODE == 2
        attn_phase(lds, a, XB, DM, (int)blockIdx.x, G);
#endif
    }
    SEAM_FILL(2, (convert_weights<WJ_UP>(a, lds, G)));
    bf16_t* XC = (bf16_t*)(ws + WS_XC);
    if (IN(3)) { pg8::Gemm g{ZRG + 1024, (const bf16_t*)(ws + WS_WRNN), M, DM, DM, LDZ_RG, DM, ZQKV, (const bf16_t*)(ws + WS_WATT), LDZ_QKV}; pg8::StaticOrder S; S.init(M, DM, G, (int)blockIdx.x);
        EpiMerge E{ZG, ZG + 1024, LDZ_G, ZRG, LDZ_RG}; pg8::gemm_phase<EpiMerge, true>(lds, g, S, E); }
    SEAM_FILL(3, (convert_weights<WJ_DN>(a, lds, G)));
    if (IN(5)) { pg8::Gemm g{ZRG, (const bf16_t*)(ws + WS_WOUT), M, DM, DM, LDZ_RG, DM, nullptr, nullptr, 0}; pg8::StaticOrder S; S.init(M, DM, G, (int)blockIdx.x);
        EpiRes<1> E{XB, XC, ssq1}; pg8::gemm_phase(lds, g, S, E); }
    SEAM_FILL(5, (convert_weights<WJ_GATE>(a, lds, G)));
    if (IN(6)) { pg8::Gemm g{XC, (const bf16_t*)(ws + WS_WUP), M, DFF, DM, DM, DM, nullptr, nullptr, 0}; pg8::StaticOrder S; S.init(M, DFF, G, (int)blockIdx.x);
        EpiUp E{ssq1, U}; pg8::gemm_phase(lds, g, S, E); }
#define PLE_FILLER(round) do { pg8::Gemm g{PB, (const bf16_t*)(ws + WS_WPLE), M, DM, PLE, PLE, PLE, nullptr, nullptr, 0}; pg8::StaticOrder S; S.init(M, DM, G, (int)blockIdx.x); S.i0 = (round); S.imax = 1; \
        EpiPlain E{XB}; pg8::gemm_phase(lds, g, S, E); } while (0)
    SEAM_FILL(6, PLE_FILLER(0));
    if (IN(7)) {
        { pg8::Gemm g{U, (const bf16_t*)(ws + WS_WDN), M, DM, DFF, DFF, DFF, nullptr, nullptr, 0}; pg8::StaticOrder S; S.init(M, DM, G, (int)blockIdx.x);
          EpiRes<2> E{XC, XC, ssq2}; pg8::gemm_phase(lds, g, S, E); }
    }
    SEAM_FILL(7, PLE_FILLER(1));
    if (IN(8)) { pg8::Gemm g{XC, (const bf16_t*)(ws + WS_WGATE), M, DM, DM, DM, DM, nullptr, nullptr, 0}; pg8::StaticOrder S; S.init(M, DM, G, (int)blockIdx.x);
        EpiFinal E{ssq2, XB, XC, a.out}; pg8::gemm_phase(lds, g, S, E); }
#undef IN
#undef SEAM
#undef SEAM_FILL
#undef PLE_FILLER
}

extern "C" void kernel_launch(void* const* d_in, const int* in_sizes, int n_in, void* d_out, int out_size, void* d_ws, size_t ws_size, hipStream_t stream) {
    static int grid = 0;
    if (grid == 0) {
        if (n_in != 23 || out_size != M * DM || ws_size < WS_END) { fprintf(stderr, "kernel_launch: unexpected shapes (n_in %d out %d ws %zu)\n", n_in, out_size, ws_size); grid = -1; return; }
        int dev = 0, cus = 0, per_cu = 0;
        hipGetDevice(&dev); hipDeviceGetAttribute(&cus, hipDeviceAttributeMultiprocessorCount, dev);
        hipFuncSetAttribute((const void*)fwd_megakernel, hipFuncAttributeMaxDynamicSharedMemorySize, LDS_BYTES);
        hipOccupancyMaxActiveBlocksPerMultiprocessor(&per_cu, (const void*)fwd_megakernel, 512, LDS_BYTES);
        (void)hipGetLastError();
        if (per_cu < 1) fprintf(stderr, "kernel_launch: occupancy query says %d\n", per_cu);
        grid = cus > 0 ? cus : 256;
    }
    if (grid < 0) return;
    Args a{};
    for (int i = 0; i < 23; ++i) a.in[i] = (const float*)d_in[i];
    a.out = (float*)d_out; a.ws = (unsigned char*)d_ws;
#if MK_N_LAUNCHES == 1
    a.ph_lo = 0; a.ph_hi = 9;
    void* args[] = {&a};
    (void)hipMemsetAsync((char*)d_ws + WS_BAR, 0, XCD_BAR_WORDS * 4, stream);
    hipError_t e = hipLaunchCooperativeKernel((const void*)fwd_megakernel, dim3(grid), dim3(512), args, LDS_BYTES, stream);
    if (e != hipSuccess) fprintf(stderr, "cooperative launch failed: %s (grid %d)\n", hipGetErrorString(e), grid);
#else
    for (int ph = 0; ph < 9; ++ph) { a.ph_lo = ph; a.ph_hi = ph + 1; hipLaunchKernelGGL(fwd_megakernel, dim3(grid), dim3(512), LDS_BYTES, stream, a); }
#endif
}
```

```cpp
#include <hip/hip_runtime.h>
#include <hip/hip_cooperative_groups.h>
#include <cstdio>
#include <cstdint>
namespace cg = cooperative_groups;

#ifndef MK_N_LAUNCHES
#define MK_N_LAUNCHES 1
#endif

#ifndef PROBE_MODE
#define PROBE_MODE 0
#endif
#define LAS __attribute__((address_space(3)))
typedef unsigned short bf16_t;
typedef short bf16x8 __attribute__((ext_vector_type(8)));
typedef short s16x4 __attribute__((ext_vector_type(4)));
typedef float f32x4 __attribute__((ext_vector_type(4)));
typedef float f32x16 __attribute__((ext_vector_type(16)));
typedef unsigned u32x4 __attribute__((ext_vector_type(4)));
typedef unsigned u32x2 __attribute__((ext_vector_type(2)));

constexpr int M = 32768, DM = 1024, SEQ = 2048, NIN = 5632, DFF = 4096, PLE = 256;
constexpr float EPS = 1e-6f;
constexpr int LDZ_RG = 2048, LDZ_QKV = 1536, LDZ_G = 2048;

constexpr size_t MiB = 1u << 20, KiB = 1u << 10;
constexpr size_t WS_SSQ0 = 0, WS_SSQ1 = 128 * KiB, WS_SSQ2 = 256 * KiB, WS_COS = 512 * KiB, WS_SIN = 768 * KiB;
constexpr size_t WS_BAR = 384 * KiB;
constexpr size_t WS_WRG = 1 * MiB, WS_WIG = 1 * MiB + 128 * KiB;
constexpr size_t WS_WIN = 2 * MiB, WS_WRNN = 13 * MiB, WS_WATT = 15 * MiB, WS_WOUT = 17 * MiB, WS_WUP = 19 * MiB, WS_WDN = 27 * MiB, WS_WGATE = 35 * MiB, WS_WPLE = 37 * MiB;
constexpr size_t WS_XB = 38 * MiB;
constexpr size_t WS_PB = 102 * MiB;
constexpr size_t WS_ZRG = 118 * MiB;
constexpr size_t WS_ZQKV = 246 * MiB;
constexpr size_t WS_ZG = 342 * MiB;
constexpr size_t WS_XC = 406 * MiB;
constexpr size_t WS_U = 118 * MiB;
constexpr size_t WS_END = 470 * MiB;

constexpr int LDS_BYTES = 147456;

__device__ __forceinline__ unsigned cvt_pk_bf16(float lo, float hi) { unsigned r; asm volatile("v_cvt_pk_bf16_f32 %0, %1, %2" : "=v"(r) : "v"(lo), "v"(hi)); return r; }
__device__ __forceinline__ float bflo(unsigned w) { return __uint_as_float(w << 16); }
__device__ __forceinline__ float bfhi(unsigned w) { return __uint_as_float(w & 0xffff0000u); }
__device__ __forceinline__ float sigm(float x) { return __builtin_amdgcn_rcpf(1.f + __builtin_amdgcn_exp2f(-1.44269504f * x)); }
__device__ __forceinline__ f32x4 exp2v(f32x4 v) { return (f32x4){__builtin_amdgcn_exp2f(v.x), __builtin_amdgcn_exp2f(v.y), __builtin_amdgcn_exp2f(v.z), __builtin_amdgcn_exp2f(v.w)}; }
__device__ __forceinline__ f32x4 rcpv(f32x4 v) { return (f32x4){__builtin_amdgcn_rcpf(v.x), __builtin_amdgcn_rcpf(v.y), __builtin_amdgcn_rcpf(v.z), __builtin_amdgcn_rcpf(v.w)}; }
__device__ __forceinline__ f32x4 maxv(f32x4 v, float lo) { return (f32x4){fmaxf(v.x, lo), fmaxf(v.y, lo), fmaxf(v.z, lo), fmaxf(v.w, lo)}; }
__device__ __forceinline__ f32x4 expnegv(f32x4 x) { return exp2v(maxv(x, -60.f) * -1.44269504f); }

namespace pg8 {
constexpr int BM = 256, BK = 64, HALF = 128, HTB = HALF * BK * 2, STAGE_BYTES = 8 * HTB, NXCD = 8, WGM = 8;
__host__ __device__ __forceinline__ int lds_byte(int r, int c) { const int st = (r >> 4) * 2 + (c >> 5), rr = r & 15, cc = c & 31, ob = rr * 64 + cc * 2; return st * 1024 + (ob ^ (((ob >> 9) & 1) << 5)); }
__host__ __device__ __forceinline__ void stage_rc(int b, int& R, int& C) { const int st = b / 1024, sb = b % 1024, swz = sb ^ (((sb >> 9) & 1) << 5); R = (st >> 1) * 16 + swz / 64; C = (st & 1) * 32 + (swz % 64) / 2; }
__host__ __device__ __forceinline__ int perm32(int rho) { const int n = rho >> 4, i = rho & 15; return 8 * (i >> 2) + 4 * n + (i & 3); }

struct Unit { int pm, pn; };
struct Gemm { const bf16_t* A; const bf16_t* Bt; int M, N, K, lda, ldb; const bf16_t* A1; const bf16_t* Bt1; int lda1; };

struct StaticOrder {
    int nM, nN, nwg, G, c, i0 = 0, imax = 1 << 30;
    __host__ __device__ void init(int M_, int N_, int G_, int c_) { nM = M_ / BM; nN = N_ / BM; nwg = nM * nN; G = G_; c = c_; }
    __host__ __device__ bool next(int i, Unit& u) const {
        if (i >= imax) return false;
        const long L = (long)(i + i0) * G + c; if (L >= nwg) return false;
        int wgid = (int)L; { const int q = nwg / NXCD, r = nwg % NXCD, xcd = wgid % NXCD, off = wgid / NXCD; wgid = (xcd < r ? xcd * (q + 1) : r * (q + 1) + (xcd - r) * q) + off; }
        const int nig = WGM * nN, gid = wgid / nig, fm = gid * WGM, gsz = (nM - fm) < WGM ? (nM - fm) : WGM;
        u.pm = fm + ((wgid % nig) % gsz); u.pn = (wgid % nig) / gsz; return true;
    }
};

template <class Epi, bool DUAL = false>
__device__ __forceinline__ void gemm_phase(LAS unsigned char* lds, const Gemm g, const StaticOrder& S, const Epi& E) {
    const int tid = threadIdx.x, wid = __builtin_amdgcn_readfirstlane(tid >> 6), lane = tid & 63, wr = wid >> 2, wc = wid & 3, fr = lane & 15, fq = lane >> 4;
    const int K = g.K, nt = K / BK;
    unsigned voffA0[2], voffA1[2], voffB[2];
#pragma unroll
    for (int i = 0; i < 2; ++i) { int R, C; stage_rc(tid * 16 + i * 8192, R, C); const int Rb = (R & ~31) + perm32(R & 31);
        voffA0[i] = (unsigned)(R * g.lda + C) * 2u; voffA1[i] = DUAL ? (unsigned)(R * g.lda1 + C) * 2u : voffA0[i]; voffB[i] = (unsigned)(Rb * g.ldb + C) * 2u; }
    const size_t kstep = (size_t)(BK * 2);
    const size_t hstepA0 = (size_t)HALF * g.lda * 2, hstepA1 = DUAL ? (size_t)HALF * g.lda1 * 2 : hstepA0, hstepB = (size_t)HALF * g.ldb * 2;
    const size_t tstepA0 = 2 * hstepA0, tstepA1 = 2 * hstepA1, tstepB = 2 * hstepB;
    const unsigned ldsw = (unsigned)wid * 1024u;
    const int aoff = lds_byte(wr * 64 + fr, fq * 8), boff = lds_byte(wc * 32 + fr, fq * 8);
#define PG8_SA(b, h) (((b) * 2 + (h)) * HTB)
#define PG8_SB(b, h) ((4 + (b) * 2 + (h)) * HTB)
#define PG8_STAGE2(bufoff, gbase, v0, v1) do { \
        __builtin_amdgcn_global_load_lds((const unsigned*)((const char*)(gbase) + (v0)), (LAS unsigned*)(lds + (bufoff) + ldsw), 16, 0, 0); \
        __builtin_amdgcn_global_load_lds((const unsigned*)((const char*)(gbase) + (v1)), (LAS unsigned*)(lds + (bufoff) + ldsw + 8192), 16, 0, 0); } while (0)
#define PG8_STAGEB(bufoff, gbase) PG8_STAGE2(bufoff, gbase, voffB[0], voffB[1])
#define PG8_LDA(dst, b, h) do { _Pragma("unroll") for (int m = 0; m < 4; ++m) _Pragma("unroll") for (int k = 0; k < 2; ++k) dst[m][k] = *(const LAS bf16x8*)(lds + PG8_SA(b, h) + aoff + m * 2048 + k * 1024); } while (0)
#define PG8_LDB(dst, b, h) do { _Pragma("unroll") for (int n = 0; n < 2; ++n) _Pragma("unroll") for (int k = 0; k < 2; ++k) dst[n][k] = *(const LAS bf16x8*)(lds + PG8_SB(b, h) + boff + n * 2048 + k * 1024); } while (0)
#define PG8_MMA(ai, bj, At, Bt) do { __builtin_amdgcn_s_setprio(1); _Pragma("unroll") for (int m = 0; m < 4; ++m) _Pragma("unroll") for (int n = 0; n < 2; ++n) _Pragma("unroll") for (int k = 0; k < 2; ++k) \
        acc[ai][bj][m][n] = __builtin_amdgcn_mfma_f32_16x16x32_bf16(Bt[n][k], At[m][k], acc[ai][bj][m][n], 0, 0, 0); __builtin_amdgcn_s_setprio(0); } while (0)
#define PG8_WAIT_V(n) asm volatile("s_waitcnt vmcnt(" #n ")" ::: "memory")
#define PG8_WAIT_L(n) asm volatile("s_waitcnt lgkmcnt(" #n ")" ::: "memory")
#define PG8_BAR __builtin_amdgcn_s_barrier()
#define PG8_SCHED __builtin_amdgcn_sched_barrier(0)
    Unit cur, nxt; int ui = 0;
    if (!S.next(0, cur)) return;
    f32x4 acc[2][2][4][2];
#pragma unroll
    for (int a = 0; a < 2; ++a)
#pragma unroll
        for (int b = 0; b < 2; ++b)
#pragma unroll
            for (int m = 0; m < 4; ++m)
#pragma unroll
                for (int n = 0; n < 2; ++n) acc[a][b][m][n] = (f32x4){0.f, 0.f, 0.f, 0.f};
    bf16x8 At[4][2], B0[2][2], B1[2][2];
    const char* cA = (const char*)g.A + (size_t)cur.pm * tstepA0; const char* cB = (const char*)g.Bt + (size_t)cur.pn * tstepB;
    PG8_STAGEB(PG8_SB(0, 0), cB); PG8_STAGEB(PG8_SB(0, 1), cB + hstepB); PG8_STAGE2(PG8_SA(0, 0), cA, voffA0[0], voffA0[1]); PG8_STAGE2(PG8_SA(0, 1), cA + hstepA0, voffA0[0], voffA0[1]);
    if (wr == 1) PG8_BAR;
    PG8_WAIT_V(2); PG8_BAR;
    PG8_STAGEB(PG8_SB(1, 0), cB + kstep); PG8_STAGE2(PG8_SA(1, 0), cA + kstep, voffA0[0], voffA0[1]); PG8_STAGEB(PG8_SB(1, 1), cB + hstepB + kstep);
    PG8_WAIT_V(6); PG8_BAR;
    for (;;) {
        const bool has_next = S.next(ui + 1, nxt);
#pragma unroll
        for (int sg = 0; sg < (DUAL ? 2 : 1); ++sg) {
            const bool to_seg1 = DUAL && sg == 0;
            const unsigned vc0 = sg ? voffA1[0] : voffA0[0], vc1 = sg ? voffA1[1] : voffA0[1]; const size_t hc = sg ? hstepA1 : hstepA0;
            const char* nA; const char* nB; unsigned vn0, vn1; size_t hn;
            if (to_seg1) { nA = (const char*)g.A1 + (size_t)cur.pm * tstepA1; nB = (const char*)g.Bt1 + (size_t)cur.pn * tstepB; vn0 = voffA1[0]; vn1 = voffA1[1]; hn = hstepA1; }
            else if (has_next) { nA = (const char*)g.A + (size_t)nxt.pm * tstepA0; nB = (const char*)g.Bt + (size_t)nxt.pn * tstepB; vn0 = voffA0[0]; vn1 = voffA0[1]; hn = hstepA0; }
            else { nA = cA; nB = cB; vn0 = vc0; vn1 = vc1; hn = hc; }
            for (int t = 0; t < nt; t += 2) {
                const bool last = (t == nt - 2);
                const char* a1 = cA + (size_t)(t + 1) * kstep;
                const char* a2 = last ? nA : cA + (size_t)(t + 2) * kstep; const char* b2 = last ? nB : cB + (size_t)(t + 2) * kstep;
                const char* a3 = a2 + kstep; const char* b3 = b2 + kstep;
                const unsigned vx0 = last ? vn0 : vc0, vx1 = last ? vn1 : vc1; const size_t hx = last ? hn : hc;
                PG8_LDB(B0, 0, 0); PG8_LDB(B1, 0, 1); PG8_SCHED; PG8_LDA(At, 0, 0); PG8_STAGE2(PG8_SA(1, 1), a1 + hc, vc0, vc1);
                PG8_WAIT_V(8); PG8_WAIT_L(0); PG8_BAR; PG8_MMA(0, 0, At, B0); PG8_MMA(0, 1, At, B1); PG8_BAR; PG8_SCHED;
                PG8_LDA(At, 0, 1); PG8_STAGEB(PG8_SB(0, 0), b2); PG8_STAGEB(PG8_SB(0, 1), b2 + hstepB); PG8_STAGE2(PG8_SA(0, 0), a2, vx0, vx1);
                PG8_WAIT_V(8); PG8_WAIT_L(0); PG8_BAR; PG8_MMA(1, 0, At, B0); PG8_MMA(1, 1, At, B1); PG8_BAR; PG8_SCHED;
                PG8_LDB(B0, 1, 0); PG8_LDB(B1, 1, 1); PG8_SCHED; PG8_LDA(At, 1, 0); PG8_STAGE2(PG8_SA(0, 1), a2 + hx, vx0, vx1);
                PG8_WAIT_V(8); PG8_WAIT_L(0); PG8_BAR; PG8_MMA(0, 0, At, B0); PG8_MMA(0, 1, At, B1); PG8_BAR; PG8_SCHED;
                PG8_LDA(At, 1, 1); PG8_STAGEB(PG8_SB(1, 0), b3); PG8_STAGEB(PG8_SB(1, 1), b3 + hstepB); PG8_STAGE2(PG8_SA(1, 0), a3, vx0, vx1);
                PG8_WAIT_V(8); PG8_WAIT_L(0); PG8_BAR; PG8_MMA(1, 0, At, B0); PG8_MMA(1, 1, At, B1); PG8_BAR; PG8_SCHED;
            }
            if constexpr (DUAL) { if (sg == 0) { PG8_SCHED; E.mid(acc, cur, wr, wc, fr, fq); PG8_SCHED; } }
            cA = nA; cB = nB;
        }
        if (wr == 0) PG8_BAR;
        E(acc, cur, wr, wc, fr, fq);
        if (!has_next) break;
        bf16x8 zfrag = {0, 0, 0, 0, 0, 0, 0, 0}; asm volatile("" : "+v"(zfrag));
#pragma unroll
        for (int a = 0; a < 2; ++a)
#pragma unroll
            for (int b = 0; b < 2; ++b)
#pragma unroll
                for (int m = 0; m < 4; ++m)
#pragma unroll
                    for (int n = 0; n < 2; ++n) acc[a][b][m][n] = __builtin_amdgcn_mfma_f32_16x16x32_bf16(zfrag, zfrag, (f32x4){0.f, 0.f, 0.f, 0.f}, 0, 0, 0);
        cur = nxt; ++ui;
        if (wr == 1) PG8_BAR;
    }
    PG8_WAIT_V(0);
    PG8_BAR;
#undef PG8_SA
#undef PG8_SB
#undef PG8_STAGE2
#undef PG8_STAGEB
#undef PG8_LDA
#undef PG8_LDB
#undef PG8_MMA
#undef PG8_WAIT_V
#undef PG8_WAIT_L
#undef PG8_BAR
#undef PG8_SCHED
}
}

typedef f32x4 AccT[2][2][4][2];
#define EPI_LOOP_ROWS  _Pragma("unroll") for (int ai = 0; ai < 2; ++ai) _Pragma("unroll") for (int m = 0; m < 4; ++m)
__device__ __forceinline__ u32x4 pack8(f32x4 v0, f32x4 v1) { u32x4 w; w.x = cvt_pk_bf16(v0[0], v0[1]); w.y = cvt_pk_bf16(v0[2], v0[3]); w.z = cvt_pk_bf16(v1[0], v1[1]); w.w = cvt_pk_bf16(v1[2], v1[3]); return w; }
__device__ __forceinline__ void unpack8(u32x4 w, f32x4& v0, f32x4& v1) { v0 = (f32x4){bflo(w.x), bfhi(w.x), bflo(w.y), bfhi(w.y)}; v1 = (f32x4){bflo(w.z), bfhi(w.z), bflo(w.w), bfhi(w.w)}; }

#define EPI_M _Pragma("unroll") for (int m = 0; m < 4; ++m)
#define EPI_BJ _Pragma("unroll") for (int bj = 0; bj < 2; ++bj)
struct EpiIn {
    bf16_t *zrg, *zqkv, *zg; const float* ssq;
    __device__ __forceinline__ void operator()(const AccT& acc, const pg8::Unit& u, int wr, int wc, int fr, int fq) const {
        bf16_t* base; int ld, colt;
        if (u.pn < 8) { base = zrg; ld = LDZ_RG; colt = u.pn * 256; } else if (u.pn < 14) { base = zqkv; ld = LDZ_QKV; colt = (u.pn - 8) * 256; } else { base = zg; ld = LDZ_G; colt = (u.pn - 14) * 256; }
        const int row0 = u.pm * 256 + wr * 64 + fr, col0 = colt + wc * 32 + 8 * fq;
        float sv[2][4];
        EPI_LOOP_ROWS sv[ai][m] = ssq[row0 + ai * 128 + m * 16];
        EPI_LOOP_ROWS { const int row = row0 + ai * 128 + m * 16; const float s = __builtin_amdgcn_rsqf(sv[ai][m] * (1.f / DM) + EPS); bf16_t* rowp = base + (size_t)row * ld + col0;
            EPI_BJ *(u32x4*)(rowp + bj * 128) = pack8(acc[ai][bj][m][0] * s, acc[ai][bj][m][1] * s); }
    }
};
struct EpiMerge {
    const bf16_t* ga; const bf16_t* gb; int ldg; bf16_t* O; int ldo;
    __device__ __forceinline__ void mid(AccT& acc, const pg8::Unit& u, int wr, int wc, int fr, int fq) const {
        int row0 = u.pm * 256 + wr * 64 + fr, col0 = u.pn * 256 + wc * 32 + 8 * fq;
        asm volatile("" : "+v"(row0), "+v"(col0));
        u32x4 av[2][2][2], bv[2][2][2];
#pragma unroll
        for (int b = 0; b < 5; ++b) {
            if (b < 4) {
#pragma unroll
                for (int mm = 0; mm < 2; ++mm) EPI_BJ { const size_t off = (size_t)(row0 + (b >> 1) * 128 + (2 * (b & 1) + mm) * 16) * ldg + col0 + bj * 128; av[b & 1][mm][bj] = *(const u32x4*)(ga + off); bv[b & 1][mm][bj] = *(const u32x4*)(gb + off); }
            }
            if (b >= 1) { const int c = b - 1, ai = c >> 1;
#pragma unroll
                for (int mm = 0; mm < 2; ++mm) { const int m = 2 * (c & 1) + mm;
                    EPI_BJ { f32x4 a0, a1, b0, b1; unpack8(av[c & 1][mm][bj], a0, a1); unpack8(bv[c & 1][mm][bj], b0, b1);
                        acc[ai][bj][m][0] *= (expnegv(b0) + 1.f) * rcpv(exp2v(a0 * -1.44269504f) + 1.f);
                        acc[ai][bj][m][1] *= (expnegv(b1) + 1.f) * rcpv(exp2v(a1 * -1.44269504f) + 1.f); }
                    asm volatile("" : "+v"(acc[ai][0][m][0]), "+v"(acc[ai][0][m][1]), "+v"(acc[ai][1][m][0]), "+v"(acc[ai][1][m][1]) :: "memory"); }
            }
        }
    }
    __device__ __forceinline__ void operator()(const AccT& acc, const pg8::Unit& u, int wr, int wc, int fr, int fq) const {
        const int row0 = u.pm * 256 + wr * 64 + fr, col0 = u.pn * 256 + wc * 32 + 8 * fq;
        u32x4 bv[2][4][2];
        EPI_LOOP_ROWS EPI_BJ bv[ai][m][bj] = *(const u32x4*)(gb + (size_t)(row0 + ai * 128 + m * 16) * ldg + col0 + bj * 128);
        EPI_LOOP_ROWS EPI_BJ { f32x4 b0, b1; unpack8(bv[ai][m][bj], b0, b1);
            const f32x4 v0 = acc[ai][bj][m][0] * rcpv(expnegv(b0) + 1.f), v1 = acc[ai][bj][m][1] * rcpv(expnegv(b1) + 1.f);
            *(u32x4*)(O + (size_t)(row0 + ai * 128 + m * 16) * ldo + col0 + bj * 128) = pack8(v0, v1); }
    }
};
template <int NB  > struct EpiRes {
    const bf16_t* rbf; bf16_t* xb; float* ssq;
    __device__ __forceinline__ void operator()(const AccT& acc, const pg8::Unit& u, int wr, int wc, int fr, int fq) const {
        const int row0 = u.pm * 256 + wr * 64 + fr, col0 = u.pn * 256 + wc * 32 + 8 * fq;
#pragma unroll
        for (int h = 0; h < NB; ++h) {
            u32x4 rb[2][4][2];
#pragma unroll
            for (int ai = (NB == 2 ? h : 0); ai < (NB == 2 ? h + 1 : 2); ++ai) EPI_M EPI_BJ rb[ai][m][bj] = *(const u32x4*)(rbf + (size_t)(row0 + ai * 128 + m * 16) * DM + col0 + bj * 128);
#pragma unroll
            for (int ai = (NB == 2 ? h : 0); ai < (NB == 2 ? h + 1 : 2); ++ai) EPI_M { const int row = row0 + ai * 128 + m * 16; float sq = 0.f;
                EPI_BJ { const size_t off = (size_t)row * DM + col0 + bj * 128; f32x4 r0, r1; unpack8(rb[ai][m][bj], r0, r1);
                    const f32x4 v0 = acc[ai][bj][m][0] + r0, v1 = acc[ai][bj][m][1] + r1;
                    *(u32x4*)(xb + off) = pack8(v0, v1);
                    const f32x4 q4 = v0 * v0 + v1 * v1; sq += (q4[0] + q4[1]) + (q4[2] + q4[3]); }
                sq += __shfl_xor(sq, 16); sq += __shfl_xor(sq, 32);
                if (fq == 0) unsafeAtomicAdd(ssq + row, sq); }
        }
    }
};
struct EpiUp {
    const float* ssq; bf16_t* O;
    __device__ __forceinline__ void operator()(const AccT& acc, const pg8::Unit& u, int wr, int wc, int fr, int fq) const {
        const int row0 = u.pm * 256 + wr * 64 + fr, col0 = u.pn * 256 + wc * 32 + 8 * fq;
        float sv[2][4];
        EPI_LOOP_ROWS sv[ai][m] = ssq[row0 + ai * 128 + m * 16];
        EPI_LOOP_ROWS { const int row = row0 + ai * 128 + m * 16; const float s = __builtin_amdgcn_rsqf(sv[ai][m] * (1.f / DM) + EPS);
            EPI_BJ { const f32x4 r0 = maxv(acc[ai][bj][m][0] * s, 0.f), r1 = maxv(acc[ai][bj][m][1] * s, 0.f);
                *(u32x4*)(O + (size_t)row * DFF + col0 + bj * 128) = pack8(r0 * r0, r1 * r1); } }
    }
};
struct EpiPlain {
    bf16_t* O;
    __device__ __forceinline__ void operator()(const AccT& acc, const pg8::Unit& u, int wr, int wc, int fr, int fq) const {
        const int row0 = u.pm * 256 + wr * 64 + fr, col0 = u.pn * 256 + wc * 32 + 8 * fq;
        EPI_LOOP_ROWS { const int row = row0 + ai * 128 + m * 16;
            EPI_BJ *(u32x4*)(O + (size_t)row * DM + col0 + bj * 128) = pack8(acc[ai][bj][m][0], acc[ai][bj][m][1]); }
    }
};
struct EpiFinal {
    const float* ssq; const bf16_t* Eb; const bf16_t* xin; float* out;
    __device__ __forceinline__ void operator()(const AccT& acc, const pg8::Unit& u, int wr, int wc, int fr, int fq) const {
        const int row0 = u.pm * 256 + wr * 64 + fr, col0 = u.pn * 256 + wc * 32 + 8 * fq;
        float sv[2][4];
        EPI_LOOP_ROWS sv[ai][m] = ssq[row0 + ai * 128 + m * 16];
        u32x4 xv[2][2][2], ev[2][2][2];
#pragma unroll
        for (int b = 0; b < 5; ++b) {
            if (b < 4) {
#pragma unroll
                for (int mm = 0; mm < 2; ++mm) EPI_BJ { const size_t off = (size_t)(row0 + (b >> 1) * 128 + (2 * (b & 1) + mm) * 16) * DM + col0 + bj * 128; xv[b & 1][mm][bj] = *(const u32x4*)(xin + off); ev[b & 1][mm][bj] = *(const u32x4*)(Eb + off); }
            }
            if (b >= 1) { const int c = b - 1, ai = c >> 1;
#pragma unroll
                for (int mm = 0; mm < 2; ++mm) { const int m = 2 * (c & 1) + mm; const float sc = __builtin_amdgcn_rsqf(sv[ai][m] * (1.f / DM) + EPS);
                    EPI_BJ { const size_t off = (size_t)(row0 + ai * 128 + m * 16) * DM + col0 + bj * 128; f32x4 e0, e1, v0, v1; unpack8(ev[c & 1][mm][bj], e0, e1); unpack8(xv[c & 1][mm][bj], v0, v1);
                        const float nsc = -1.44269504f * sc;
                        v0 += e0 * rcpv(exp2v(acc[ai][bj][m][0] * nsc) + 1.f); v1 += e1 * rcpv(exp2v(acc[ai][bj][m][1] * nsc) + 1.f);
                        __builtin_nontemporal_store(v0, (f32x4*)(out + off)); __builtin_nontemporal_store(v1, (f32x4*)(out + off + 4)); } }
            }
        }
    }
};

__device__ __forceinline__ float wave_sum(float v) {
#pragma unroll
    for (int o = 1; o < 64; o <<= 1) v += __shfl_xor(v, o);
    return v;
}
__device__ __forceinline__ void p0_transpose_item(const float* W, int K, int N, bf16_t* WT, const float* g, LAS float* scr, int item, int lane) {
    const int nblk = N / 32, kb = item / nblk, nb = item % nblk, k0 = 64 * kb, n0 = 32 * nb;
#pragma unroll
    for (int i = 0; i < 32; ++i) { const int kk = 2 * i + (lane >> 5); const float gv = g ? g[k0 + kk] : 1.f; scr[kk * 33 + (lane & 31)] = __builtin_nontemporal_load(W + (size_t)(k0 + kk) * N + n0 + (lane & 31)) * gv; }
    asm volatile("s_waitcnt lgkmcnt(0)" ::: "memory");
    const int c = lane & 7;
#pragma unroll
    for (int j = 0; j < 4; ++j) { const int n = (lane >> 3) + 8 * j; const LAS float* s = scr + (8 * c) * 33 + n;
        u32x4 o; o.x = cvt_pk_bf16(s[0 * 33], s[1 * 33]); o.y = cvt_pk_bf16(s[2 * 33], s[3 * 33]); o.z = cvt_pk_bf16(s[4 * 33], s[5 * 33]); o.w = cvt_pk_bf16(s[6 * 33], s[7 * 33]);
        *(u32x4*)(WT + (size_t)(n0 + n) * K + k0 + 8 * c) = o; }
    asm volatile("s_waitcnt lgkmcnt(0)" ::: "memory");
}

struct Args { const float* in[23]; float* out; unsigned char* ws; int ph_lo, ph_hi; };
enum { I_X = 0, I_P, I_GMIX, I_WIN, I_CONVW, I_CONVB, I_WRG, I_BRG, I_WIG, I_BIG, I_LAM, I_WRNN, I_QG, I_KG, I_SINK, I_WATT, I_WOUT, I_GMLP, I_WUP, I_WDN, I_GPLE, I_WGATE, I_WPLE };

__device__ __forceinline__ void convert_p(const Args& a, int G) {
    const int gt = blockIdx.x * 512 + threadIdx.x, NT = G * 512;
    const f32x4* p4 = (const f32x4*)a.in[I_P]; u32x2* pb = (u32x2*)(a.ws + WS_PB);
    for (int i = gt; i < M * PLE / 4; i += 4 * NT) { f32x4 v[4];
#pragma unroll
        for (int q = 0; q < 4; ++q) v[q] = (i + q * NT < M * PLE / 4) ? __builtin_nontemporal_load(p4 + i + q * NT) : (f32x4){0.f, 0.f, 0.f, 0.f};
#pragma unroll
        for (int q = 0; q < 4; ++q) if (i + q * NT < M * PLE / 4) { u32x2 w; w.x = cvt_pk_bf16(v[q].x, v[q].y); w.y = cvt_pk_bf16(v[q].z, v[q].w); __builtin_nontemporal_store(w, pb + i + q * NT); } }
}

enum { WJ_IN = 1, WJ_RNN = 2, WJ_ATT = 4, WJ_OUT = 8, WJ_UP = 16, WJ_DN = 32, WJ_GATE = 64, WJ_PLE = 128, WJ_RG = 256, WJ_IG = 512 };
template <unsigned MASK> __device__ __forceinline__ void convert_weights(const Args& a, LAS unsigned char* lds, int G) {
    const int tid = threadIdx.x, lane = tid & 63, wave = tid >> 6;
    unsigned char* ws = a.ws;
    LAS float* scr = (LAS float*)(lds + wave * 16384);
    const int gw = blockIdx.x * 8 + wave, NGW = G * 8;
    constexpr int N0 = (DM / 64) * (NIN / 32), N1 = (DM / 64) * (DM / 32), N5 = (DM / 64) * (DFF / 32), N6 = (DFF / 64) * (DM / 32), N8 = (PLE / 64) * (DM / 32), N9 = 32;
    constexpr int C_IN = (MASK & WJ_IN) ? N0 : 0, C_RNN = (MASK & WJ_RNN) ? N1 : 0, C_ATT = (MASK & WJ_ATT) ? N1 : 0, C_OUT = (MASK & WJ_OUT) ? N1 : 0, C_UP = (MASK & WJ_UP) ? N5 : 0,
                  C_DN = (MASK & WJ_DN) ? N6 : 0, C_GATE = (MASK & WJ_GATE) ? N1 : 0, C_PLE = (MASK & WJ_PLE) ? N8 : 0, C_RG = (MASK & WJ_RG) ? N9 : 0, C_IG = (MASK & WJ_IG) ? N9 : 0;
    constexpr int NITEMS = C_IN + C_RNN + C_ATT + C_OUT + C_UP + C_DN + C_GATE + C_PLE + C_RG + C_IG;
    for (int it = gw; it < NITEMS; it += NGW) {
        int r = it;
        if (r < C_IN) { p0_transpose_item(a.in[I_WIN], DM, NIN, (bf16_t*)(ws + WS_WIN), a.in[I_GMIX], scr, r, lane); continue; } r -= C_IN;
        if (r < C_RNN) { p0_transpose_item(a.in[I_WRNN], DM, DM, (bf16_t*)(ws + WS_WRNN), nullptr, scr, r, lane); continue; } r -= C_RNN;
        if (r < C_ATT) { p0_transpose_item(a.in[I_WATT], DM, DM, (bf16_t*)(ws + WS_WATT), nullptr, scr, r, lane); continue; } r -= C_ATT;
        if (r < C_OUT) { p0_transpose_item(a.in[I_WOUT], DM, DM, (bf16_t*)(ws + WS_WOUT), nullptr, scr, r, lane); continue; } r -= C_OUT;
        if (r < C_UP) { p0_transpose_item(a.in[I_WUP], DM, DFF, (bf16_t*)(ws + WS_WUP), a.in[I_GMLP], scr, r, lane); continue; } r -= C_UP;
        if (r < C_DN) { p0_transpose_item(a.in[I_WDN], DFF, DM, (bf16_t*)(ws + WS_WDN), nullptr, scr, r, lane); continue; } r -= C_DN;
        if (r < C_GATE) { p0_transpose_item(a.in[I_WGATE], DM, DM, (bf16_t*)(ws + WS_WGATE), a.in[I_GPLE], scr, r, lane); continue; } r -= C_GATE;
        if (r < C_PLE) { p0_transpose_item(a.in[I_WPLE], PLE, DM, (bf16_t*)(ws + WS_WPLE), nullptr, scr, r, lane); continue; } r -= C_PLE;
        if (r < C_RG) { p0_transpose_item(a.in[I_WRG] + (size_t)(r >> 1) * 4096, 64, 64, (bf16_t*)(ws + WS_WRG) + (size_t)(r >> 1) * 4096, nullptr, scr, r & 1, lane); continue; } r -= C_RG;
        if (r < C_IG) p0_transpose_item(a.in[I_WIG] + (size_t)(r >> 1) * 4096, 64, 64, (bf16_t*)(ws + WS_WIG) + (size_t)(r >> 1) * 4096, nullptr, scr, r & 1, lane);
    }
}

__device__ __forceinline__ void p0_prologue(const Args& a, LAS unsigned char* lds, int G) {
    const int tid = threadIdx.x, lane = tid & 63, wave = tid >> 6;
    unsigned char* ws = a.ws;
    const int gw = blockIdx.x * 8 + wave, NGW = G * 8;
    convert_weights<WJ_IN>(a, lds, G);
    const float* x = a.in[I_X]; bf16_t* XB = (bf16_t*)(ws + WS_XB); float* ssq0 = (float*)(ws + WS_SSQ0);
    for (int m4 = gw * 4; m4 < M; m4 += NGW * 4) {
        f32x4 v[4][4];
#pragma unroll
        for (int r = 0; r < 4; ++r) { const f32x4* xr = (const f32x4*)(x + (size_t)(m4 + r) * DM) + lane;
#pragma unroll
            for (int j = 0; j < 4; ++j) v[r][j] = __builtin_nontemporal_load(xr + 64 * j); }
#pragma unroll
        for (int r = 0; r < 4; ++r) { float s = 0.f;
#pragma unroll
            for (int j = 0; j < 4; ++j) s += (v[r][j].x * v[r][j].x + v[r][j].y * v[r][j].y) + (v[r][j].z * v[r][j].z + v[r][j].w * v[r][j].w);
            s = wave_sum(s); if (lane == 0) ssq0[m4 + r] = s;
            u32x2* o8 = (u32x2*)(XB + (size_t)(m4 + r) * DM) + lane;
#pragma unroll
            for (int j = 0; j < 4; ++j) { u32x2 w; w.x = cvt_pk_bf16(v[r][j].x, v[r][j].y); w.y = cvt_pk_bf16(v[r][j].z, v[r][j].w); o8[64 * j] = w; } }
    }
}
__device__ __forceinline__ void setup_misc(const Args& a, int G) {
    unsigned char* ws = a.ws;
    const int gt = blockIdx.x * 512 + threadIdx.x, NT = G * 512;
    { float* s1 = (float*)(ws + WS_SSQ1); float* s2 = (float*)(ws + WS_SSQ2); for (int i = gt; i < M; i += NT) { s1[i] = 0.f; s2[i] = 0.f; } }
    { float* ct = (float*)(ws + WS_COS); float* st = (float*)(ws + WS_SIN);
      for (int i = gt; i < SEQ * 32; i += NT) { const int pos = i >> 5, k = i & 31; const float inv = exp2f(-(float)k * 0.41524101186092029f); const float ang = (float)pos * inv; ct[i] = cosf(ang); st[i] = sinf(ang); } }
}

constexpr int R_XS = 0, R_GS = 18432, R_XCB = 36864, R_WR = 46080, R_WI = 55296, R_AF = 64512, R_BI = 81920, R_SEGP = 99328, R_SEGH = 101376, R_CARRY = 103424, R_OUTB = 104448;
constexpr int RP = 144;
constexpr int FP = 68;
__device__ __forceinline__ void rnn_item(LAS unsigned char* lds, int item, const Args& a, bf16_t* yo, int ldy) {
    const int tid = threadIdx.x, lane = tid & 63, w = __builtin_amdgcn_readfirstlane(tid >> 6);
    const int b = item >> 4, blk = item & 15, c0 = blk * 64;
    bf16_t* zrg = (bf16_t*)(a.ws + WS_ZRG);
    const int c = lane, seg = w;
    const int lrow = tid >> 3, lpiece = tid & 7;
    { const bf16_t* wr = (const bf16_t*)(a.ws + WS_WRG) + blk * 4096; const bf16_t* wi = (const bf16_t*)(a.ws + WS_WIG) + blk * 4096;
      *(LAS u32x4*)(lds + R_WR + lrow * RP + lpiece * 16) = *(const u32x4*)(wr + lrow * 64 + lpiece * 8);
      *(LAS u32x4*)(lds + R_WI + lrow * RP + lpiece * 16) = *(const u32x4*)(wi + lrow * 64 + lpiece * 8); }
    const int ch = c0 + c;
    const float cw0 = a.in[I_CONVW][ch], cw1 = a.in[I_CONVW][1024 + ch], cw2 = a.in[I_CONVW][2048 + ch], cw3 = a.in[I_CONVW][3072 + ch], cb = a.in[I_CONVB][ch];
    float ebr[2], ebi[2], ec8[2];
#pragma unroll
    for (int q = 0; q < 2; ++q) { const int che = c0 + 16 * (2 * (w & 1) + q) + (lane & 15); ebr[q] = -1.44269504f * a.in[I_BRG][che]; ebi[q] = -1.44269504f * a.in[I_BIG][che]; ec8[q] = 1.44269504f * 8.f * log1pf(expf(-a.in[I_LAM][che])); }
    const size_t rowbase = (size_t)b * SEQ;
    const bf16_t* gx = zrg + (rowbase + lrow) * LDZ_RG + c0 + lpiece * 8;
    u32x4 xpre[2], gpre[2];
    xpre[0] = *(const u32x4*)gx; gpre[0] = *(const u32x4*)(gx + 1024);
    { const bf16_t* g1 = gx + (size_t)64 * LDZ_RG; xpre[1] = *(const u32x4*)g1; gpre[1] = *(const u32x4*)(g1 + 1024); }
    const int mt = w >> 1;
    *(LAS u32x4*)(lds + R_XS + lrow * RP + lpiece * 16) = xpre[0]; *(LAS u32x4*)(lds + R_GS + lrow * RP + lpiece * 16) = gpre[0];
    { const bf16_t* gn = gx + (size_t)2 * 64 * LDZ_RG; xpre[0] = *(const u32x4*)gn; gpre[0] = *(const u32x4*)(gn + 1024); }
    __syncthreads();
#pragma unroll 2
    for (int ci = 0; ci < SEQ / 64; ++ci) {
        const int cur = ci & 1;
        LAS unsigned char* XS = lds + R_XS + cur * 9216; LAS unsigned char* XSP = lds + R_XS + (cur ^ 1) * 9216; LAS unsigned char* GS = lds + R_GS + cur * 9216;
        float xv[11];
#pragma unroll
        for (int k = 0; k < 11; ++k) { const int rr = seg * 8 - 3 + k;
            if (rr >= 0) xv[k] = __uint_as_float((unsigned)*(const LAS unsigned short*)(XS + rr * RP + c * 2) << 16);
            else xv[k] = (ci > 0) ? __uint_as_float((unsigned)*(const LAS unsigned short*)(XSP + (64 + rr) * RP + c * 2) << 16) : 0.f; }
        float xc[8];
#pragma unroll
        for (int j = 0; j < 8; ++j) { xc[j] = (((cb + xv[j] * cw0) + xv[j + 1] * cw1) + xv[j + 2] * cw2) + xv[j + 3] * cw3;
            *(LAS unsigned short*)(lds + R_XCB + (seg * 8 + j) * RP + c * 2) = (unsigned short)(cvt_pk_bf16(xc[j], 0.f) & 0xffffu); }
        __syncthreads();
        {
            bf16x8 af[2];
#pragma unroll
            for (int ks = 0; ks < 2; ++ks) af[ks] = *(const LAS bf16x8*)(lds + R_XCB + (16 * mt + (lane & 15)) * RP + ks * 64 + (lane >> 4) * 16);
#pragma unroll
            for (int q = 0; q < 2; ++q) { const int nt = 2 * (w & 1) + q;
                f32x4 ar = (f32x4){0.f, 0.f, 0.f, 0.f}, ai = (f32x4){0.f, 0.f, 0.f, 0.f};
#pragma unroll
                for (int ks = 0; ks < 2; ++ks) { const int boff = (16 * nt + (lane & 15)) * RP + ks * 64 + (lane >> 4) * 16;
                    ar = __builtin_amdgcn_mfma_f32_16x16x32_bf16(af[ks], *(const LAS bf16x8*)(lds + R_WR + boff), ar, 0, 0, 0);
                    ai = __builtin_amdgcn_mfma_f32_16x16x32_bf16(af[ks], *(const LAS bf16x8*)(lds + R_WI + boff), ai, 0, 0, 0); }
#pragma unroll
                for (int e = 0; e < 4; e += 2) { const int t = 16 * mt + 4 * (lane >> 4) + e, cc = 16 * nt + (lane & 15);
                    typedef float f32x2 __attribute__((ext_vector_type(2)));
                    const f32x2 tr = (f32x2){ar[e], ar[e + 1]} * -1.44269504f + ebr[q], ti = (f32x2){ai[e], ai[e + 1]} * -1.44269504f + ebi[q];
                    const f32x2 dr = (f32x2){__builtin_amdgcn_exp2f(tr.x), __builtin_amdgcn_exp2f(tr.y)} + 1.f, di = (f32x2){__builtin_amdgcn_exp2f(ti.x), __builtin_amdgcn_exp2f(ti.y)} + 1.f;
                    const f32x2 r = {__builtin_amdgcn_rcpf(dr.x), __builtin_amdgcn_rcpf(dr.y)}, ig = {__builtin_amdgcn_rcpf(di.x), __builtin_amdgcn_rcpf(di.y)};
                    const f32x2 la2 = r * -ec8[q];
                    const f32x2 av = {__builtin_amdgcn_exp2f(la2.x), __builtin_amdgcn_exp2f(la2.y)};
                    const f32x2 m2 = 1.f - av * av;
                    const f32x2 bi = (f32x2){__builtin_amdgcn_sqrtf(m2.x), __builtin_amdgcn_sqrtf(m2.y)} * ig;
                    ((LAS float*)(lds + R_AF))[t * FP + cc] = av.x; ((LAS float*)(lds + R_AF))[(t + 1) * FP + cc] = av.y;
                    ((LAS float*)(lds + R_BI))[t * FP + cc] = bi.x; ((LAS float*)(lds + R_BI))[(t + 1) * FP + cc] = bi.y; } }
        }
        __syncthreads();
        float av[8], bv[8]; float P = 1.f, h = 0.f;
#pragma unroll
        for (int j = 0; j < 8; ++j) { av[j] = ((const LAS float*)(lds + R_AF))[(seg * 8 + j) * FP + c]; bv[j] = ((const LAS float*)(lds + R_BI))[(seg * 8 + j) * FP + c] * xc[j]; h = av[j] * h + bv[j]; P *= av[j]; }
        ((LAS float*)(lds + R_SEGP))[seg * 64 + c] = P; ((LAS float*)(lds + R_SEGH))[seg * 64 + c] = h;
        __syncthreads();
        float hin = (ci > 0) ? ((const LAS float*)(lds + R_CARRY))[cur * 64 + c] : 0.f;
        {
            float sp[7], sh[7];
#pragma unroll
            for (int s = 0; s < 7; ++s) { sp[s] = ((const LAS float*)(lds + R_SEGP))[s * 64 + c]; sh[s] = ((const LAS float*)(lds + R_SEGH))[s * 64 + c]; }
#pragma unroll
            for (int s = 0; s < 7; ++s) if (s < seg) hin = sp[s] * hin + sh[s];
        }
        h = hin;
        float hv[8];
#pragma unroll
        for (int j = 0; j < 8; ++j) { h = av[j] * h + bv[j]; hv[j] = h; }
#pragma unroll
        for (int j = 0; j < 8; j += 2) { typedef float f32x2 __attribute__((ext_vector_type(2)));
            const f32x2 gg = {__uint_as_float((unsigned)*(const LAS unsigned short*)(GS + (seg * 8 + j) * RP + c * 2) << 16), __uint_as_float((unsigned)*(const LAS unsigned short*)(GS + (seg * 8 + j + 1) * RP + c * 2) << 16)};
            const f32x2 wq = gg * (gg * gg * -0.10294324f + -2.3022082f);
            const f32x2 dn = (f32x2){__builtin_amdgcn_exp2f(wq.x), __builtin_amdgcn_exp2f(wq.y)} + 1.f;
            const f32x2 y = (f32x2){hv[j], hv[j + 1]} * gg * (f32x2){__builtin_amdgcn_rcpf(dn.x), __builtin_amdgcn_rcpf(dn.y)};
            *(LAS unsigned short*)(lds + R_OUTB + (seg * 8 + j) * RP + c * 2) = (unsigned short)(cvt_pk_bf16(y.x, 0.f) & 0xffffu);
            *(LAS unsigned short*)(lds + R_OUTB + (seg * 8 + j + 1) * RP + c * 2) = (unsigned short)(cvt_pk_bf16(y.y, 0.f) & 0xffffu); }
        if (seg == 7) ((LAS float*)(lds + R_CARRY))[(cur ^ 1) * 64 + c] = h;
        if (ci + 1 < SEQ / 64) {
            *(LAS u32x4*)(lds + R_XS + (cur ^ 1) * 9216 + lrow * RP + lpiece * 16) = xpre[(ci + 1) & 1]; *(LAS u32x4*)(lds + R_GS + (cur ^ 1) * 9216 + lrow * RP + lpiece * 16) = gpre[(ci + 1) & 1];
            if (ci + 3 < SEQ / 64) { const bf16_t* gn = gx + (size_t)(ci + 3) * 64 * LDZ_RG; xpre[(ci + 1) & 1] = *(const u32x4*)gn; gpre[(ci + 1) & 1] = *(const u32x4*)(gn + 1024); } }
        __syncthreads();
        *(u32x4*)(yo + (rowbase + (size_t)ci * 64 + lrow) * ldy + c0 + lpiece * 8) = *(const LAS u32x4*)(lds + R_OUTB + lrow * RP + lpiece * 16);
    }
    __syncthreads();
}

constexpr int A_K = 0, A_V = 36864, KP = 144, VP = 520;
__device__ __forceinline__ void attn_kv_load(int item, const bf16_t* zq, int tid, u32x4 (&kr)[4], u32x2 (&vr)[8]) {
    const int b = item >> 6, n = (item >> 2) & 15, kvh = item & 3;
    const int key = tid >> 1, half = tid & 1; const int pos = (n - 1) * 128 + key;
    if (pos >= 0) {
        const bf16_t* kp = zq + (size_t)(b * SEQ + pos) * LDZ_QKV + 1024 + kvh * 64 + 16 * half;
        kr[0] = *(const u32x4*)kp; kr[1] = *(const u32x4*)(kp + 8); kr[2] = *(const u32x4*)(kp + 32); kr[3] = *(const u32x4*)(kp + 40);
    } else {
        const u32x4 z = (u32x4){0u, 0u, 0u, 0u};
#pragma unroll
        for (int i = 0; i < 4; ++i) kr[i] = z;
    }
    const int kp2 = tid >> 2, dq = tid & 3; const int vpos = (n - 1) * 128 + 2 * kp2;
    if (vpos >= 0) {
        const bf16_t* vp = zq + (size_t)(b * SEQ + vpos) * LDZ_QKV + 1280 + kvh * 64 + 4 * dq;
#pragma unroll
        for (int g = 0; g < 4; ++g) { vr[2 * g] = *(const u32x2*)(vp + 16 * g); vr[2 * g + 1] = *(const u32x2*)(vp + LDZ_QKV + 16 * g); }
    } else {
#pragma unroll
        for (int i = 0; i < 8; ++i) vr[i] = (u32x2){0u, 0u};
    }
}
__device__ __forceinline__ void attn_phase(LAS unsigned char* lds, const Args& a, bf16_t* oo, int ldo, int first, int step) {
    const int tid = threadIdx.x, lane = tid & 63, w = __builtin_amdgcn_readfirstlane(tid >> 6);
    const bf16_t* zq = (const bf16_t*)(a.ws + WS_ZQKV);
    const float* cosT = (const float*)(a.ws + WS_COS); const float* sinT = (const float*)(a.ws + WS_SIN);
    const int g = w >> 1, r = lane & 31, hh = lane >> 5;
    const float C2 = 0.125f * 1.44269504f;
    int item = first; if (item >= 1024) return;
    u32x4 kr[4]; u32x2 vr[8];
    attn_kv_load(item, zq, tid, kr, vr);
    for (; item < 1024; item += step) {
        const int b = item >> 6, n = (item >> 2) & 15, kvh = item & 3, head = kvh * 4 + g;
        u32x4 qr[2][4];
#pragma unroll
        for (int qt = 0; qt < 2; ++qt) { const bf16_t* qp = zq + (size_t)(b * SEQ + n * 128 + (w & 1) * 64 + qt * 32 + r) * LDZ_QKV + head * 64;
#pragma unroll
            for (int ks = 0; ks < 4; ++ks) qr[qt][ks] = *(const u32x4*)(qp + 16 * ks + 8 * hh); }
        {
            const int key = tid >> 1, half = tid & 1; const int pos = (n - 1) * 128 + key; const int posc = pos >= 0 ? pos : 0;
            float t1[16], t2[16];
            { f32x4 p, q; unpack8(kr[0], p, q); t1[0] = p[0]; t1[1] = p[1]; t1[2] = p[2]; t1[3] = p[3]; t1[4] = q[0]; t1[5] = q[1]; t1[6] = q[2]; t1[7] = q[3];
              unpack8(kr[1], p, q); t1[8] = p[0]; t1[9] = p[1]; t1[10] = p[2]; t1[11] = p[3]; t1[12] = q[0]; t1[13] = q[1]; t1[14] = q[2]; t1[15] = q[3];
              unpack8(kr[2], p, q); t2[0] = p[0]; t2[1] = p[1]; t2[2] = p[2]; t2[3] = p[3]; t2[4] = q[0]; t2[5] = q[1]; t2[6] = q[2]; t2[7] = q[3];
              unpack8(kr[3], p, q); t2[8] = p[0]; t2[9] = p[1]; t2[10] = p[2]; t2[11] = p[3]; t2[12] = q[0]; t2[13] = q[1]; t2[14] = q[2]; t2[15] = q[3]; }
            float ss = 0.f;
#pragma unroll
            for (int i = 0; i < 16; ++i) ss += t1[i] * t1[i] + t2[i] * t2[i];
            ss += __shfl_xor(ss, 1);
            const float rinv = __builtin_amdgcn_rsqf(ss * (1.f / 64.f) + EPS);
            const float* kg = a.in[I_KG] + 16 * half; const float* cp = cosT + posc * 32 + 16 * half; const float* sp = sinT + posc * 32 + 16 * half;
            float o1[16], o2[16];
#pragma unroll
            for (int i = 0; i < 16; ++i) { const float y1 = t1[i] * rinv * kg[i], y2 = t2[i] * rinv * kg[32 + i], cc = cp[i], sn = sp[i]; o1[i] = y1 * cc - y2 * sn; o2[i] = y2 * cc + y1 * sn; }
            LAS unsigned char* kd = lds + A_K + key * KP + 32 * half;
            *(LAS u32x4*)(kd) = pack8((f32x4){o1[0], o1[1], o1[2], o1[3]}, (f32x4){o1[4], o1[5], o1[6], o1[7]});
            *(LAS u32x4*)(kd + 16) = pack8((f32x4){o1[8], o1[9], o1[10], o1[11]}, (f32x4){o1[12], o1[13], o1[14], o1[15]});
            *(LAS u32x4*)(kd + 64) = pack8((f32x4){o2[0], o2[1], o2[2], o2[3]}, (f32x4){o2[4], o2[5], o2[6], o2[7]});
            *(LAS u32x4*)(kd + 80) = pack8((f32x4){o2[8], o2[9], o2[10], o2[11]}, (f32x4){o2[12], o2[13], o2[14], o2[15]});
            const int kp2 = tid >> 2, dq = tid & 3;
            LAS unsigned char* vd = lds + A_V + (4 * dq) * VP + kp2 * 4;
#pragma unroll
            for (int g = 0; g < 4; ++g) { const unsigned a0 = vr[2 * g].x, a1 = vr[2 * g].y, b0 = vr[2 * g + 1].x, b1 = vr[2 * g + 1].y;
                *(LAS unsigned*)(vd + (16 * g + 0) * VP) = (a0 & 0xffffu) | (b0 << 16);
                *(LAS unsigned*)(vd + (16 * g + 1) * VP) = (a0 >> 16) | (b0 & 0xffff0000u);
                *(LAS unsigned*)(vd + (16 * g + 2) * VP) = (a1 & 0xffffu) | (b1 << 16);
                *(LAS unsigned*)(vd + (16 * g + 3) * VP) = (a1 >> 16) | (b1 & 0xffff0000u); }
        }
        __syncthreads();
        if (item + step < 1024) attn_kv_load(item + step, zq, tid, kr, vr);
        const float sink2 = a.in[I_SINK][head] * 1.44269504f;
#pragma unroll
        for (int qt = 0; qt < 2; ++qt) {
            const int m0 = (w & 1) * 64 + qt * 32, i0 = m0 >> 5, q = m0 + r; const int pos = n * 128 + q;
            bf16_t* op = oo + (size_t)(b * SEQ + pos) * ldo + head * 64;
            float v[4][8];
#pragma unroll
            for (int ks = 0; ks < 4; ++ks) { f32x4 p0, p1; unpack8(qr[qt][ks], p0, p1);
                v[ks][0] = p0[0]; v[ks][1] = p0[1]; v[ks][2] = p0[2]; v[ks][3] = p0[3]; v[ks][4] = p1[0]; v[ks][5] = p1[1]; v[ks][6] = p1[2]; v[ks][7] = p1[3]; }
            float ss = 0.f;
#pragma unroll
            for (int ks = 0; ks < 4; ++ks)
#pragma unroll
                for (int j = 0; j < 8; ++j) ss += v[ks][j] * v[ks][j];
            ss += __shfl_xor(ss, 32);
            const float rinv = __builtin_amdgcn_rsqf(ss * (1.f / 64.f) + EPS) * C2;
            bf16x8 qf[4];
#pragma unroll
            for (int ks = 0; ks < 2; ++ks) { const int dl = 16 * ks + 8 * hh; float o1[8], o2[8];
#pragma unroll
                for (int j = 0; j < 8; ++j) { const float y1 = v[ks][j] * rinv * a.in[I_QG][dl + j], y2 = v[ks + 2][j] * rinv * a.in[I_QG][32 + dl + j], cc = cosT[pos * 32 + dl + j], sn = sinT[pos * 32 + dl + j];
                    o1[j] = y1 * cc - y2 * sn; o2[j] = y2 * cc + y1 * sn; }
                u32x4 w1 = pack8((f32x4){o1[0], o1[1], o1[2], o1[3]}, (f32x4){o1[4], o1[5], o1[6], o1[7]}), w2 = pack8((f32x4){o2[0], o2[1], o2[2], o2[3]}, (f32x4){o2[4], o2[5], o2[6], o2[7]});
                qf[ks] = __builtin_bit_cast(bf16x8, w1); qf[ks + 2] = __builtin_bit_cast(bf16x8, w2); }
            f32x16 sacc[5];
#pragma unroll
            for (int t = 0; t < 5; ++t) { const int kt = i0 + t;
                const f32x16 zero16 = {0.f, 0.f, 0.f, 0.f, 0.f, 0.f, 0.f, 0.f, 0.f, 0.f, 0.f, 0.f, 0.f, 0.f, 0.f, 0.f};
#pragma unroll
                for (int ks = 0; ks < 4; ++ks) sacc[t] = __builtin_amdgcn_mfma_f32_32x32x16_bf16(*(const LAS bf16x8*)(lds + A_K + (32 * kt + r) * KP + ks * 32 + hh * 16), qf[ks], ks == 0 ? zero16 : sacc[t], 0, 0, 0); }
            const float NEG = -INFINITY;
#pragma unroll
            for (int e = 0; e < 16; ++e) { const int kr_ = (e & 3) + 8 * (e >> 2) + 4 * hh;
                if (!(kr_ > r)) sacc[0][e] = NEG;
                if (!(kr_ <= r)) sacc[4][e] = NEG; }
            if (n == 0) {
#pragma unroll
                for (int t = 0; t < 4; ++t) if (i0 + t < 4) {
#pragma unroll
                    for (int e = 0; e < 16; ++e) sacc[t][e] = NEG; } }
            float mx = NEG;
#pragma unroll
            for (int t = 0; t < 5; ++t)
#pragma unroll
                for (int e = 0; e < 16; ++e) mx = fmaxf(mx, sacc[t][e]);
            mx = fmaxf(mx, __shfl_xor(mx, 32));
            mx = fmaxf(mx, sink2);
            typedef float f32x2v __attribute__((ext_vector_type(2)));
            f32x2v sum2 = {0.f, 0.f};
#pragma unroll
            for (int t = 0; t < 5; ++t)
#pragma unroll
                for (int e = 0; e < 16; e += 2) { const float p0 = __builtin_amdgcn_exp2f(sacc[t][e] - mx), p1 = __builtin_amdgcn_exp2f(sacc[t][e + 1] - mx); sacc[t][e] = p0; sacc[t][e + 1] = p1; sum2 += (f32x2v){p0, p1}; }
            float sum = sum2.x + sum2.y;
            sum += __shfl_xor(sum, 32);
            const float rden = 1.f / (sum + __builtin_amdgcn_exp2f(sink2 - mx));
            f32x16 oacc[2];
#pragma unroll
            for (int t = 0; t < 5; ++t) { const int kt = i0 + t;
#pragma unroll
                for (int s2 = 0; s2 < 2; ++s2) {
                    u32x4 pw; pw.x = cvt_pk_bf16(sacc[t][8 * s2 + 0], sacc[t][8 * s2 + 1]); pw.y = cvt_pk_bf16(sacc[t][8 * s2 + 2], sacc[t][8 * s2 + 3]); pw.z = cvt_pk_bf16(sacc[t][8 * s2 + 4], sacc[t][8 * s2 + 5]); pw.w = cvt_pk_bf16(sacc[t][8 * s2 + 6], sacc[t][8 * s2 + 7]);
                    const bf16x8 pf = __builtin_bit_cast(bf16x8, pw);
#pragma unroll
                    for (int dt = 0; dt < 2; ++dt) { const LAS unsigned char* vb = lds + A_V + (32 * dt + r) * VP + (32 * kt + 16 * s2 + 4 * hh) * 2;
                        const s16x4 lo = *(const LAS s16x4*)vb, hi = *(const LAS s16x4*)(vb + 16);
                        const bf16x8 vf = __builtin_shufflevector(lo, hi, 0, 1, 2, 3, 4, 5, 6, 7);
                        const f32x16 zero16 = {0.f, 0.f, 0.f, 0.f, 0.f, 0.f, 0.f, 0.f, 0.f, 0.f, 0.f, 0.f, 0.f, 0.f, 0.f, 0.f};
                        oacc[dt] = __builtin_amdgcn_mfma_f32_32x32x16_bf16(vf, pf, (t == 0 && s2 == 0) ? zero16 : oacc[dt], 0, 0, 0); } } }
#pragma unroll
            for (int dt = 0; dt < 2; ++dt)
#pragma unroll
                for (int gq = 0; gq < 4; ++gq) { u32x2 ow; ow.x = cvt_pk_bf16(oacc[dt][4 * gq + 0] * rden, oacc[dt][4 * gq + 1] * rden); ow.y = cvt_pk_bf16(oacc[dt][4 * gq + 2] * rden, oacc[dt][4 * gq + 3] * rden);
                    *(u32x2*)(op + 32 * dt + 8 * gq + 4 * hh) = ow; }
        }
        __syncthreads();
    }
}

#define XB_TMO      128
#define XB_XCNT(j)  (256  + 64 * (j))
#define XB_XSUB(j)  (1280 + 64 * (j))
#define XB_XGEN(j)  (2304 + 64 * (j))
#define XB_TOP      3328
#define XB_TOPGEN   3392
#define XCD_BAR_WORDS 3456
#define XB_SPIN_CAP (1u << 18)
__device__ __forceinline__ unsigned xb_ld(unsigned* p)              { return __hip_atomic_load(p, __ATOMIC_RELAXED, __HIP_MEMORY_SCOPE_AGENT); }
__device__ __forceinline__ unsigned xb_add(unsigned* p, unsigned v) { return __hip_atomic_fetch_add(p, v, __ATOMIC_RELAXED, __HIP_MEMORY_SCOPE_AGENT); }
__device__ __forceinline__ unsigned xb_xcc_id() { return (unsigned)__builtin_amdgcn_s_getreg((3 << 11) | 20) & 0xFu; }
#define XB_SPIN(cond, bar) do { unsigned _sp = 0; while (cond) { __builtin_amdgcn_s_sleep(1); \
    if ((++_sp & 255u) == 0u) { if (xb_ld(&(bar)[XB_TMO])) break; if (_sp > XB_SPIN_CAP) { atomicAdd(&(bar)[XB_TMO], 1u); break; } } } } while (0)
struct XcdBarrier { unsigned* bar; unsigned x; volatile LAS unsigned* st; };
__device__ __forceinline__ XcdBarrier xcd_barrier_post(unsigned* bar, volatile LAS unsigned* st) {
    XcdBarrier b; b.bar = bar; b.x = xb_xcc_id(); b.st = st;
    if (threadIdx.x == 0) (void)xb_add(&bar[XB_XCNT(b.x)], 1u);
    return b;
}
__device__ __forceinline__ void xcd_barrier_complete(unsigned* bar, unsigned x, unsigned& nloc, unsigned& nx) {
    const unsigned G = gridDim.x * gridDim.y * gridDim.z;
    unsigned sum, cnt, mine, sp = 0u;
    for (;;) {
        sum = 0u; cnt = 0u; mine = 0u;
#pragma unroll
        for (unsigned j = 0; j < 16; ++j) { const unsigned c = xb_ld(&bar[XB_XCNT(j)]); sum += c; cnt += (c > 0u) ? 1u : 0u; mine = (j == x) ? c : mine; }
        if (sum == G) break;
        __builtin_amdgcn_s_sleep(1);
        if ((++sp & 255u) == 0u) { if (xb_ld(&bar[XB_TMO])) break; if (sp > XB_SPIN_CAP) { atomicAdd(&bar[XB_TMO], 1u); break; } }
    }
    nloc = mine > 0u ? mine : 1u; nx = cnt > 0u ? cnt : 1u;
}
__device__ __forceinline__ void xcd_barrier(const XcdBarrier& b) {
    asm volatile("s_waitcnt vmcnt(0)" ::: "memory");
    __syncthreads();
    if (threadIdx.x == 0) {
        unsigned* bar = b.bar;
        __builtin_amdgcn_s_waitcnt(0);
        unsigned nloc = b.st[0], nx = b.st[1]; const unsigned xg = b.st[3];
        if (nloc == 0u) { xcd_barrier_complete(bar, b.x, nloc, nx); b.st[0] = nloc; b.st[1] = nx; }
        const unsigned old = xb_add(&bar[XB_XSUB(b.x)], 1u);
        const unsigned gen = old / nloc;
        if (old + 1u == (gen + 1u) * nloc) {
            __builtin_amdgcn_fence(__ATOMIC_RELEASE, "agent");
            asm volatile("s_waitcnt vmcnt(0)" ::: "memory");
            const unsigned og = xb_add(&bar[XB_TOP], 1u);
            const unsigned tg = og / nx;
            if (og + 1u == (tg + 1u) * nx) xb_add(&bar[XB_TOPGEN], 1u);
            else XB_SPIN(xb_ld(&bar[XB_TOPGEN]) == tg, bar);
            __builtin_amdgcn_fence(__ATOMIC_ACQUIRE, "agent");
            xb_add(&bar[XB_XGEN(b.x)], 1u);
            asm volatile("s_waitcnt vmcnt(0)" ::: "memory");
        } else {
            XB_SPIN(xb_ld(&bar[XB_XGEN(b.x)]) == xg, bar);
            __builtin_amdgcn_fence(__ATOMIC_ACQUIRE, "agent");
            asm volatile("s_waitcnt vmcnt(0)" ::: "memory");
        }
        b.st[3] = xg + 1u;
    }
    __syncthreads();
}
__device__ __forceinline__ void xcd_arrive(const XcdBarrier& b) {
    asm volatile("s_waitcnt vmcnt(0)" ::: "memory");
    __syncthreads();
    if (threadIdx.x == 0) {
        unsigned* bar = b.bar;
        __builtin_amdgcn_s_waitcnt(0);
        unsigned nloc = b.st[0], nx = b.st[1];
        if (nloc == 0u) { xcd_barrier_complete(bar, b.x, nloc, nx); b.st[0] = nloc; b.st[1] = nx; }
        const unsigned old = xb_add(&bar[XB_XSUB(b.x)], 1u);
        const unsigned gen = old / nloc;
        b.st[2] = gen;
        if (old + 1u == (gen + 1u) * nloc) {
            __builtin_amdgcn_fence(__ATOMIC_RELEASE, "agent");
            asm volatile("s_waitcnt vmcnt(0)" ::: "memory");
            const unsigned og = xb_add(&bar[XB_TOP], 1u);
            const unsigned tg = og / nx;
            if (og + 1u == (tg + 1u) * nx) xb_add(&bar[XB_TOPGEN], 1u);
        }
    }
}
__device__ __forceinline__ void xcd_wait(const XcdBarrier& b) {
    __syncthreads();
    if (threadIdx.x == 0) {
        unsigned* bar = b.bar;
        const unsigned gen = b.st[2];
        XB_SPIN(xb_ld(&bar[XB_TOPGEN]) == gen, bar);
        __builtin_amdgcn_fence(__ATOMIC_ACQUIRE, "agent");
        asm volatile("s_waitcnt vmcnt(0)" ::: "memory");
    }
    __syncthreads();
}

__global__ void __launch_bounds__(512) fwd_megakernel(Args a) {
    extern __shared__ __attribute__((aligned(16))) unsigned char lds_raw[];
    LAS unsigned char* lds = (LAS unsigned char*)lds_raw;
    cg::grid_group grid = cg::this_grid();
    const int G = gridDim.x, lo = a.ph_lo, hi = a.ph_hi;
    unsigned char* ws = a.ws;
    float* ssq0 = (float*)(ws + WS_SSQ0); float* ssq1 = (float*)(ws + WS_SSQ1); float* ssq2 = (float*)(ws + WS_SSQ2);
    bf16_t* XB = (bf16_t*)(ws + WS_XB); bf16_t* PB = (bf16_t*)(ws + WS_PB); bf16_t* ZRG = (bf16_t*)(ws + WS_ZRG); bf16_t* ZQKV = (bf16_t*)(ws + WS_ZQKV); bf16_t* ZG = (bf16_t*)(ws + WS_ZG);
    bf16_t* U = (bf16_t*)(ws + WS_U);
#define IN(k) (lo <= (k) && (k) < hi)
#define SEAM(k) do { if (IN(k) && IN((k) + 1)) xcd_barrier(bar); } while (0)
#define SEAM_FILL(k, filler) do { if (IN(k) && IN((k) + 1)) xcd_arrive(bar); if (IN(k)) { filler; } if (IN(k) && IN((k) + 1)) xcd_wait(bar); } while (0)
    volatile LAS unsigned* MISC = (volatile LAS unsigned*)(lds + 131072);
    if (threadIdx.x < 32) MISC[threadIdx.x] = 0u;
    __syncthreads();
    XcdBarrier bar; bar.bar = (unsigned*)(ws + WS_BAR); bar.x = 0; bar.st = MISC + 8;
    if (hi - lo > 1) bar = xcd_barrier_post((unsigned*)(ws + WS_BAR), MISC + 8);
    if (hi > 1000) grid.sync();
    if (IN(0)) {
#pragma nounroll
        for (int rep = 0; rep < (PROBE_MODE == 4 ? 2 : 1); ++rep) { p0_prologue(a, lds, G); __syncthreads(); }
    }
#if PROBE_MODE == 7
    for (int i = 0; i < 8; ++i) grid.sync();
#endif
    SEAM_FILL(0, (convert_weights<WJ_RNN | WJ_ATT | WJ_OUT | WJ_RG | WJ_IG | WJ_PLE>(a, lds, G), setup_misc(a, G)));
    if (IN(1)) { pg8::Gemm g{XB, (const bf16_t*)(ws + WS_WIN), M, NIN, DM, DM, DM, nullptr, nullptr, 0}; pg8::StaticOrder S; S.init(M, NIN, G, (int)blockIdx.x);
        EpiIn E{ZRG, ZQKV, ZG, ssq0}; pg8::gemm_phase(lds, g, S, E);
#if PROBE_MODE == 3
        pg8::gemm_phase(lds, g, S, E);
#endif
    }
    SEAM_FILL(1, convert_p(a, G));
    if (IN(2)) {
        attn_phase(lds, a, ZQKV, LDZ_QKV, (int)blockIdx.x, G);
        for (int it = blockIdx.x; it < 256; it += G) rnn_item(lds, it, a, ZRG + 1024, LDZ_RG);
#if PROBE_MODE == 1
        for (int it = blockIdx.x; it < 256; it += G) rnn_item(lds, it, a, XB, DM);
#elif PROBE_MODE == 2
        attn_phase(lds, a, XB, DM, (int)blockIdx.x, G);
#endif
    }
    SEAM_FILL(2, (convert_weights<WJ_UP>(a, lds, G)));
    bf16_t* XC = (bf16_t*)(ws + WS_XC);
    if (IN(3)) { pg8::Gemm g{ZRG + 1024, (const bf16_t*)(ws + WS_WRNN), M, DM, DM, LDZ_RG, DM, ZQKV, (const bf16_t*)(ws + WS_WATT), LDZ_QKV}; pg8::StaticOrder S; S.init(M, DM, G, (int)blockIdx.x);
        EpiMerge E{ZG, ZG + 1024, LDZ_G, ZRG, LDZ_RG}; pg8::gemm_phase<EpiMerge, true>(lds, g, S, E); }
    SEAM_FILL(3, (convert_weights<WJ_DN>(a, lds, G)));
    if (IN(5)) { pg8::Gemm g{ZRG, (const bf16_t*)(ws + WS_WOUT), M, DM, DM, LDZ_RG, DM, nullptr, nullptr, 0}; pg8::StaticOrder S; S.init(M, DM, G, (int)blockIdx.x);
        EpiRes<1> E{XB, XC, ssq1}; pg8::gemm_phase(lds, g, S, E); }
    SEAM_FILL(5, (convert_weights<WJ_GATE>(a, lds, G)));
    if (IN(6)) { pg8::Gemm g{XC, (const bf16_t*)(ws + WS_WUP), M, DFF, DM, DM, DM, nullptr, nullptr, 0}; pg8::StaticOrder S; S.init(M, DFF, G, (int)blockIdx.x);
        EpiUp E{ssq1, U}; pg8::gemm_phase(lds, g, S, E); }
#define PLE_FILLER(round) do { pg8::Gemm g{PB, (const bf16_t*)(ws + WS_WPLE), M, DM, PLE, PLE, PLE, nullptr, nullptr, 0}; pg8::StaticOrder S; S.init(M, DM, G, (int)blockIdx.x); S.i0 = (round); S.imax = 1; \
        EpiPlain E{XB}; pg8::gemm_phase(lds, g, S, E); } while (0)
    SEAM_FILL(6, PLE_FILLER(0));
    if (IN(7)) {
        { pg8::Gemm g{U, (const bf16_t*)(ws + WS_WDN), M, DM, DFF, DFF, DFF, nullptr, nullptr, 0}; pg8::StaticOrder S; S.init(M, DM, G, (int)blockIdx.x);
          EpiRes<2> E{XC, XC, ssq2}; pg8::gemm_phase(lds, g, S, E); }
    }
    SEAM_FILL(7, PLE_FILLER(1));
    if (IN(8)) { pg8::Gemm g{XC, (const bf16_t*)(ws + WS_WGATE), M, DM, DM, DM, DM, nullptr, nullptr, 0}; pg8::StaticOrder S; S.init(M, DM, G, (int)blockIdx.x);
        EpiFinal E{ssq2, XB, XC, a.out}; pg8::gemm_phase(lds, g, S, E); }
#undef IN
#undef SEAM
#undef SEAM_FILL
#undef PLE_FILLER
}

extern "C" void kernel_launch(void* const* d_in, const int* in_sizes, int n_in, void* d_out, int out_size, void* d_ws, size_t ws_size, hipStream_t stream) {
    static int grid = 0;
    if (grid == 0) {
        if (n_in != 23 || out_size != M * DM || ws_size < WS_END) { fprintf(stderr, "kernel_launch: unexpected shapes (n_in %d out %d ws %zu)\n", n_in, out_size, ws_size); grid = -1; return; }
        int dev = 0, cus = 0, per_cu = 0;
        hipGetDevice(&dev); hipDeviceGetAttribute(&cus, hipDeviceAttributeMultiprocessorCount, dev);
        hipFuncSetAttribute((const void*)fwd_megakernel, hipFuncAttributeMaxDynamicSharedMemorySize, LDS_BYTES);
        hipOccupancyMaxActiveBlocksPerMultiprocessor(&per_cu, (const void*)fwd_megakernel, 512, LDS_BYTES);
        (void)hipGetLastError();
        if (per_cu < 1) fprintf(stderr, "kernel_launch: occupancy query says %d\n", per_cu);
        grid = cus > 0 ? cus : 256;
    }
    if (grid < 0) return;
    Args a{};
    for (int i = 0; i < 23; ++i) a.in[i] = (const float*)d_in[i];
    a.out = (float*)d_out; a.ws = (unsigned char*)d_ws;
#if MK_N_LAUNCHES == 1
    a.ph_lo = 0; a.ph_hi = 9;
    void* args[] = {&a};
    (void)hipMemsetAsync((char*)d_ws + WS_BAR, 0, XCD_BAR_WORDS * 4, stream);
    hipError_t e = hipLaunchCooperativeKernel((const void*)fwd_megakernel, dim3(grid), dim3(512), args, LDS_BYTES, stream);
    if (e != hipSuccess) fprintf(stderr, "cooperative launch failed: %s (grid %d)\n", hipGetErrorString(e), grid);
#else
    for (int ph = 0; ph < 9; ++ph) { a.ph_lo = ph; a.ph_hi = ph + 1; hipLaunchKernelGGL(fwd_megakernel, dim3(grid), dim3(512), LDS_BYTES, stream, a); }
#endif
}
```

```cpp
#include <hip/hip_runtime.h>
#include <hip/hip_cooperative_groups.h>
#include <cstdio>
#include <cstdint>
namespace cg = cooperative_groups;

#ifndef MK_N_LAUNCHES
#define MK_N_LAUNCHES 1
#endif

#ifndef PROBE_MODE
#define PROBE_MODE 0
#endif
#define LAS __attribute__((address_space(3)))
typedef unsigned short bf16_t;
typedef short bf16x8 __attribute__((ext_vector_type(8)));
typedef short s16x4 __attribute__((ext_vector_type(4)));
typedef float f32x4 __attribute__((ext_vector_type(4)));
typedef float f32x16 __attribute__((ext_vector_type(16)));
typedef unsigned u32x4 __attribute__((ext_vector_type(4)));
typedef unsigned u32x2 __attribute__((ext_vector_type(2)));

constexpr int M = 32768, DM = 1024, SEQ = 2048, NIN = 5632, DFF = 4096, PLE = 256;
constexpr float EPS = 1e-6f;
constexpr int LDZ_RG = 2048, LDZ_QKV = 1536, LDZ_G = 2048;

constexpr size_t MiB = 1u << 20, KiB = 1u << 10;
constexpr size_t WS_SSQ0 = 0, WS_SSQ1 = 128 * KiB, WS_SSQ2 = 256 * KiB, WS_COS = 512 * KiB, WS_SIN = 768 * KiB;
constexpr size_t WS_BAR = 384 * KiB;
constexpr size_t WS_WRG = 1 * MiB, WS_WIG = 1 * MiB + 128 * KiB;
constexpr size_t WS_WIN = 2 * MiB, WS_WRNN = 13 * MiB, WS_WATT = 15 * MiB, WS_WOUT = 17 * MiB, WS_WUP = 19 * MiB, WS_WDN = 27 * MiB, WS_WGATE = 35 * MiB, WS_WPLE = 37 * MiB;
constexpr size_t WS_XB = 38 * MiB;
constexpr size_t WS_PB = 102 * MiB;
constexpr size_t WS_ZRG = 118 * MiB;
constexpr size_t WS_ZQKV = 246 * MiB;
constexpr size_t WS_ZG = 342 * MiB;
constexpr size_t WS_XC = 406 * MiB;
constexpr size_t WS_U = 118 * MiB;
constexpr size_t WS_END = 470 * MiB;

constexpr int LDS_BYTES = 147456;

__device__ __forceinline__ unsigned cvt_pk_bf16(float lo, float hi) { unsigned r; asm volatile("v_cvt_pk_bf16_f32 %0, %1, %2" : "=v"(r) : "v"(lo), "v"(hi)); return r; }
__device__ __forceinline__ float bflo(unsigned w) { return __uint_as_float(w << 16); }
__device__ __forceinline__ float bfhi(unsigned w) { return __uint_as_float(w & 0xffff0000u); }
__device__ __forceinline__ float sigm(float x) { return __builtin_amdgcn_rcpf(1.f + __builtin_amdgcn_exp2f(-1.44269504f * x)); }
__device__ __forceinline__ f32x4 exp2v(f32x4 v) { return (f32x4){__builtin_amdgcn_exp2f(v.x), __builtin_amdgcn_exp2f(v.y), __builtin_amdgcn_exp2f(v.z), __builtin_amdgcn_exp2f(v.w)}; }
__device__ __forceinline__ f32x4 rcpv(f32x4 v) { return (f32x4){__builtin_amdgcn_rcpf(v.x), __builtin_amdgcn_rcpf(v.y), __builtin_amdgcn_rcpf(v.z), __builtin_amdgcn_rcpf(v.w)}; }
__device__ __forceinline__ f32x4 maxv(f32x4 v, float lo) { return (f32x4){fmaxf(v.x, lo), fmaxf(v.y, lo), fmaxf(v.z, lo), fmaxf(v.w, lo)}; }
__device__ __forceinline__ f32x4 expnegv(f32x4 x) { return exp2v(maxv(x, -60.f) * -1.44269504f); }

namespace pg8 {
constexpr int BM = 256, BK = 64, HALF = 128, HTB = HALF * BK * 2, STAGE_BYTES = 8 * HTB, NXCD = 8, WGM = 8;
__host__ __device__ __forceinline__ int lds_byte(int r, int c) { const int st = (r >> 4) * 2 + (c >> 5), rr = r & 15, cc = c & 31, ob = rr * 64 + cc * 2; return st * 1024 + (ob ^ (((ob >> 9) & 1) << 5)); }
__host__ __device__ __forceinline__ void stage_rc(int b, int& R, int& C) { const int st = b / 1024, sb = b % 1024, swz = sb ^ (((sb >> 9) & 1) << 5); R = (st >> 1) * 16 + swz / 64; C = (st & 1) * 32 + (swz % 64) / 2; }
__host__ __device__ __forceinline__ int perm32(int rho) { const int n = rho >> 4, i = rho & 15; return 8 * (i >> 2) + 4 * n + (i & 3); }

struct Unit { int pm, pn; };
struct Gemm { const bf16_t* A; const bf16_t* Bt; int M, N, K, lda, ldb; const bf16_t* A1; const bf16_t* Bt1; int lda1; };

struct StaticOrder {
    int nM, nN, nwg, G, c, i0 = 0, imax = 1 << 30;
    __host__ __device__ void init(int M_, int N_, int G_, int c_) { nM = M_ / BM; nN = N_ / BM; nwg = nM * nN; G = G_; c = c_; }
    __host__ __device__ bool next(int i, Unit& u) const {
        if (i >= imax) return false;
        const long L = (long)(i + i0) * G + c; if (L >= nwg) return false;
        int wgid = (int)L; { const int q = nwg / NXCD, r = nwg % NXCD, xcd = wgid % NXCD, off = wgid / NXCD; wgid = (xcd < r ? xcd * (q + 1) : r * (q + 1) + (xcd - r) * q) + off; }
        const int nig = WGM * nN, gid = wgid / nig, fm = gid * WGM, gsz = (nM - fm) < WGM ? (nM - fm) : WGM;
        u.pm = fm + ((wgid % nig) % gsz); u.pn = (wgid % nig) / gsz; return true;
    }
};

template <class Epi, bool DUAL = false>
__device__ __forceinline__ void gemm_phase(LAS unsigned char* lds, const Gemm g, const StaticOrder& S, const Epi& E) {
    const int tid = threadIdx.x, wid = __builtin_amdgcn_readfirstlane(tid >> 6), lane = tid & 63, wr = wid >> 2, wc = wid & 3, fr = lane & 15, fq = lane >> 4;
    const int K = g.K, nt = K / BK;
    unsigned voffA0[2], voffA1[2], voffB[2];
#pragma unroll
    for (int i = 0; i < 2; ++i) { int R, C; stage_rc(tid * 16 + i * 8192, R, C); const int Rb = (R & ~31) + perm32(R & 31);
        voffA0[i] = (unsigned)(R * g.lda + C) * 2u; voffA1[i] = DUAL ? (unsigned)(R * g.lda1 + C) * 2u : voffA0[i]; voffB[i] = (unsigned)(Rb * g.ldb + C) * 2u; }
    const size_t kstep = (size_t)(BK * 2);
    const size_t hstepA0 = (size_t)HALF * g.lda * 2, hstepA1 = DUAL ? (size_t)HALF * g.lda1 * 2 : hstepA0, hstepB = (size_t)HALF * g.ldb * 2;
    const size_t tstepA0 = 2 * hstepA0, tstepA1 = 2 * hstepA1, tstepB = 2 * hstepB;
    const unsigned ldsw = (unsigned)wid * 1024u;
    const int aoff = lds_byte(wr * 64 + fr, fq * 8), boff = lds_byte(wc * 32 + fr, fq * 8);
#define PG8_SA(b, h) (((b) * 2 + (h)) * HTB)
#define PG8_SB(b, h) ((4 + (b) * 2 + (h)) * HTB)
#define PG8_STAGE2(bufoff, gbase, v0, v1) do { \
        __builtin_amdgcn_global_load_lds((const unsigned*)((const char*)(gbase) + (v0)), (LAS unsigned*)(lds + (bufoff) + ldsw), 16, 0, 0); \
        __builtin_amdgcn_global_load_lds((const unsigned*)((const char*)(gbase) + (v1)), (LAS unsigned*)(lds + (bufoff) + ldsw + 8192), 16, 0, 0); } while (0)
#define PG8_STAGEB(bufoff, gbase) PG8_STAGE2(bufoff, gbase, voffB[0], voffB[1])
#define PG8_LDA(dst, b, h) do { _Pragma("unroll") for (int m = 0; m < 4; ++m) _Pragma("unroll") for (int k = 0; k < 2; ++k) dst[m][k] = *(const LAS bf16x8*)(lds + PG8_SA(b, h) + aoff + m * 2048 + k * 1024); } while (0)
#define PG8_LDB(dst, b, h) do { _Pragma("unroll") for (int n = 0; n < 2; ++n) _Pragma("unroll") for (int k = 0; k < 2; ++k) dst[n][k] = *(const LAS bf16x8*)(lds + PG8_SB(b, h) + boff + n * 2048 + k * 1024); } while (0)
#define PG8_MMA(ai, bj, At, Bt) do { __builtin_amdgcn_s_setprio(1); _Pragma("unroll") for (int m = 0; m < 4; ++m) _Pragma("unroll") for (int n = 0; n < 2; ++n) _Pragma("unroll") for (int k = 0; k < 2; ++k) \
        acc[ai][bj][m][n] = __builtin_amdgcn_mfma_f32_16x16x32_bf16(Bt[n][k], At[m][k], acc[ai][bj][m][n], 0, 0, 0); __builtin_amdgcn_s_setprio(0); } while (0)
#define PG8_WAIT_V(n) asm volatile("s_waitcnt vmcnt(" #n ")" ::: "memory")
#define PG8_WAIT_L(n) asm volatile("s_waitcnt lgkmcnt(" #n ")" ::: "memory")
#define PG8_BAR __builtin_amdgcn_s_barrier()
#define PG8_SCHED __builtin_amdgcn_sched_barrier(0)
    Unit cur, nxt; int ui = 0;
    if (!S.next(0, cur)) return;
    f32x4 acc[2][2][4][2];
#pragma unroll
    for (int a = 0; a < 2; ++a)
#pragma unroll
        for (int b = 0; b < 2; ++b)
#pragma unroll
            for (int m = 0; m < 4; ++m)
#pragma unroll
                for (int n = 0; n < 2; ++n) acc[a][b][m][n] = (f32x4){0.f, 0.f, 0.f, 0.f};
    bf16x8 At[4][2], B0[2][2], B1[2][2];
    const char* cA = (const char*)g.A + (size_t)cur.pm * tstepA0; const char* cB = (const char*)g.Bt + (size_t)cur.pn * tstepB;
    PG8_STAGEB(PG8_SB(0, 0), cB); PG8_STAGEB(PG8_SB(0, 1), cB + hstepB); PG8_STAGE2(PG8_SA(0, 0), cA, voffA0[0], voffA0[1]); PG8_STAGE2(PG8_SA(0, 1), cA + hstepA0, voffA0[0], voffA0[1]);
    if (wr == 1) PG8_BAR;
    PG8_WAIT_V(2); PG8_BAR;
    PG8_STAGEB(PG8_SB(1, 0), cB + kstep); PG8_STAGE2(PG8_SA(1, 0), cA + kstep, voffA0[0], voffA0[1]); PG8_STAGEB(PG8_SB(1, 1), cB + hstepB + kstep);
    PG8_WAIT_V(6); PG8_BAR;
    for (;;) {
        const bool has_next = S.next(ui + 1, nxt);
#pragma unroll
        for (int sg = 0; sg < (DUAL ? 2 : 1); ++sg) {
            const bool to_seg1 = DUAL && sg == 0;
            const unsigned vc0 = sg ? voffA1[0] : voffA0[0], vc1 = sg ? voffA1[1] : voffA0[1]; const size_t hc = sg ? hstepA1 : hstepA0;
            const char* nA; const char* nB; unsigned vn0, vn1; size_t hn;
            if (to_seg1) { nA = (const char*)g.A1 + (size_t)cur.pm * tstepA1; nB = (const char*)g.Bt1 + (size_t)cur.pn * tstepB; vn0 = voffA1[0]; vn1 = voffA1[1]; hn = hstepA1; }
            else if (has_next) { nA = (const char*)g.A + (size_t)nxt.pm * tstepA0; nB = (const char*)g.Bt + (size_t)nxt.pn * tstepB; vn0 = voffA0[0]; vn1 = voffA0[1]; hn = hstepA0; }
            else { nA = cA; nB = cB; vn0 = vc0; vn1 = vc1; hn = hc; }
            for (int t = 0; t < nt; t += 2) {
                const bool last = (t == nt - 2);
                const char* a1 = cA + (size_t)(t + 1) * kstep;
                const char* a2 = last ? nA : cA + (size_t)(t + 2) * kstep; const char* b2 = last ? nB : cB + (size_t)(t + 2) * kstep;
                const char* a3 = a2 + kstep; const char* b3 = b2 + kstep;
                const unsigned vx0 = last ? vn0 : vc0, vx1 = last ? vn1 : vc1; const size_t hx = last ? hn : hc;
                PG8_LDB(B0, 0, 0); PG8_LDB(B1, 0, 1); PG8_SCHED; PG8_LDA(At, 0, 0); PG8_STAGE2(PG8_SA(1, 1), a1 + hc, vc0, vc1);
                PG8_WAIT_V(8); PG8_WAIT_L(0); PG8_BAR; PG8_MMA(0, 0, At, B0); PG8_MMA(0, 1, At, B1); PG8_BAR; PG8_SCHED;
                PG8_LDA(At, 0, 1); PG8_STAGEB(PG8_SB(0, 0), b2); PG8_STAGEB(PG8_SB(0, 1), b2 + hstepB); PG8_STAGE2(PG8_SA(0, 0), a2, vx0, vx1);
                PG8_WAIT_V(8); PG8_WAIT_L(0); PG8_BAR; PG8_MMA(1, 0, At, B0); PG8_MMA(1, 1, At, B1); PG8_BAR; PG8_SCHED;
                PG8_LDB(B0, 1, 0); PG8_LDB(B1, 1, 1); PG8_SCHED; PG8_LDA(At, 1, 0); PG8_STAGE2(PG8_SA(0, 1), a2 + hx, vx0, vx1);
                PG8_WAIT_V(8); PG8_WAIT_L(0); PG8_BAR; PG8_MMA(0, 0, At, B0); PG8_MMA(0, 1, At, B1); PG8_BAR; PG8_SCHED;
                PG8_LDA(At, 1, 1); PG8_STAGEB(PG8_SB(1, 0), b3); PG8_STAGEB(PG8_SB(1, 1), b3 + hstepB); PG8_STAGE2(PG8_SA(1, 0), a3, vx0, vx1);
                PG8_WAIT_V(8); PG8_WAIT_L(0); PG8_BAR; PG8_MMA(1, 0, At, B0); PG8_MMA(1, 1, At, B1); PG8_BAR; PG8_SCHED;
            }
            if constexpr (DUAL) { if (sg == 0) { PG8_SCHED; E.mid(acc, cur, wr, wc, fr, fq); PG8_SCHED; } }
            cA = nA; cB = nB;
        }
        if (wr == 0) PG8_BAR;
        E(acc, cur, wr, wc, fr, fq);
        if (!has_next) break;
        bf16x8 zfrag = {0, 0, 0, 0, 0, 0, 0, 0}; asm volatile("" : "+v"(zfrag));
#pragma unroll
        for (int a = 0; a < 2; ++a)
#pragma unroll
            for (int b = 0; b < 2; ++b)
#pragma unroll
                for (int m = 0; m < 4; ++m)
#pragma unroll
                    for (int n = 0; n < 2; ++n) acc[a][b][m][n] = __builtin_amdgcn_mfma_f32_16x16x32_bf16(zfrag, zfrag, (f32x4){0.f, 0.f, 0.f, 0.f}, 0, 0, 0);
        cur = nxt; ++ui;
        if (wr == 1) PG8_BAR;
    }
    PG8_WAIT_V(0);
    PG8_BAR;
#undef PG8_SA
#undef PG8_SB
#undef PG8_STAGE2
#undef PG8_STAGEB
#undef PG8_LDA
#undef PG8_LDB
#undef PG8_MMA
#undef PG8_WAIT_V
#undef PG8_WAIT_L
#undef PG8_BAR
#undef PG8_SCHED
}
}

typedef f32x4 AccT[2][2][4][2];
#define EPI_LOOP_ROWS  _Pragma("unroll") for (int ai = 0; ai < 2; ++ai) _Pragma("unroll") for (int m = 0; m < 4; ++m)
__device__ __forceinline__ u32x4 pack8(f32x4 v0, f32x4 v1) { u32x4 w; w.x = cvt_pk_bf16(v0[0], v0[1]); w.y = cvt_pk_bf16(v0[2], v0[3]); w.z = cvt_pk_bf16(v1[0], v1[1]); w.w = cvt_pk_bf16(v1[2], v1[3]); return w; }
__device__ __forceinline__ void unpack8(u32x4 w, f32x4& v0, f32x4& v1) { v0 = (f32x4){bflo(w.x), bfhi(w.x), bflo(w.y), bfhi(w.y)}; v1 = (f32x4){bflo(w.z), bfhi(w.z), bflo(w.w), bfhi(w.w)}; }

#define EPI_M _Pragma("unroll") for (int m = 0; m < 4; ++m)
#define EPI_BJ _Pragma("unroll") for (int bj = 0; bj < 2; ++bj)
struct EpiIn {
    bf16_t *zrg, *zqkv, *zg; const float* ssq;
    __device__ __forceinline__ void operator()(const AccT& acc, const pg8::Unit& u, int wr, int wc, int fr, int fq) const {
        bf16_t* base; int ld, colt;
        if (u.pn < 8) { base = zrg; ld = LDZ_RG; colt = u.pn * 256; } else if (u.pn < 14) { base = zqkv; ld = LDZ_QKV; colt = (u.pn - 8) * 256; } else { base = zg; ld = LDZ_G; colt = (u.pn - 14) * 256; }
        const int row0 = u.pm * 256 + wr * 64 + fr, col0 = colt + wc * 32 + 8 * fq;
        float sv[2][4];
        EPI_LOOP_ROWS sv[ai][m] = ssq[row0 + ai * 128 + m * 16];
        EPI_LOOP_ROWS { const int row = row0 + ai * 128 + m * 16; const float s = __builtin_amdgcn_rsqf(sv[ai][m] * (1.f / DM) + EPS); bf16_t* rowp = base + (size_t)row * ld + col0;
            EPI_BJ *(u32x4*)(rowp + bj * 128) = pack8(acc[ai][bj][m][0] * s, acc[ai][bj][m][1] * s); }
    }
};
struct EpiMerge {
    const bf16_t* ga; const bf16_t* gb; int ldg; bf16_t* O; int ldo;
    __device__ __forceinline__ void mid(AccT& acc, const pg8::Unit& u, int wr, int wc, int fr, int fq) const {
        int row0 = u.pm * 256 + wr * 64 + fr, col0 = u.pn * 256 + wc * 32 + 8 * fq;
        asm volatile("" : "+v"(row0), "+v"(col0));
        u32x4 av[2][2][2], bv[2][2][2];
#pragma unroll
        for (int b = 0; b < 5; ++b) {
            if (b < 4) {
#pragma unroll
                for (int mm = 0; mm < 2; ++mm) EPI_BJ { const size_t off = (size_t)(row0 + (b >> 1) * 128 + (2 * (b & 1) + mm) * 16) * ldg + col0 + bj * 128; av[b & 1][mm][bj] = *(const u32x4*)(ga + off); bv[b & 1][mm][bj] = *(const u32x4*)(gb + off); }
            }
            if (b >= 1) { const int c = b - 1, ai = c >> 1;
#pragma unroll
                for (int mm = 0; mm < 2; ++mm) { const int m = 2 * (c & 1) + mm;
                    EPI_BJ { f32x4 a0, a1, b0, b1; unpack8(av[c & 1][mm][bj], a0, a1); unpack8(bv[c & 1][mm][bj], b0, b1);
                        acc[ai][bj][m][0] *= (expnegv(b0) + 1.f) * rcpv(exp2v(a0 * -1.44269504f) + 1.f);
                        acc[ai][bj][m][1] *= (expnegv(b1) + 1.f) * rcpv(exp2v(a1 * -1.44269504f) + 1.f); }
                    asm volatile("" : "+v"(acc[ai][0][m][0]), "+v"(acc[ai][0][m][1]), "+v"(acc[ai][1][m][0]), "+v"(acc[ai][1][m][1]) :: "memory"); }
            }
        }
    }
    __device__ __forceinline__ void operator()(const AccT& acc, const pg8::Unit& u, int wr, int wc, int fr, int fq) const {
        const int row0 = u.pm * 256 + wr * 64 + fr, col0 = u.pn * 256 + wc * 32 + 8 * fq;
        u32x4 bv[2][4][2];
        EPI_LOOP_ROWS EPI_BJ bv[ai][m][bj] = *(const u32x4*)(gb + (size_t)(row0 + ai * 128 + m * 16) * ldg + col0 + bj * 128);
        EPI_LOOP_ROWS EPI_BJ { f32x4 b0, b1; unpack8(bv[ai][m][bj], b0, b1);
            const f32x4 v0 = acc[ai][bj][m][0] * rcpv(expnegv(b0) + 1.f), v1 = acc[ai][bj][m][1] * rcpv(expnegv(b1) + 1.f);
            *(u32x4*)(O + (size_t)(row0 + ai * 128 + m * 16) * ldo + col0 + bj * 128) = pack8(v0, v1); }
    }
};
template <int NB  > struct EpiRes {
    const bf16_t* rbf; bf16_t* xb; float* ssq;
    __device__ __forceinline__ void operator()(const AccT& acc, const pg8::Unit& u, int wr, int wc, int fr, int fq) const {
        const int row0 = u.pm * 256 + wr * 64 + fr, col0 = u.pn * 256 + wc * 32 + 8 * fq;
#pragma unroll
        for (int h = 0; h < NB; ++h) {
            u32x4 rb[2][4][2];
#pragma unroll
            for (int ai = (NB == 2 ? h : 0); ai < (NB == 2 ? h + 1 : 2); ++ai) EPI_M EPI_BJ rb[ai][m][bj] = *(const u32x4*)(rbf + (size_t)(row0 + ai * 128 + m * 16) * DM + col0 + bj * 128);
#pragma unroll
            for (int ai = (NB == 2 ? h : 0); ai < (NB == 2 ? h + 1 : 2); ++ai) EPI_M { const int row = row0 + ai * 128 + m * 16; float sq = 0.f;
                EPI_BJ { const size_t off = (size_t)row * DM + col0 + bj * 128; f32x4 r0, r1; unpack8(rb[ai][m][bj], r0, r1);
                    const f32x4 v0 = acc[ai][bj][m][0] + r0, v1 = acc[ai][bj][m][1] + r1;
                    *(u32x4*)(xb + off) = pack8(v0, v1);
                    const f32x4 q4 = v0 * v0 + v1 * v1; sq += (q4[0] + q4[1]) + (q4[2] + q4[3]); }
                sq += __shfl_xor(sq, 16); sq += __shfl_xor(sq, 32);
                if (fq == 0) unsafeAtomicAdd(ssq + row, sq); }
        }
    }
};
struct EpiUp {
    const float* ssq; bf16_t* O;
    __device__ __forceinline__ void operator()(const AccT& acc, const pg8::Unit& u, int wr, int wc, int fr, int fq) const {
        const int row0 = u.pm * 256 + wr * 64 + fr, col0 = u.pn * 256 + wc * 32 + 8 * fq;
        float sv[2][4];
        EPI_LOOP_ROWS sv[ai][m] = ssq[row0 + ai * 128 + m * 16];
        EPI_LOOP_ROWS { const int row = row0 + ai * 128 + m * 16; const float s = __builtin_amdgcn_rsqf(sv[ai][m] * (1.f / DM) + EPS);
            EPI_BJ { const f32x4 r0 = maxv(acc[ai][bj][m][0] * s, 0.f), r1 = maxv(acc[ai][bj][m][1] * s, 0.f);
                *(u32x4*)(O + (size_t)row * DFF + col0 + bj * 128) = pack8(r0 * r0, r1 * r1); } }
    }
};
struct EpiPlain {
    bf16_t* O;
    __device__ __forceinline__ void operator()(const AccT& acc, const pg8::Unit& u, int wr, int wc, int fr, int fq) const {
        const int row0 = u.pm * 256 + wr * 64 + fr, col0 = u.pn * 256 + wc * 32 + 8 * fq;
        EPI_LOOP_ROWS { const int row = row0 + ai * 128 + m * 16;
            EPI_BJ *(u32x4*)(O + (size_t)row * DM + col0 + bj * 128) = pack8(acc[ai][bj][m][0], acc[ai][bj][m][1]); }
    }
};
struct EpiFinal {
    const float* ssq; const bf16_t* Eb; const bf16_t* xin; float* out;
    __device__ __forceinline__ void operator()(const AccT& acc, const pg8::Unit& u, int wr, int wc, int fr, int fq) const {
        const int row0 = u.pm * 256 + wr * 64 + fr, col0 = u.pn * 256 + wc * 32 + 8 * fq;
        float sv[2][4];
        EPI_LOOP_ROWS sv[ai][m] = ssq[row0 + ai * 128 + m * 16];
        u32x4 xv[2][2][2], ev[2][2][2];
#pragma unroll
        for (int b = 0; b < 5; ++b) {
            if (b < 4) {
#pragma unroll
                for (int mm = 0; mm < 2; ++mm) EPI_BJ { const size_t off = (size_t)(row0 + (b >> 1) * 128 + (2 * (b & 1) + mm) * 16) * DM + col0 + bj * 128; xv[b & 1][mm][bj] = *(const u32x4*)(xin + off); ev[b & 1][mm][bj] = *(const u32x4*)(Eb + off); }
            }
            if (b >= 1) { const int c = b - 1, ai = c >> 1;
#pragma unroll
                for (int mm = 0; mm < 2; ++mm) { const int m = 2 * (c & 1) + mm; const float sc = __builtin_amdgcn_rsqf(sv[ai][m] * (1.f / DM) + EPS);
                    EPI_BJ { const size_t off = (size_t)(row0 + ai * 128 + m * 16) * DM + col0 + bj * 128; f32x4 e0, e1, v0, v1; unpack8(ev[c & 1][mm][bj], e0, e1); unpack8(xv[c & 1][mm][bj], v0, v1);
                        const float nsc = -1.44269504f * sc;
                        v0 += e0 * rcpv(exp2v(acc[ai][bj][m][0] * nsc) + 1.f); v1 += e1 * rcpv(exp2v(acc[ai][bj][m][1] * nsc) + 1.f);
                        __builtin_nontemporal_store(v0, (f32x4*)(out + off)); __builtin_nontemporal_store(v1, (f32x4*)(out + off + 4)); } }
            }
        }
    }
};

__device__ __forceinline__ float wave_sum(float v) {
#pragma unroll
    for (int o = 1; o < 64; o <<= 1) v += __shfl_xor(v, o);
    return v;
}
__device__ __forceinline__ void p0_transpose_item(const float* W, int K, int N, bf16_t* WT, const float* g, LAS float* scr, int item, int lane) {
    const int nblk = N / 32, kb = item / nblk, nb = item % nblk, k0 = 64 * kb, n0 = 32 * nb;
#pragma unroll
    for (int i = 0; i < 32; ++i) { const int kk = 2 * i + (lane >> 5); const float gv = g ? g[k0 + kk] : 1.f; scr[kk * 33 + (lane & 31)] = __builtin_nontemporal_load(W + (size_t)(k0 + kk) * N + n0 + (lane & 31)) * gv; }
    asm volatile("s_waitcnt lgkmcnt(0)" ::: "memory");
    const int c = lane & 7;
#pragma unroll
    for (int j = 0; j < 4; ++j) { const int n = (lane >> 3) + 8 * j; const LAS float* s = scr + (8 * c) * 33 + n;
        u32x4 o; o.x = cvt_pk_bf16(s[0 * 33], s[1 * 33]); o.y = cvt_pk_bf16(s[2 * 33], s[3 * 33]); o.z = cvt_pk_bf16(s[4 * 33], s[5 * 33]); o.w = cvt_pk_bf16(s[6 * 33], s[7 * 33]);
        *(u32x4*)(WT + (size_t)(n0 + n) * K + k0 + 8 * c) = o; }
    asm volatile("s_waitcnt lgkmcnt(0)" ::: "memory");
}

struct Args { const float* in[23]; float* out; unsigned char* ws; int ph_lo, ph_hi; };
enum { I_X = 0, I_P, I_GMIX, I_WIN, I_CONVW, I_CONVB, I_WRG, I_BRG, I_WIG, I_BIG, I_LAM, I_WRNN, I_QG, I_KG, I_SINK, I_WATT, I_WOUT, I_GMLP, I_WUP, I_WDN, I_GPLE, I_WGATE, I_WPLE };

__device__ __forceinline__ void convert_p(const Args& a, int G) {
    const int gt = blockIdx.x * 512 + threadIdx.x, NT = G * 512;
    const f32x4* p4 = (const f32x4*)a.in[I_P]; u32x2* pb = (u32x2*)(a.ws + WS_PB);
    for (int i = gt; i < M * PLE / 4; i += 4 * NT) { f32x4 v[4];
#pragma unroll
        for (int q = 0; q < 4; ++q) v[q] = (i + q * NT < M * PLE / 4) ? __builtin_nontemporal_load(p4 + i + q * NT) : (f32x4){0.f, 0.f, 0.f, 0.f};
#pragma unroll
        for (int q = 0; q < 4; ++q) if (i + q * NT < M * PLE / 4) { u32x2 w; w.x = cvt_pk_bf16(v[q].x, v[q].y); w.y = cvt_pk_bf16(v[q].z, v[q].w); __builtin_nontemporal_store(w, pb + i + q * NT); } }
}

enum { WJ_IN = 1, WJ_RNN = 2, WJ_ATT = 4, WJ_OUT = 8, WJ_UP = 16, WJ_DN = 32, WJ_GATE = 64, WJ_PLE = 128, WJ_RG = 256, WJ_IG = 512 };
template <unsigned MASK> __device__ __forceinline__ void convert_weights(const Args& a, LAS unsigned char* lds, int G) {
    const int tid = threadIdx.x, lane = tid & 63, wave = tid >> 6;
    unsigned char* ws = a.ws;
    LAS float* scr = (LAS float*)(lds + wave * 16384);
    const int gw = blockIdx.x * 8 + wave, NGW = G * 8;
    constexpr int N0 = (DM / 64) * (NIN / 32), N1 = (DM / 64) * (DM / 32), N5 = (DM / 64) * (DFF / 32), N6 = (DFF / 64) * (DM / 32), N8 = (PLE / 64) * (DM / 32), N9 = 32;
    constexpr int C_IN = (MASK & WJ_IN) ? N0 : 0, C_RNN = (MASK & WJ_RNN) ? N1 : 0, C_ATT = (MASK & WJ_ATT) ? N1 : 0, C_OUT = (MASK & WJ_OUT) ? N1 : 0, C_UP = (MASK & WJ_UP) ? N5 : 0,
                  C_DN = (MASK & WJ_DN) ? N6 : 0, C_GATE = (MASK & WJ_GATE) ? N1 : 0, C_PLE = (MASK & WJ_PLE) ? N8 : 0, C_RG = (MASK & WJ_RG) ? N9 : 0, C_IG = (MASK & WJ_IG) ? N9 : 0;
    constexpr int NITEMS = C_IN + C_RNN + C_ATT + C_OUT + C_UP + C_DN + C_GATE + C_PLE + C_RG + C_IG;
    for (int it = gw; it < NITEMS; it += NGW) {
        int r = it;
        if (r < C_IN) { p0_transpose_item(a.in[I_WIN], DM, NIN, (bf16_t*)(ws + WS_WIN), a.in[I_GMIX], scr, r, lane); continue; } r -= C_IN;
        if (r < C_RNN) { p0_transpose_item(a.in[I_WRNN], DM, DM, (bf16_t*)(ws + WS_WRNN), nullptr, scr, r, lane); continue; } r -= C_RNN;
        if (r < C_ATT) { p0_transpose_item(a.in[I_WATT], DM, DM, (bf16_t*)(ws + WS_WATT), nullptr, scr, r, lane); continue; } r -= C_ATT;
        if (r < C_OUT) { p0_transpose_item(a.in[I_WOUT], DM, DM, (bf16_t*)(ws + WS_WOUT), nullptr, scr, r, lane); continue; } r -= C_OUT;
        if (r < C_UP) { p0_transpose_item(a.in[I_WUP], DM, DFF, (bf16_t*)(ws + WS_WUP), a.in[I_GMLP], scr, r, lane); continue; } r -= C_UP;
        if (r < C_DN) { p0_transpose_item(a.in[I_WDN], DFF, DM, (bf16_t*)(ws + WS_WDN), nullptr, scr, r, lane); continue; } r -= C_DN;
        if (r < C_GATE) { p0_transpose_item(a.in[I_WGATE], DM, DM, (bf16_t*)(ws + WS_WGATE), a.in[I_GPLE], scr, r, lane); continue; } r -= C_GATE;
        if (r < C_PLE) { p0_transpose_item(a.in[I_WPLE], PLE, DM, (bf16_t*)(ws + WS_WPLE), nullptr, scr, r, lane); continue; } r -= C_PLE;
        if (r < C_RG) { p0_transpose_item(a.in[I_WRG] + (size_t)(r >> 1) * 4096, 64, 64, (bf16_t*)(ws + WS_WRG) + (size_t)(r >> 1) * 4096, nullptr, scr, r & 1, lane); continue; } r -= C_RG;
        if (r < C_IG) p0_transpose_item(a.in[I_WIG] + (size_t)(r >> 1) * 4096, 64, 64, (bf16_t*)(ws + WS_WIG) + (size_t)(r >> 1) * 4096, nullptr, scr, r & 1, lane);
    }
}

__device__ __forceinline__ void p0_prologue(const Args& a, LAS unsigned char* lds, int G) {
    const int tid = threadIdx.x, lane = tid & 63, wave = tid >> 6;
    unsigned char* ws = a.ws;
    const int gw = blockIdx.x * 8 + wave, NGW = G * 8;
    convert_weights<WJ_IN>(a, lds, G);
    const float* x = a.in[I_X]; bf16_t* XB = (bf16_t*)(ws + WS_XB); float* ssq0 = (float*)(ws + WS_SSQ0);
    for (int m4 = gw * 4; m4 < M; m4 += NGW * 4) {
        f32x4 v[4][4];
#pragma unroll
        for (int r = 0; r < 4; ++r) { const f32x4* xr = (const f32x4*)(x + (size_t)(m4 + r) * DM) + lane;
#pragma unroll
            for (int j = 0; j < 4; ++j) v[r][j] = __builtin_nontemporal_load(xr + 64 * j); }
#pragma unroll
        for (int r = 0; r < 4; ++r) { float s = 0.f;
#pragma unroll
            for (int j = 0; j < 4; ++j) s += (v[r][j].x * v[r][j].x + v[r][j].y * v[r][j].y) + (v[r][j].z * v[r][j].z + v[r][j].w * v[r][j].w);
            s = wave_sum(s); if (lane == 0) ssq0[m4 + r] = s;
            u32x2* o8 = (u32x2*)(XB + (size_t)(m4 + r) * DM) + lane;
#pragma unroll
            for (int j = 0; j < 4; ++j) { u32x2 w; w.x = cvt_pk_bf16(v[r][j].x, v[r][j].y); w.y = cvt_pk_bf16(v[r][j].z, v[r][j].w); o8[64 * j] = w; } }
    }
}
__device__ __forceinline__ void setup_misc(const Args& a, int G) {
    unsigned char* ws = a.ws;
    const int gt = blockIdx.x * 512 + threadIdx.x, NT = G * 512;
    { float* s1 = (float*)(ws + WS_SSQ1); float* s2 = (float*)(ws + WS_SSQ2); for (int i = gt; i < M; i += NT) { s1[i] = 0.f; s2[i] = 0.f; } }
    { float* ct = (float*)(ws + WS_COS); float* st = (float*)(ws + WS_SIN);
      for (int i = gt; i < SEQ * 32; i += NT) { const int pos = i >> 5, k = i & 31; const float inv = exp2f(-(float)k * 0.41524101186092029f); const float ang = (float)pos * inv; ct[i] = cosf(ang); st[i] = sinf(ang); } }
}

constexpr int R_XS = 0, R_GS = 18432, R_XCB = 36864, R_WR = 46080, R_WI = 55296, R_AF = 64512, R_BI = 81920, R_SEGP = 99328, R_SEGH = 101376, R_CARRY = 103424, R_OUTB = 104448;
constexpr int RP = 144;
constexpr int FP = 68;
__device__ __forceinline__ void rnn_item(LAS unsigned char* lds, int item, const Args& a, bf16_t* yo, int ldy) {
    const int tid = threadIdx.x, lane = tid & 63, w = __builtin_amdgcn_readfirstlane(tid >> 6);
    const int b = item >> 4, blk = item & 15, c0 = blk * 64;
    bf16_t* zrg = (bf16_t*)(a.ws + WS_ZRG);
    const int c = lane, seg = w;
    const int lrow = tid >> 3, lpiece = tid & 7;
    { const bf16_t* wr = (const bf16_t*)(a.ws + WS_WRG) + blk * 4096; const bf16_t* wi = (const bf16_t*)(a.ws + WS_WIG) + blk * 4096;
      *(LAS u32x4*)(lds + R_WR + lrow * RP + lpiece * 16) = *(const u32x4*)(wr + lrow * 64 + lpiece * 8);
      *(LAS u32x4*)(lds + R_WI + lrow * RP + lpiece * 16) = *(const u32x4*)(wi + lrow * 64 + lpiece * 8); }
    const int ch = c0 + c;
    const float cw0 = a.in[I_CONVW][ch], cw1 = a.in[I_CONVW][1024 + ch], cw2 = a.in[I_CONVW][2048 + ch], cw3 = a.in[I_CONVW][3072 + ch], cb = a.in[I_CONVB][ch];
    float ebr[2], ebi[2], ec8[2];
#pragma unroll
    for (int q = 0; q < 2; ++q) { const int che = c0 + 16 * (2 * (w & 1) + q) + (lane & 15); ebr[q] = -1.44269504f * a.in[I_BRG][che]; ebi[q] = -1.44269504f * a.in[I_BIG][che]; ec8[q] = 1.44269504f * 8.f * log1pf(expf(-a.in[I_LAM][che])); }
    const size_t rowbase = (size_t)b * SEQ;
    const bf16_t* gx = zrg + (rowbase + lrow) * LDZ_RG + c0 + lpiece * 8;
    u32x4 xpre[2], gpre[2];
    xpre[0] = *(const u32x4*)gx; gpre[0] = *(const u32x4*)(gx + 1024);
    { const bf16_t* g1 = gx + (size_t)64 * LDZ_RG; xpre[1] = *(const u32x4*)g1; gpre[1] = *(const u32x4*)(g1 + 1024); }
    const int mt = w >> 1;
    *(LAS u32x4*)(lds + R_XS + lrow * RP + lpiece * 16) = xpre[0]; *(LAS u32x4*)(lds + R_GS + lrow * RP + lpiece * 16) = gpre[0];
    { const bf16_t* gn = gx + (size_t)2 * 64 * LDZ_RG; xpre[0] = *(const u32x4*)gn; gpre[0] = *(const u32x4*)(gn + 1024); }
    __syncthreads();
    bf16x8 wfr[2][2], wfi[2][2];
#pragma unroll
    for (int q = 0; q < 2; ++q)
#pragma unroll
        for (int ks = 0; ks < 2; ++ks) { const int boff = (16 * (2 * (w & 1) + q) + (lane & 15)) * RP + ks * 64 + (lane >> 4) * 16;
            wfr[q][ks] = *(const LAS bf16x8*)(lds + R_WR + boff); wfi[q][ks] = *(const LAS bf16x8*)(lds + R_WI + boff); }
#pragma unroll 2
    for (int ci = 0; ci < SEQ / 64; ++ci) {
        const int cur = ci & 1;
        LAS unsigned char* XS = lds + R_XS + cur * 9216; LAS unsigned char* XSP = lds + R_XS + (cur ^ 1) * 9216; LAS unsigned char* GS = lds + R_GS + cur * 9216;
        float xv[11];
#pragma unroll
        for (int k = 0; k < 11; ++k) { const int rr = seg * 8 - 3 + k;
            if (rr >= 0) xv[k] = __uint_as_float((unsigned)*(const LAS unsigned short*)(XS + rr * RP + c * 2) << 16);
            else xv[k] = (ci > 0) ? __uint_as_float((unsigned)*(const LAS unsigned short*)(XSP + (64 + rr) * RP + c * 2) << 16) : 0.f; }
        float xc[8];
#pragma unroll
        for (int j = 0; j < 8; ++j) { xc[j] = (((cb + xv[j] * cw0) + xv[j + 1] * cw1) + xv[j + 2] * cw2) + xv[j + 3] * cw3;
            *(LAS unsigned short*)(lds + R_XCB + (seg * 8 + j) * RP + c * 2) = (unsigned short)(cvt_pk_bf16(xc[j], 0.f) & 0xffffu); }
        __syncthreads();
        {
            bf16x8 af[2];
#pragma unroll
            for (int ks = 0; ks < 2; ++ks) af[ks] = *(const LAS bf16x8*)(lds + R_XCB + (16 * mt + (lane & 15)) * RP + ks * 64 + (lane >> 4) * 16);
#pragma unroll
            for (int q = 0; q < 2; ++q) { const int nt = 2 * (w & 1) + q;
                f32x4 ar = (f32x4){0.f, 0.f, 0.f, 0.f}, ai = (f32x4){0.f, 0.f, 0.f, 0.f};
#pragma unroll
                for (int ks = 0; ks < 2; ++ks) {
                    ar = __builtin_amdgcn_mfma_f32_16x16x32_bf16(af[ks], wfr[q][ks], ar, 0, 0, 0);
                    ai = __builtin_amdgcn_mfma_f32_16x16x32_bf16(af[ks], wfi[q][ks], ai, 0, 0, 0); }
#pragma unroll
                for (int e = 0; e < 4; e += 2) { const int t = 16 * mt + 4 * (lane >> 4) + e, cc = 16 * nt + (lane & 15);
                    typedef float f32x2 __attribute__((ext_vector_type(2)));
                    const f32x2 tr = (f32x2){ar[e], ar[e + 1]} * -1.44269504f + ebr[q], ti = (f32x2){ai[e], ai[e + 1]} * -1.44269504f + ebi[q];
                    const f32x2 dr = (f32x2){__builtin_amdgcn_exp2f(tr.x), __builtin_amdgcn_exp2f(tr.y)} + 1.f, di = (f32x2){__builtin_amdgcn_exp2f(ti.x), __builtin_amdgcn_exp2f(ti.y)} + 1.f;
                    const f32x2 r = {__builtin_amdgcn_rcpf(dr.x), __builtin_amdgcn_rcpf(dr.y)}, ig = {__builtin_amdgcn_rcpf(di.x), __builtin_amdgcn_rcpf(di.y)};
                    const f32x2 la2 = r * -ec8[q];
                    const f32x2 av = {__builtin_amdgcn_exp2f(la2.x), __builtin_amdgcn_exp2f(la2.y)};
                    const f32x2 m2 = 1.f - av * av;
                    const f32x2 bi = (f32x2){__builtin_amdgcn_sqrtf(m2.x), __builtin_amdgcn_sqrtf(m2.y)} * ig;
                    ((LAS float*)(lds + R_AF))[t * FP + cc] = av.x; ((LAS float*)(lds + R_AF))[(t + 1) * FP + cc] = av.y;
                    ((LAS float*)(lds + R_BI))[t * FP + cc] = bi.x; ((LAS float*)(lds + R_BI))[(t + 1) * FP + cc] = bi.y; } }
        }
        __syncthreads();
        float av[8], bv[8]; float P = 1.f, h = 0.f;
#pragma unroll
        for (int j = 0; j < 8; ++j) { av[j] = ((const LAS float*)(lds + R_AF))[(seg * 8 + j) * FP + c]; bv[j] = ((const LAS float*)(lds + R_BI))[(seg * 8 + j) * FP + c] * xc[j]; h = av[j] * h + bv[j]; P *= av[j]; }
        ((LAS float*)(lds + R_SEGP))[seg * 64 + c] = P; ((LAS float*)(lds + R_SEGH))[seg * 64 + c] = h;
        __syncthreads();
        float hin = (ci > 0) ? ((const LAS float*)(lds + R_CARRY))[cur * 64 + c] : 0.f;
        {
            float sp[7], sh[7];
#pragma unroll
            for (int s = 0; s < 7; ++s) { sp[s] = ((const LAS float*)(lds + R_SEGP))[s * 64 + c]; sh[s] = ((const LAS float*)(lds + R_SEGH))[s * 64 + c]; }
#pragma unroll
            for (int s = 0; s < 7; ++s) if (s < seg) hin = sp[s] * hin + sh[s];
        }
        h = hin;
        float hv[8];
#pragma unroll
        for (int j = 0; j < 8; ++j) { h = av[j] * h + bv[j]; hv[j] = h; }
#pragma unroll
        for (int j = 0; j < 8; j += 2) { typedef float f32x2 __attribute__((ext_vector_type(2)));
            const f32x2 gg = {__uint_as_float((unsigned)*(const LAS unsigned short*)(GS + (seg * 8 + j) * RP + c * 2) << 16), __uint_as_float((unsigned)*(const LAS unsigned short*)(GS + (seg * 8 + j + 1) * RP + c * 2) << 16)};
            const f32x2 wq = gg * (gg * gg * -0.10294324f + -2.3022082f);
            const f32x2 dn = (f32x2){__builtin_amdgcn_exp2f(wq.x), __builtin_amdgcn_exp2f(wq.y)} + 1.f;
            const f32x2 y = (f32x2){hv[j], hv[j + 1]} * gg * (f32x2){__builtin_amdgcn_rcpf(dn.x), __builtin_amdgcn_rcpf(dn.y)};
            *(LAS unsigned short*)(lds + R_OUTB + (seg * 8 + j) * RP + c * 2) = (unsigned short)(cvt_pk_bf16(y.x, 0.f) & 0xffffu);
            *(LAS unsigned short*)(lds + R_OUTB + (seg * 8 + j + 1) * RP + c * 2) = (unsigned short)(cvt_pk_bf16(y.y, 0.f) & 0xffffu); }
        if (seg == 7) ((LAS float*)(lds + R_CARRY))[(cur ^ 1) * 64 + c] = h;
        if (ci + 1 < SEQ / 64) {
            *(LAS u32x4*)(lds + R_XS + (cur ^ 1) * 9216 + lrow * RP + lpiece * 16) = xpre[(ci + 1) & 1]; *(LAS u32x4*)(lds + R_GS + (cur ^ 1) * 9216 + lrow * RP + lpiece * 16) = gpre[(ci + 1) & 1];
            if (ci + 3 < SEQ / 64) { const bf16_t* gn = gx + (size_t)(ci + 3) * 64 * LDZ_RG; xpre[(ci + 1) & 1] = *(const u32x4*)gn; gpre[(ci + 1) & 1] = *(const u32x4*)(gn + 1024); } }
        __syncthreads();
        *(u32x4*)(yo + (rowbase + (size_t)ci * 64 + lrow) * ldy + c0 + lpiece * 8) = *(const LAS u32x4*)(lds + R_OUTB + lrow * RP + lpiece * 16);
    }
    __syncthreads();
}

constexpr int A_K = 0, A_V = 36864, KP = 144, VP = 520;
__device__ __forceinline__ void attn_kv_load(int item, const bf16_t* zq, int tid, u32x4 (&kr)[4], u32x2 (&vr)[8]) {
    const int b = item >> 6, n = (item >> 2) & 15, kvh = item & 3;
    const int key = tid >> 1, half = tid & 1; const int pos = (n - 1) * 128 + key;
    if (pos >= 0) {
        const bf16_t* kp = zq + (size_t)(b * SEQ + pos) * LDZ_QKV + 1024 + kvh * 64 + 16 * half;
        kr[0] = *(const u32x4*)kp; kr[1] = *(const u32x4*)(kp + 8); kr[2] = *(const u32x4*)(kp + 32); kr[3] = *(const u32x4*)(kp + 40);
    } else {
        const u32x4 z = (u32x4){0u, 0u, 0u, 0u};
#pragma unroll
        for (int i = 0; i < 4; ++i) kr[i] = z;
    }
    const int kp2 = tid >> 2, dq = tid & 3; const int vpos = (n - 1) * 128 + 2 * kp2;
    if (vpos >= 0) {
        const bf16_t* vp = zq + (size_t)(b * SEQ + vpos) * LDZ_QKV + 1280 + kvh * 64 + 4 * dq;
#pragma unroll
        for (int g = 0; g < 4; ++g) { vr[2 * g] = *(const u32x2*)(vp + 16 * g); vr[2 * g + 1] = *(const u32x2*)(vp + LDZ_QKV + 16 * g); }
    } else {
#pragma unroll
        for (int i = 0; i < 8; ++i) vr[i] = (u32x2){0u, 0u};
    }
}
__device__ __forceinline__ void attn_phase(LAS unsigned char* lds, const Args& a, bf16_t* oo, int ldo, int first, int step) {
    const int tid = threadIdx.x, lane = tid & 63, w = __builtin_amdgcn_readfirstlane(tid >> 6);
    const bf16_t* zq = (const bf16_t*)(a.ws + WS_ZQKV);
    const float* cosT = (const float*)(a.ws + WS_COS); const float* sinT = (const float*)(a.ws + WS_SIN);
    const int g = w >> 1, r = lane & 31, hh = lane >> 5;
    const float C2 = 0.125f * 1.44269504f;
    int item = first; if (item >= 1024) return;
    u32x4 kr[4]; u32x2 vr[8];
    attn_kv_load(item, zq, tid, kr, vr);
    for (; item < 1024; item += step) {
        const int b = item >> 6, n = (item >> 2) & 15, kvh = item & 3, head = kvh * 4 + g;
        u32x4 qr[2][4];
#pragma unroll
        for (int qt = 0; qt < 2; ++qt) { const bf16_t* qp = zq + (size_t)(b * SEQ + n * 128 + (w & 1) * 64 + qt * 32 + r) * LDZ_QKV + head * 64;
#pragma unroll
            for (int ks = 0; ks < 4; ++ks) qr[qt][ks] = *(const u32x4*)(qp + 16 * ks + 8 * hh); }
        {
            const int key = tid >> 1, half = tid & 1; const int pos = (n - 1) * 128 + key; const int posc = pos >= 0 ? pos : 0;
            float t1[16], t2[16];
            { f32x4 p, q; unpack8(kr[0], p, q); t1[0] = p[0]; t1[1] = p[1]; t1[2] = p[2]; t1[3] = p[3]; t1[4] = q[0]; t1[5] = q[1]; t1[6] = q[2]; t1[7] = q[3];
              unpack8(kr[1], p, q); t1[8] = p[0]; t1[9] = p[1]; t1[10] = p[2]; t1[11] = p[3]; t1[12] = q[0]; t1[13] = q[1]; t1[14] = q[2]; t1[15] = q[3];
              unpack8(kr[2], p, q); t2[0] = p[0]; t2[1] = p[1]; t2[2] = p[2]; t2[3] = p[3]; t2[4] = q[0]; t2[5] = q[1]; t2[6] = q[2]; t2[7] = q[3];
              unpack8(kr[3], p, q); t2[8] = p[0]; t2[9] = p[1]; t2[10] = p[2]; t2[11] = p[3]; t2[12] = q[0]; t2[13] = q[1]; t2[14] = q[2]; t2[15] = q[3]; }
            float ss = 0.f;
#pragma unroll
            for (int i = 0; i < 16; ++i) ss += t1[i] * t1[i] + t2[i] * t2[i];
            ss += __shfl_xor(ss, 1);
            const float rinv = __builtin_amdgcn_rsqf(ss * (1.f / 64.f) + EPS);
            const float* kg = a.in[I_KG] + 16 * half; const float* cp = cosT + posc * 32 + 16 * half; const float* sp = sinT + posc * 32 + 16 * half;
            float o1[16], o2[16];
#pragma unroll
            for (int i = 0; i < 16; ++i) { const float y1 = t1[i] * rinv * kg[i], y2 = t2[i] * rinv * kg[32 + i], cc = cp[i], sn = sp[i]; o1[i] = y1 * cc - y2 * sn; o2[i] = y2 * cc + y1 * sn; }
            LAS unsigned char* kd = lds + A_K + key * KP + 32 * half;
            *(LAS u32x4*)(kd) = pack8((f32x4){o1[0], o1[1], o1[2], o1[3]}, (f32x4){o1[4], o1[5], o1[6], o1[7]});
            *(LAS u32x4*)(kd + 16) = pack8((f32x4){o1[8], o1[9], o1[10], o1[11]}, (f32x4){o1[12], o1[13], o1[14], o1[15]});
            *(LAS u32x4*)(kd + 64) = pack8((f32x4){o2[0], o2[1], o2[2], o2[3]}, (f32x4){o2[4], o2[5], o2[6], o2[7]});
            *(LAS u32x4*)(kd + 80) = pack8((f32x4){o2[8], o2[9], o2[10], o2[11]}, (f32x4){o2[12], o2[13], o2[14], o2[15]});
            const int kp2 = tid >> 2, dq = tid & 3;
            LAS unsigned char* vd = lds + A_V + (4 * dq) * VP + kp2 * 4;
#pragma unroll
            for (int g = 0; g < 4; ++g) { const unsigned a0 = vr[2 * g].x, a1 = vr[2 * g].y, b0 = vr[2 * g + 1].x, b1 = vr[2 * g + 1].y;
                *(LAS unsigned*)(vd + (16 * g + 0) * VP) = (a0 & 0xffffu) | (b0 << 16);
                *(LAS unsigned*)(vd + (16 * g + 1) * VP) = (a0 >> 16) | (b0 & 0xffff0000u);
                *(LAS unsigned*)(vd + (16 * g + 2) * VP) = (a1 & 0xffffu) | (b1 << 16);
                *(LAS unsigned*)(vd + (16 * g + 3) * VP) = (a1 >> 16) | (b1 & 0xffff0000u); }
        }
        __syncthreads();
        if (item + step < 1024) attn_kv_load(item + step, zq, tid, kr, vr);
        const float sink2 = a.in[I_SINK][head] * 1.44269504f;
#pragma unroll
        for (int qt = 0; qt < 2; ++qt) {
            const int m0 = (w & 1) * 64 + qt * 32, i0 = m0 >> 5, q = m0 + r; const int pos = n * 128 + q;
            bf16_t* op = oo + (size_t)(b * SEQ + pos) * ldo + head * 64;
            float v[4][8];
#pragma unroll
            for (int ks = 0; ks < 4; ++ks) { f32x4 p0, p1; unpack8(qr[qt][ks], p0, p1);
                v[ks][0] = p0[0]; v[ks][1] = p0[1]; v[ks][2] = p0[2]; v[ks][3] = p0[3]; v[ks][4] = p1[0]; v[ks][5] = p1[1]; v[ks][6] = p1[2]; v[ks][7] = p1[3]; }
            float ss = 0.f;
#pragma unroll
            for (int ks = 0; ks < 4; ++ks)
#pragma unroll
                for (int j = 0; j < 8; ++j) ss += v[ks][j] * v[ks][j];
            ss += __shfl_xor(ss, 32);
            const float rinv = __builtin_amdgcn_rsqf(ss * (1.f / 64.f) + EPS) * C2;
            bf16x8 qf[4];
#pragma unroll
            for (int ks = 0; ks < 2; ++ks) { const int dl = 16 * ks + 8 * hh; float o1[8], o2[8];
#pragma unroll
                for (int j = 0; j < 8; ++j) { const float y1 = v[ks][j] * rinv * a.in[I_QG][dl + j], y2 = v[ks + 2][j] * rinv * a.in[I_QG][32 + dl + j], cc = cosT[pos * 32 + dl + j], sn = sinT[pos * 32 + dl + j];
                    o1[j] = y1 * cc - y2 * sn; o2[j] = y2 * cc + y1 * sn; }
                u32x4 w1 = pack8((f32x4){o1[0], o1[1], o1[2], o1[3]}, (f32x4){o1[4], o1[5], o1[6], o1[7]}), w2 = pack8((f32x4){o2[0], o2[1], o2[2], o2[3]}, (f32x4){o2[4], o2[5], o2[6], o2[7]});
                qf[ks] = __builtin_bit_cast(bf16x8, w1); qf[ks + 2] = __builtin_bit_cast(bf16x8, w2); }
            f32x16 sacc[5];
#pragma unroll
            for (int t = 0; t < 5; ++t) { const int kt = i0 + t;
                const f32x16 zero16 = {0.f, 0.f, 0.f, 0.f, 0.f, 0.f, 0.f, 0.f, 0.f, 0.f, 0.f, 0.f, 0.f, 0.f, 0.f, 0.f};
#pragma unroll
                for (int ks = 0; ks < 4; ++ks) sacc[t] = __builtin_amdgcn_mfma_f32_32x32x16_bf16(*(const LAS bf16x8*)(lds + A_K + (32 * kt + r) * KP + ks * 32 + hh * 16), qf[ks], ks == 0 ? zero16 : sacc[t], 0, 0, 0); }
            const float NEG = -INFINITY;
#pragma unroll
            for (int e = 0; e < 16; ++e) { const int kr_ = (e & 3) + 8 * (e >> 2) + 4 * hh;
                if (!(kr_ > r)) sacc[0][e] = NEG;
                if (!(kr_ <= r)) sacc[4][e] = NEG; }
            if (n == 0) {
#pragma unroll
                for (int t = 0; t < 4; ++t) if (i0 + t < 4) {
#pragma unroll
                    for (int e = 0; e < 16; ++e) sacc[t][e] = NEG; } }
            float mx = NEG;
#pragma unroll
            for (int t = 0; t < 5; ++t)
#pragma unroll
                for (int e = 0; e < 16; ++e) mx = fmaxf(mx, sacc[t][e]);
            mx = fmaxf(mx, __shfl_xor(mx, 32));
            mx = fmaxf(mx, sink2);
            typedef float f32x2v __attribute__((ext_vector_type(2)));
            f32x2v sum2 = {0.f, 0.f};
#pragma unroll
            for (int t = 0; t < 5; ++t)
#pragma unroll
                for (int e = 0; e < 16; e += 2) { const float p0 = __builtin_amdgcn_exp2f(sacc[t][e] - mx), p1 = __builtin_amdgcn_exp2f(sacc[t][e + 1] - mx); sacc[t][e] = p0; sacc[t][e + 1] = p1; sum2 += (f32x2v){p0, p1}; }
            float sum = sum2.x + sum2.y;
            sum += __shfl_xor(sum, 32);
            const float rden = 1.f / (sum + __builtin_amdgcn_exp2f(sink2 - mx));
            f32x16 oacc[2];
#pragma unroll
            for (int t = 0; t < 5; ++t) { const int kt = i0 + t;
#pragma unroll
                for (int s2 = 0; s2 < 2; ++s2) {
                    u32x4 pw; pw.x = cvt_pk_bf16(sacc[t][8 * s2 + 0], sacc[t][8 * s2 + 1]); pw.y = cvt_pk_bf16(sacc[t][8 * s2 + 2], sacc[t][8 * s2 + 3]); pw.z = cvt_pk_bf16(sacc[t][8 * s2 + 4], sacc[t][8 * s2 + 5]); pw.w = cvt_pk_bf16(sacc[t][8 * s2 + 6], sacc[t][8 * s2 + 7]);
                    const bf16x8 pf = __builtin_bit_cast(bf16x8, pw);
#pragma unroll
                    for (int dt = 0; dt < 2; ++dt) { const LAS unsigned char* vb = lds + A_V + (32 * dt + r) * VP + (32 * kt + 16 * s2 + 4 * hh) * 2;
                        const s16x4 lo = *(const LAS s16x4*)vb, hi = *(const LAS s16x4*)(vb + 16);
                        const bf16x8 vf = __builtin_shufflevector(lo, hi, 0, 1, 2, 3, 4, 5, 6, 7);
                        const f32x16 zero16 = {0.f, 0.f, 0.f, 0.f, 0.f, 0.f, 0.f, 0.f, 0.f, 0.f, 0.f, 0.f, 0.f, 0.f, 0.f, 0.f};
                        oacc[dt] = __builtin_amdgcn_mfma_f32_32x32x16_bf16(vf, pf, (t == 0 && s2 == 0) ? zero16 : oacc[dt], 0, 0, 0); } } }
#pragma unroll
            for (int dt = 0; dt < 2; ++dt)
#pragma unroll
                for (int gq = 0; gq < 4; ++gq) { u32x2 ow; ow.x = cvt_pk_bf16(oacc[dt][4 * gq + 0] * rden, oacc[dt][4 * gq + 1] * rden); ow.y = cvt_pk_bf16(oacc[dt][4 * gq + 2] * rden, oacc[dt][4 * gq + 3] * rden);
                    *(u32x2*)(op + 32 * dt + 8 * gq + 4 * hh) = ow; }
        }
        __syncthreads();
    }
}

#define XB_TMO      128
#define XB_XCNT(j)  (256  + 64 * (j))
#define XB_XSUB(j)  (1280 + 64 * (j))
#define XB_XGEN(j)  (2304 + 64 * (j))
#define XB_TOP      3328
#define XB_TOPGEN   3392
#define XCD_BAR_WORDS 3456
#define XB_SPIN_CAP (1u << 18)
__device__ __forceinline__ unsigned xb_ld(unsigned* p)              { return __hip_atomic_load(p, __ATOMIC_RELAXED, __HIP_MEMORY_SCOPE_AGENT); }
__device__ __forceinline__ unsigned xb_add(unsigned* p, unsigned v) { return __hip_atomic_fetch_add(p, v, __ATOMIC_RELAXED, __HIP_MEMORY_SCOPE_AGENT); }
__device__ __forceinline__ unsigned xb_xcc_id() { return (unsigned)__builtin_amdgcn_s_getreg((3 << 11) | 20) & 0xFu; }
#define XB_SPIN(cond, bar) do { unsigned _sp = 0; while (cond) { __builtin_amdgcn_s_sleep(1); \
    if ((++_sp & 255u) == 0u) { if (xb_ld(&(bar)[XB_TMO])) break; if (_sp > XB_SPIN_CAP) { atomicAdd(&(bar)[XB_TMO], 1u); break; } } } } while (0)
struct XcdBarrier { unsigned* bar; unsigned x; volatile LAS unsigned* st; };
__device__ __forceinline__ XcdBarrier xcd_barrier_post(unsigned* bar, volatile LAS unsigned* st) {
    XcdBarrier b; b.bar = bar; b.x = xb_xcc_id(); b.st = st;
    if (threadIdx.x == 0) (void)xb_add(&bar[XB_XCNT(b.x)], 1u);
    return b;
}
__device__ __forceinline__ void xcd_barrier_complete(unsigned* bar, unsigned x, unsigned& nloc, unsigned& nx) {
    const unsigned G = gridDim.x * gridDim.y * gridDim.z;
    unsigned sum, cnt, mine, sp = 0u;
    for (;;) {
        sum = 0u; cnt = 0u; mine = 0u;
#pragma unroll
        for (unsigned j = 0; j < 16; ++j) { const unsigned c = xb_ld(&bar[XB_XCNT(j)]); sum += c; cnt += (c > 0u) ? 1u : 0u; mine = (j == x) ? c : mine; }
        if (sum == G) break;
        __builtin_amdgcn_s_sleep(1);
        if ((++sp & 255u) == 0u) { if (xb_ld(&bar[XB_TMO])) break; if (sp > XB_SPIN_CAP) { atomicAdd(&bar[XB_TMO], 1u); break; } }
    }
    nloc = mine > 0u ? mine : 1u; nx = cnt > 0u ? cnt : 1u;
}
__device__ __forceinline__ void xcd_barrier(const XcdBarrier& b) {
    asm volatile("s_waitcnt vmcnt(0)" ::: "memory");
    __syncthreads();
    if (threadIdx.x == 0) {
        unsigned* bar = b.bar;
        __builtin_amdgcn_s_waitcnt(0);
        unsigned nloc = b.st[0], nx = b.st[1]; const unsigned xg = b.st[3];
        if (nloc == 0u) { xcd_barrier_complete(bar, b.x, nloc, nx); b.st[0] = nloc; b.st[1] = nx; }
        const unsigned old = xb_add(&bar[XB_XSUB(b.x)], 1u);
        const unsigned gen = old / nloc;
        if (old + 1u == (gen + 1u) * nloc) {
            __builtin_amdgcn_fence(__ATOMIC_RELEASE, "agent");
            asm volatile("s_waitcnt vmcnt(0)" ::: "memory");
            const unsigned og = xb_add(&bar[XB_TOP], 1u);
            const unsigned tg = og / nx;
            if (og + 1u == (tg + 1u) * nx) xb_add(&bar[XB_TOPGEN], 1u);
            else XB_SPIN(xb_ld(&bar[XB_TOPGEN]) == tg, bar);
            __builtin_amdgcn_fence(__ATOMIC_ACQUIRE, "agent");
            xb_add(&bar[XB_XGEN(b.x)], 1u);
            asm volatile("s_waitcnt vmcnt(0)" ::: "memory");
        } else {
            XB_SPIN(xb_ld(&bar[XB_XGEN(b.x)]) == xg, bar);
            __builtin_amdgcn_fence(__ATOMIC_ACQUIRE, "agent");
            asm volatile("s_waitcnt vmcnt(0)" ::: "memory");
        }
        b.st[3] = xg + 1u;
    }
    __syncthreads();
}
__device__ __forceinline__ void xcd_arrive(const XcdBarrier& b) {
    asm volatile("s_waitcnt vmcnt(0)" ::: "memory");
    __syncthreads();
    if (threadIdx.x == 0) {
        unsigned* bar = b.bar;
        __builtin_amdgcn_s_waitcnt(0);
        unsigned nloc = b.st[0], nx = b.st[1];
        if (nloc == 0u) { xcd_barrier_complete(bar, b.x, nloc, nx); b.st[0] = nloc; b.st[1] = nx; }
        const unsigned old = xb_add(&bar[XB_XSUB(b.x)], 1u);
        const unsigned gen = old / nloc;
        b.st[2] = gen;
        if (old + 1u == (gen + 1u) * nloc) {
            __builtin_amdgcn_fence(__ATOMIC_RELEASE, "agent");
            asm volatile("s_waitcnt vmcnt(0)" ::: "memory");
            const unsigned og = xb_add(&bar[XB_TOP], 1u);
            const unsigned tg = og / nx;
            if (og + 1u == (tg + 1u) * nx) xb_add(&bar[XB_TOPGEN], 1u);
        }
    }
}
__device__ __forceinline__ void xcd_wait(const XcdBarrier& b) {
    __syncthreads();
    if (threadIdx.x == 0) {
        unsigned* bar = b.bar;
        const unsigned gen = b.st[2];
        XB_SPIN(xb_ld(&bar[XB_TOPGEN]) == gen, bar);
        __builtin_amdgcn_fence(__ATOMIC_ACQUIRE, "agent");
        asm volatile("s_waitcnt vmcnt(0)" ::: "memory");
    }
    __syncthreads();
}

__global__ void __launch_bounds__(512) fwd_megakernel(Args a) {
    extern __shared__ __attribute__((aligned(16))) unsigned char lds_raw[];
    LAS unsigned char* lds = (LAS unsigned char*)lds_raw;
    cg::grid_group grid = cg::this_grid();
    const int G = gridDim.x, lo = a.ph_lo, hi = a.ph_hi;
    unsigned char* ws = a.ws;
    float* ssq0 = (float*)(ws + WS_SSQ0); float* ssq1 = (float*)(ws + WS_SSQ1); float* ssq2 = (float*)(ws + WS_SSQ2);
    bf16_t* XB = (bf16_t*)(ws + WS_XB); bf16_t* PB = (bf16_t*)(ws + WS_PB); bf16_t* ZRG = (bf16_t*)(ws + WS_ZRG); bf16_t* ZQKV = (bf16_t*)(ws + WS_ZQKV); bf16_t* ZG = (bf16_t*)(ws + WS_ZG);
    bf16_t* U = (bf16_t*)(ws + WS_U);
#define IN(k) (lo <= (k) && (k) < hi)
#define SEAM(k) do { if (IN(k) && IN((k) + 1)) xcd_barrier(bar); } while (0)
#define SEAM_FILL(k, filler) do { if (IN(k) && IN((k) + 1)) xcd_arrive(bar); if (IN(k)) { filler; } if (IN(k) && IN((k) + 1)) xcd_wait(bar); } while (0)
    volatile LAS unsigned* MISC = (volatile LAS unsigned*)(lds + 131072);
    if (threadIdx.x < 32) MISC[threadIdx.x] = 0u;
    __syncthreads();
    XcdBarrier bar; bar.bar = (unsigned*)(ws + WS_BAR); bar.x = 0; bar.st = MISC + 8;
    if (hi - lo > 1) bar = xcd_barrier_post((unsigned*)(ws + WS_BAR), MISC + 8);
    if (hi > 1000) grid.sync();
    if (IN(0)) {
#pragma nounroll
        for (int rep = 0; rep < (PROBE_MODE == 4 ? 2 : 1); ++rep) { p0_prologue(a, lds, G); __syncthreads(); }
    }
#if PROBE_MODE == 7
    for (int i = 0; i < 8; ++i) grid.sync();
#endif
    SEAM_FILL(0, (convert_weights<WJ_RNN | WJ_ATT | WJ_OUT | WJ_RG | WJ_IG | WJ_PLE>(a, lds, G), setup_misc(a, G)));
    if (IN(1)) { pg8::Gemm g{XB, (const bf16_t*)(ws + WS_WIN), M, NIN, DM, DM, DM, nullptr, nullptr, 0}; pg8::StaticOrder S; S.init(M, NIN, G, (int)blockIdx.x);
        EpiIn E{ZRG, ZQKV, ZG, ssq0}; pg8::gemm_phase(lds, g, S, E);
#if PROBE_MODE == 3
        pg8::gemm_phase(lds, g, S, E);
#endif
    }
    SEAM_FILL(1, convert_p(a, G));
    if (IN(2)) {
        attn_phase(lds, a, ZQKV, LDZ_QKV, (int)blockIdx.x, G);
        for (int it = blockIdx.x; it < 256; it += G) rnn_item(lds, it, a, ZRG + 1024, LDZ_RG);
#if PROBE_MODE == 1
        for (int it = blockIdx.x; it < 256; it += G) rnn_item(lds, it, a, XB, DM);
#elif PROBE_MODE == 2
        attn_phase(lds, a, XB, DM, (int)blockIdx.x, G);
#endif
    }
    SEAM_FILL(2, (convert_weights<WJ_UP>(a, lds, G)));
    bf16_t* XC = (bf16_t*)(ws + WS_XC);
    if (IN(3)) { pg8::Gemm g{ZRG + 1024, (const bf16_t*)(ws + WS_WRNN), M, DM, DM, LDZ_RG, DM, ZQKV, (const bf16_t*)(ws + WS_WATT), LDZ_QKV}; pg8::StaticOrder S; S.init(M, DM, G, (int)blockIdx.x);
        EpiMerge E{ZG, ZG + 1024, LDZ_G, ZRG, LDZ_RG}; pg8::gemm_phase<EpiMerge, true>(lds, g, S, E); }
    SEAM_FILL(3, (convert_weights<WJ_DN>(a, lds, G)));
    if (IN(5)) { pg8::Gemm g{ZRG, (const bf16_t*)(ws + WS_WOUT), M, DM, DM, LDZ_RG, DM, nullptr, nullptr, 0}; pg8::StaticOrder S; S.init(M, DM, G, (int)blockIdx.x);
        EpiRes<1> E{XB, XC, ssq1}; pg8::gemm_phase(lds, g, S, E); }
    SEAM_FILL(5, (convert_weights<WJ_GATE>(a, lds, G)));
    if (IN(6)) { pg8::Gemm g{XC, (const bf16_t*)(ws + WS_WUP), M, DFF, DM, DM, DM, nullptr, nullptr, 0}; pg8::StaticOrder S; S.init(M, DFF, G, (int)blockIdx.x);
        EpiUp E{ssq1, U}; pg8::gemm_phase(lds, g, S, E); }
#define PLE_FILLER(round) do { pg8::Gemm g{PB, (const bf16_t*)(ws + WS_WPLE), M, DM, PLE, PLE, PLE, nullptr, nullptr, 0}; pg8::StaticOrder S; S.init(M, DM, G, (int)blockIdx.x); S.i0 = (round); S.imax = 1; \
        EpiPlain E{XB}; pg8::gemm_phase(lds, g, S, E); } while (0)
    SEAM_FILL(6, PLE_FILLER(0));
    if (IN(7)) {
        { pg8::Gemm g{U, (const bf16_t*)(ws + WS_WDN), M, DM, DFF, DFF, DFF, nullptr, nullptr, 0}; pg8::StaticOrder S; S.init(M, DM, G, (int)blockIdx.x);
          EpiRes<2> E{XC, XC, ssq2}; pg8::gemm_phase(lds, g, S, E); }
    }
    SEAM_FILL(7, PLE_FILLER(1));
    if (IN(8)) { pg8::Gemm g{XC, (const bf16_t*)(ws + WS_WGATE), M, DM, DM, DM, DM, nullptr, nullptr, 0}; pg8::StaticOrder S; S.init(M, DM, G, (int)blockIdx.x);
        EpiFinal E{ssq2, XB, XC, a.out}; pg8::gemm_phase(lds, g, S, E); }
#undef IN
#undef SEAM
#undef SEAM_FILL
#undef PLE_FILLER
}

extern "C" void kernel_launch(void* const* d_in, const int* in_sizes, int n_in, void* d_out, int out_size, void* d_ws, size_t ws_size, hipStream_t stream) {
    static int grid = 0;
    if (grid == 0) {
        if (n_in != 23 || out_size != M * DM || ws_size < WS_END) { fprintf(stderr, "kernel_launch: unexpected shapes (n_in %d out %d ws %zu)\n", n_in, out_size, ws_size); grid = -1; return; }
        int dev = 0, cus = 0, per_cu = 0;
        hipGetDevice(&dev); hipDeviceGetAttribute(&cus, hipDeviceAttributeMultiprocessorCount, dev);
        hipFuncSetAttribute((const void*)fwd_megakernel, hipFuncAttributeMaxDynamicSharedMemorySize, LDS_BYTES);
        hipOccupancyMaxActiveBlocksPerMultiprocessor(&per_cu, (const void*)fwd_megakernel, 512, LDS_BYTES);
        (void)hipGetLastError();
        if (per_cu < 1) fprintf(stderr, "kernel_launch: occupancy query says %d\n", per_cu);
        grid = cus > 0 ? cus : 256;
    }
    if (grid < 0) return;
    Args a{};
    for (int i = 0; i < 23; ++i) a.in[i] = (const float*)d_in[i];
    a.out = (float*)d_out; a.ws = (unsigned char*)d_ws;
#if MK_N_LAUNCHES == 1
    a.ph_lo = 0; a.ph_hi = 9;
    void* args[] = {&a};
    (void)hipMemsetAsync((char*)d_ws + WS_BAR, 0, XCD_BAR_WORDS * 4, stream);
    hipError_t e = hipLaunchCooperativeKernel((const void*)fwd_megakernel, dim3(grid), dim3(512), args, LDS_BYTES, stream);
    if (e != hipSuccess) fprintf(stderr, "cooperative launch failed: %s (grid %d)\n", hipGetErrorString(e), grid);
#else
    for (int ph = 0; ph < 9; ++ph) { a.ph_lo = ph; a.ph_hi = ph + 1; hipLaunchKernelGGL(fwd_megakernel, dim3(grid), dim3(512), LDS_BYTES, stream, a); }
#endif
}
```
